# Optimizing an MI355X kernel written in HIP

```python
import jax, jax.numpy as jnp
from jax import lax
import numpy as np

D_MODEL = 1024
BATCH = 8
SEQ = 4096
DEPTH = 2

ATTN_HEADS = 8
HEAD_DIM = 64
KV_GROUPS = 2
HEADS_PER_GROUP = ATTN_HEADS // KV_GROUPS
ATTN_DIM = ATTN_HEADS * HEAD_DIM
KV_DIM = KV_GROUPS * HEAD_DIM
N_NSA_BRANCHES = 3
CMP_BLOCK = 32
CMP_STRIDE = 16
CMP_HIDDEN = 2 * HEAD_DIM
SLC_BLOCK = 64
N_SELECT = 16
WINDOW = 512
Q_BLOCK = 64
FORCE_BONUS = 1000.0
RWKV_HEADS = 8
RWKV_HEAD_DIM = 64
RWKV_DIM = RWKV_HEADS * RWKV_HEAD_DIM
W_LORA = 64
A_LORA = 64
G_LORA = 128
RWKV_MIX_DIM = 3 * RWKV_DIM + W_LORA + A_LORA + G_LORA
N_BRANCHES = 2
D_FF = 4 * D_MODEL
NSA_DIM = ATTN_DIM + 6 * KV_DIM + N_NSA_BRANCHES * ATTN_HEADS
PROJ_DIM = NSA_DIM + RWKV_MIX_DIM + N_BRANCHES * D_MODEL
RMS_EPS = 1e-6
GN_EPS = 64e-5
NEG_INF = -1e30

kernel_name = "nsa_rwkv7_gated_hybrid"


def rms_norm(x, gain):
    xf = x.astype(jnp.float32)
    y = xf * lax.rsqrt(jnp.mean(xf * xf, axis=-1, keepdims=True) + RMS_EPS)
    return (y * gain.astype(jnp.float32)).astype(x.dtype)


def masked_softmax(s, mask):
    s = jnp.where(mask, s.astype(jnp.float32), NEG_INF)
    return jax.nn.softmax(s, axis=-1) * mask


def compress_blocks(kv, pos, w1, w2):
    S = kv.shape[2]
    n_cmp = (S - CMP_BLOCK) // CMP_STRIDE + 1
    idx = (jnp.arange(n_cmp) * CMP_STRIDE)[:, None] + jnp.arange(CMP_BLOCK)[None, :]
    blocks = kv[:, :, idx] + pos
    flat = blocks.reshape(blocks.shape[:3] + (CMP_BLOCK * HEAD_DIM,))
    return jax.nn.gelu(flat @ w1) @ w2


def nsa_attention(q, kc, vc, ks, vs, kw, vw, gates, q_gain, k_gain, cmp_pos, cmp_w1, cmp_w2):
    B, S, _ = q.shape
    dt = q.dtype
    scale = HEAD_DIM ** -0.5
    qh = rms_norm(q.reshape(B, S, KV_GROUPS, HEADS_PER_GROUP, HEAD_DIM), q_gain)
    qh = qh.transpose(0, 2, 3, 1, 4)
    heads = lambda t: t.reshape(B, S, KV_GROUPS, HEAD_DIM).transpose(0, 2, 1, 3)
    k_cmp = rms_norm(compress_blocks(heads(kc), cmp_pos[0], cmp_w1[0], cmp_w2[0]), k_gain[0])
    v_cmp = compress_blocks(heads(vc), cmp_pos[1], cmp_w1[1], cmp_w2[1])
    k_slc = rms_norm(heads(ks), k_gain[1])
    v_slc = heads(vs)
    k_win = rms_norm(heads(kw), k_gain[2])
    v_win = heads(vw)

    n_cmp = k_cmp.shape[2]
    n_slc = S // SLC_BLOCK
    k_sel = min(N_SELECT, n_slc)
    cmp_start = jnp.arange(n_cmp) * CMP_STRIDE
    cmp_end = cmp_start + CMP_BLOCK - 1
    slc_start = jnp.arange(n_slc) * SLC_BLOCK
    overlap = ((cmp_start[:, None] <= slc_start[None, :] + SLC_BLOCK - 1)
               & (cmp_end[:, None] >= slc_start[None, :])).astype(jnp.float32)
    k_slc_b = k_slc.reshape(B, KV_GROUPS, n_slc, SLC_BLOCK, HEAD_DIM)
    v_slc_b = v_slc.reshape(B, KV_GROUPS, n_slc, SLC_BLOCK, HEAD_DIM)
    pad = ((0, 0), (0, 0), (WINDOW, 0), (0, 0))
    k_win_p = jnp.pad(k_win, pad)
    v_win_p = jnp.pad(v_win, pad)
    b_ix = jnp.arange(B)[:, None, None, None]
    g_ix = jnp.arange(KV_GROUPS)[None, :, None, None]
    blk_ids = jnp.arange(n_slc)

    def block(qb):
        t0 = qb * Q_BLOCK
        tpos = t0 + jnp.arange(Q_BLOCK)
        qblk = lax.dynamic_slice_in_dim(qh, t0, Q_BLOCK, axis=3)
        cmask = cmp_end[None, :] <= tpos[:, None]
        p_c = masked_softmax(jnp.einsum('bghtd,bgnd->bghtn', qblk, k_cmp) * scale, cmask)
        o_c = jnp.einsum('bghtn,bgnd->bghtd', p_c.astype(dt), v_cmp)
        imp = jnp.einsum('bghtn,nj->bgtj', p_c, overlap)
        cur = tpos // SLC_BLOCK
        forced = ((blk_ids[None, :] == 0) | (blk_ids[None, :] == cur[:, None])
                  | (blk_ids[None, :] == cur[:, None] - 1))
        causal_blk = slc_start[None, :] <= tpos[:, None]
        imp = jnp.where(causal_blk, imp + jnp.where(forced, FORCE_BONUS, 0.0), -1.0)
        _, idx = lax.top_k(imp, k_sel)
        kg = k_slc_b[b_ix, g_ix, idx]
        vg = v_slc_b[b_ix, g_ix, idx]
        tok = idx[..., None] * SLC_BLOCK + jnp.arange(SLC_BLOCK)
        smask = (tok <= tpos[None, None, :, None, None]).reshape(B, KV_GROUPS, 1, Q_BLOCK, k_sel * SLC_BLOCK)
        s_s = jnp.einsum('bghtd,bgtkpd->bghtkp', qblk, kg) * scale
        p_s = masked_softmax(s_s.reshape(B, KV_GROUPS, HEADS_PER_GROUP, Q_BLOCK, k_sel * SLC_BLOCK), smask)
        p_s = p_s.reshape(B, KV_GROUPS, HEADS_PER_GROUP, Q_BLOCK, k_sel, SLC_BLOCK).astype(dt)
        o_s = jnp.einsum('bghtkp,bgtkpd->bghtd', p_s, vg)
        kwin = lax.dynamic_slice_in_dim(k_win_p, t0, Q_BLOCK + WINDOW, axis=2)
        vwin = lax.dynamic_slice_in_dim(v_win_p, t0, Q_BLOCK + WINDOW, axis=2)
        kpos = t0 - WINDOW + jnp.arange(Q_BLOCK + WINDOW)
        diff = tpos[:, None] - kpos[None, :]
        wmask = (kpos[None, :] >= 0) & (diff >= 0) & (diff < WINDOW)
        p_w = masked_softmax(jnp.einsum('bghtd,bgsd->bghts', qblk, kwin) * scale, wmask)
        o_w = jnp.einsum('bghts,bgsd->bghtd', p_w.astype(dt), vwin)
        return jnp.stack([o_c, o_s, o_w], axis=-2)

    out = lax.map(block, jnp.arange(S // Q_BLOCK))
    out = out.transpose(1, 0, 4, 2, 3, 5, 6).reshape(B, S, ATTN_HEADS, N_NSA_BRANCHES, HEAD_DIM)
    g = jax.nn.sigmoid(gates.reshape(B, S, ATTN_HEADS, N_NSA_BRANCHES))
    return jnp.einsum('bshcd,bshc->bshd', out, g).reshape(B, S, ATTN_DIM)


def rwkv7_time_mix(p, mu, w0, w_lora_up, a0, a_lora_up, g_lora_up, k_k, k_a, r_k, ln_w, ln_b):
    B, S, _ = p.shape
    f32 = jnp.float32
    dt = p.dtype
    shifted = jnp.pad(p, ((0, 0), (1, 0), (0, 0)))[:, :-1]
    p = p + (shifted - p) * mu
    splits = np.cumsum((RWKV_DIM, RWKV_DIM, RWKV_DIM, W_LORA, A_LORA)).tolist()
    r, k, v, wl, al, gl = jnp.split(p, splits, axis=-1)
    w = -jax.nn.softplus(-(w0 + jnp.tanh(wl) @ w_lora_up)) - 0.5
    decay = jnp.exp(-jnp.exp(w.astype(f32)))
    a = jax.nn.sigmoid(a0 + al @ a_lora_up)
    g = jax.nn.sigmoid(gl) @ g_lora_up
    hd = lambda t: t.reshape(B, S, RWKV_HEADS, RWKV_HEAD_DIM).astype(f32)
    kk = hd(k * k_k)
    kk = kk * lax.rsqrt(jnp.maximum(jnp.sum(kk * kk, axis=-1, keepdims=True), 1e-24))
    k = k * (1.0 + (a - 1.0) * k_a)
    rh, wh, kh, vh, ah = hd(r), hd(decay), hd(k), hd(v), hd(a)

    def step(state, inp):
        r_t, w_t, k_t, v_t, kk_t, a_t = inp
        sa = jnp.einsum('bhvk,bhk->bhv', state, -kk_t)
        state = (state * w_t[:, :, None, :] + sa[..., None] * (kk_t * a_t)[:, :, None, :]
                 + v_t[..., None] * k_t[:, :, None, :])
        return state, jnp.einsum('bhvk,bhk->bhv', state, r_t)

    tm = lambda t: jnp.moveaxis(t, 1, 0)
    state0 = jnp.zeros((B, RWKV_HEADS, RWKV_HEAD_DIM, RWKV_HEAD_DIM), f32)
    _, y = lax.scan(step, state0, (tm(rh), tm(wh), tm(kh), tm(vh), tm(kk), tm(ah)))
    y = jnp.moveaxis(y, 0, 1)
    mean = jnp.mean(y, axis=-1, keepdims=True)
    var = jnp.mean(jnp.square(y - mean), axis=-1, keepdims=True)
    y = ((y - mean) * lax.rsqrt(var + GN_EPS)).reshape(B, S, RWKV_DIM) * ln_w + ln_b
    bonus = jnp.sum(rh * kh * r_k, axis=-1, keepdims=True) * vh
    y = (y + bonus.reshape(B, S, RWKV_DIM)) * g
    return y.astype(dt)


def setup_inputs(seed: int = 0) -> dict:
    key = jax.random.key(seed)
    ks = jax.random.split(key, 32)
    f32 = jnp.float32
    nrm = lambda k, shape, s: jax.random.normal(k, shape, f32) * s
    L = DEPTH
    ramp = jnp.arange(RWKV_DIM, dtype=f32) / (RWKV_DIM - 1)
    return {
        "x": nrm(ks[0], (BATCH, SEQ, D_MODEL), 1.0),
        "mix_norm": 1.0 + nrm(ks[1], (L, D_MODEL), 0.02),
        "w_in": nrm(ks[2], (L, D_MODEL, PROJ_DIM), D_MODEL ** -0.5),
        "q_gain": 1.0 + nrm(ks[3], (L, HEAD_DIM), 0.02),
        "k_gain": 1.0 + nrm(ks[4], (L, N_NSA_BRANCHES, HEAD_DIM), 0.02),
        "cmp_pos": nrm(ks[5], (L, 2, CMP_BLOCK, HEAD_DIM), 0.1),
        "cmp_w1": nrm(ks[6], (L, 2, CMP_BLOCK * HEAD_DIM, CMP_HIDDEN), (CMP_BLOCK * HEAD_DIM) ** -0.5),
        "cmp_w2": nrm(ks[7], (L, 2, CMP_HIDDEN, HEAD_DIM), CMP_HIDDEN ** -0.5),
        "w_attn_branch": nrm(ks[8], (L, ATTN_DIM, D_MODEL), ATTN_DIM ** -0.5),
        "tok_mix": jax.random.uniform(ks[9], (L, RWKV_MIX_DIM), f32),
        "w0": -6.0 + 5.0 * ramp ** 0.9 + nrm(ks[10], (L, RWKV_DIM), 0.1),
        "w_lora_up": nrm(ks[11], (L, W_LORA, RWKV_DIM), 0.5 * W_LORA ** -0.5),
        "a0": nrm(ks[12], (L, RWKV_DIM), 0.1),
        "a_lora_up": nrm(ks[13], (L, A_LORA, RWKV_DIM), A_LORA ** -0.5),
        "g_lora_up": nrm(ks[14], (L, G_LORA, RWKV_DIM), G_LORA ** -0.5),
        "k_k": 0.85 + nrm(ks[15], (L, RWKV_DIM), 0.02),
        "k_a": 1.0 + nrm(ks[16], (L, RWKV_DIM), 0.02),
        "r_k": nrm(ks[17], (L, RWKV_HEADS, RWKV_HEAD_DIM), 0.1),
        "ln_x_w": 1.0 + nrm(ks[18], (L, RWKV_DIM), 0.02),
        "ln_x_b": nrm(ks[19], (L, RWKV_DIM), 0.02),
        "w_rwkv_branch": nrm(ks[20], (L, RWKV_DIM, D_MODEL), RWKV_DIM ** -0.5),
        "w_out": nrm(ks[21], (L, D_MODEL, D_MODEL), D_MODEL ** -0.5),
        "ffn_norm": 1.0 + nrm(ks[22], (L, D_MODEL), 0.02),
        "w_ffn_up": nrm(ks[23], (L, D_MODEL, D_FF), D_MODEL ** -0.5),
        "w_ffn_down": nrm(ks[24], (L, D_FF, D_MODEL), D_FF ** -0.5),
    }


def reference(x, mix_norm, w_in, q_gain, k_gain, cmp_pos, cmp_w1, cmp_w2, w_attn_branch,
              tok_mix, w0, w_lora_up, a0, a_lora_up, g_lora_up, k_k, k_a, r_k, ln_x_w, ln_x_b,
              w_rwkv_branch, w_out, ffn_norm, w_ffn_up, w_ffn_down):
    nsa_splits = np.cumsum((ATTN_DIM,) + (KV_DIM,) * 6).tolist()
    for l in range(DEPTH):
        u = rms_norm(x, mix_norm[l])
        proj = u @ w_in[l]
        nsa_p, rwkv_p, gate_p = jnp.split(proj, [NSA_DIM, NSA_DIM + RWKV_MIX_DIM], axis=-1)
        q, kc, vc, ks_, vs_, kw, vw, nsa_g = jnp.split(nsa_p, nsa_splits, axis=-1)
        y_a = nsa_attention(q, kc, vc, ks_, vs_, kw, vw, nsa_g, q_gain[l], k_gain[l],
                            cmp_pos[l], cmp_w1[l], cmp_w2[l])
        y_b = rwkv7_time_mix(rwkv_p, tok_mix[l], w0[l], w_lora_up[l], a0[l], a_lora_up[l],
                             g_lora_up[l], k_k[l], k_a[l], r_k[l], ln_x_w[l], ln_x_b[l])
        g_a, g_b = jnp.split(gate_p, N_BRANCHES, axis=-1)
        merged = (jax.nn.sigmoid(g_a) * (y_a @ w_attn_branch[l])
                  + jax.nn.sigmoid(g_b) * (y_b @ w_rwkv_branch[l]))
        x = x + merged @ w_out[l]
        h = rms_norm(x, ffn_norm[l])
        x = x + jnp.square(jax.nn.relu(h @ w_ffn_up[l])) @ w_ffn_down[l]
    return x
```

```cpp
#include <hip/hip_runtime.h>
#include <hip/hip_cooperative_groups.h>
#include <cstdio>
#include <cstdint>
namespace cg = cooperative_groups;
namespace pg8 {
#define PG8_LAS __attribute__((address_space(3)))
typedef unsigned short bf16_t;
typedef short bf16x8 __attribute__((ext_vector_type(8)));
typedef float f32x4 __attribute__((ext_vector_type(4)));
typedef unsigned u32x4 __attribute__((ext_vector_type(4)));
constexpr int BM = 256, BK = 64, HALF = 128, HTB = HALF * BK * 2  , STAGE_BYTES = 8 * HTB, NXCD = 8, WGM = 8;

__host__ __device__ __forceinline__ int lds_byte(int r, int c) { const int st = (r >> 4) * 2 + (c >> 5), rr = r & 15, cc = c & 31, ob = rr * 64 + cc * 2; return st * 1024 + (ob ^ (((ob >> 9) & 1) << 5)); }
__host__ __device__ __forceinline__ void stage_rc(int b, int& R, int& C) { const int st = b / 1024, sb = b % 1024, swz = sb ^ (((sb >> 9) & 1) << 5); R = (st >> 1) * 16 + swz / 64; C = (st & 1) * 32 + (swz % 64) / 2; }
__host__ __device__ __forceinline__ int perm32(int rho) { const int n = rho >> 4, i = rho & 15; return 8 * (i >> 2) + 4 * n + (i & 3); }

struct Unit { int pm, pn; };
struct Gemm { const bf16_t* A; const bf16_t* Bt; int M, N, K, lda; };

struct StaticOrder {
    int nM, nN, nwg, G, c;
    __host__ __device__ void init(int M, int N, int G_, int c_) { nM = M / BM; nN = N / BM; nwg = nM * nN; G = G_; c = c_; }
    __host__ __device__ bool next(int i, Unit& u) const {
        const long L = (long)i * G + c; if (L >= nwg) return false;
        int wgid = (int)L; { const int q = nwg / NXCD, r = nwg % NXCD, xcd = wgid % NXCD, off = wgid / NXCD; wgid = (xcd < r ? xcd * (q + 1) : r * (q + 1) + (xcd - r) * q) + off; }
        const int nig = WGM * nN, gid = wgid / nig, fm = gid * WGM, gsz = (nM - fm) < WGM ? (nM - fm) : WGM;
        u.pm = fm + ((wgid % nig) % gsz); u.pn = (wgid % nig) / gsz; return true;
    }
    __device__ __forceinline__ void a_ready(const Unit&) const {}
    __device__ __forceinline__ void done(const Unit&) const {}
};
__device__ __forceinline__ unsigned cvt_pk_bf16(float lo, float hi) { unsigned r; asm volatile("v_cvt_pk_bf16_f32 %0, %1, %2" : "=v"(r) : "v"(lo), "v"(hi)); return r; }
template <class Epi, class Sched, bool ALIGN_EPI = false, bool SP2 = false>
__device__ __forceinline__ void gemm_phase(PG8_LAS unsigned char* lds, const Gemm g, const Sched& S, const Epi& E) {
    int tid_ = threadIdx.x; asm volatile("" : "+v"(tid_));
    const int tid = tid_, wid = __builtin_amdgcn_readfirstlane(tid >> 6), lane = tid & 63, wr = wid >> 2, wc = wid & 3, fr = lane & 15, fq = lane >> 4;
    const int K = g.K, nt = K / BK;
    unsigned voffA[2], voffB[2];
#pragma unroll
    for (int i = 0; i < 2; ++i) { int R, C; stage_rc(tid * 16 + i * 8192, R, C); const int Rb = Epi::PERM ? ((R & ~31) + perm32(R & 31)) : R;
        voffA[i] = (unsigned)(R * g.lda + C) * 2u; voffB[i] = (unsigned)(Rb * K + C) * 2u; }
    const size_t kstep = (size_t)(BK * 2);
    const size_t hstepB = (size_t)HALF * K * 2, hstepA = (size_t)HALF * g.lda * 2;
    const size_t tstepA = 2 * hstepA, tstepB = 2 * hstepB;
    const unsigned ldsw = (unsigned)wid * 1024u;
    const int aoff = lds_byte(wr * 64 + fr, fq * 8), boff = lds_byte(wc * 32 + fr, fq * 8);
#define PG8_SA(b, h) (((b) * 2 + (h)) * HTB)
#define PG8_SB(b, h) ((4 + (b) * 2 + (h)) * HTB)
#define PG8_STAGE(bufoff, gbase, voff) do { _Pragma("unroll") for (int _i = 0; _i < 2; ++_i) \
        __builtin_amdgcn_global_load_lds((const unsigned*)((const char*)(gbase) + (voff)[_i]), (PG8_LAS unsigned*)(lds + (bufoff) + ldsw + _i * 8192), 16, 0, 0); } while (0)
#define PG8_LDA(dst, b, h) do { _Pragma("unroll") for (int m = 0; m < 4; ++m) _Pragma("unroll") for (int k = 0; k < 2; ++k) dst[m][k] = *(const PG8_LAS bf16x8*)(lds + PG8_SA(b, h) + aoff + m * 2048 + k * 1024); } while (0)
#define PG8_LDB(dst, b, h) do { _Pragma("unroll") for (int n = 0; n < 2; ++n) _Pragma("unroll") for (int k = 0; k < 2; ++k) dst[n][k] = *(const PG8_LAS bf16x8*)(lds + PG8_SB(b, h) + boff + n * 2048 + k * 1024); } while (0)
#define PG8_MMA(ai, bj, At, Bt) do { __builtin_amdgcn_s_setprio(1); _Pragma("unroll") for (int m = 0; m < 4; ++m) _Pragma("unroll") for (int n = 0; n < 2; ++n) _Pragma("unroll") for (int k = 0; k < 2; ++k) \
        acc[ai][bj][m][n] = __builtin_amdgcn_mfma_f32_16x16x32_bf16(Bt[n][k], At[m][k], acc[ai][bj][m][n], 0, 0, 0); __builtin_amdgcn_s_setprio(0); } while (0)
#define PG8_WAIT_V(n) asm volatile("s_waitcnt vmcnt(" #n ")" ::: "memory")
#define PG8_WAIT_L(n) asm volatile("s_waitcnt lgkmcnt(" #n ")" ::: "memory")
#define PG8_BAR __builtin_amdgcn_s_barrier()
#define PG8_SCHED __builtin_amdgcn_sched_barrier(0)
    Unit cur, nxt; int ui = 0;
    if (!S.next(0, cur)) return;
    f32x4 acc[2][2][4][2];
#pragma unroll
    for (int a = 0; a < 2; ++a)
#pragma unroll
        for (int b = 0; b < 2; ++b)
#pragma unroll
            for (int m = 0; m < 4; ++m)
#pragma unroll
                for (int n = 0; n < 2; ++n) acc[a][b][m][n] = (f32x4){0.f, 0.f, 0.f, 0.f};
    bf16x8 At[4][2], B0[2][2], B1[2][2];
    const char* cA = (const char*)g.A + (size_t)cur.pm * tstepA; const char* cB = (const char*)g.Bt + (size_t)cur.pn * tstepB;
    S.a_ready(cur);
    if constexpr (SP2) {
        PG8_STAGE(PG8_SB(0, 0), cB, voffB); PG8_STAGE(PG8_SB(0, 1), cB + hstepB, voffB); PG8_STAGE(PG8_SA(0, 0), cA, voffA); PG8_STAGE(PG8_SA(0, 1), cA + hstepA, voffA);
        if (wr == 1) PG8_BAR;
        PG8_WAIT_V(2); PG8_BAR;
        PG8_STAGE(PG8_SB(1, 0), cB + kstep, voffB); PG8_STAGE(PG8_SA(1, 0), cA + kstep, voffA); PG8_STAGE(PG8_SB(1, 1), cB + hstepB + kstep, voffB);
        PG8_WAIT_V(6); PG8_BAR;
    } else {
        PG8_STAGE(PG8_SB(0, 0), cB, voffB); PG8_STAGE(PG8_SA(0, 0), cA, voffA); PG8_STAGE(PG8_SB(0, 1), cB + hstepB, voffB); PG8_STAGE(PG8_SA(0, 1), cA + hstepA, voffA);
        if (wr == 1) PG8_BAR;
        PG8_WAIT_V(4); PG8_BAR;
        PG8_STAGE(PG8_SB(1, 0), cB + kstep, voffB); PG8_STAGE(PG8_SA(1, 0), cA + kstep, voffA); PG8_STAGE(PG8_SB(1, 1), cB + hstepB + kstep, voffB);
        PG8_WAIT_V(6); PG8_BAR;
    }
    for (;;) {
        const bool has_next = S.next(ui + 1, nxt);
        const char* nA = has_next ? (const char*)g.A + (size_t)nxt.pm * tstepA : cA; const char* nB = has_next ? (const char*)g.Bt + (size_t)nxt.pn * tstepB : cB;
        for (int t = 0; t < nt; t += 2) {
            const bool last = (t == nt - 2);
            const char* a1 = cA + (size_t)(t + 1) * kstep;
            const char* a2 = last ? nA : cA + (size_t)(t + 2) * kstep; const char* b2 = last ? nB : cB + (size_t)(t + 2) * kstep;
            const char* a3 = a2 + kstep; const char* b3 = b2 + kstep;
            if (last && has_next) S.a_ready(nxt);
            if constexpr (SP2) {
            PG8_LDB(B0, 0, 0); PG8_LDB(B1, 0, 1); PG8_SCHED; PG8_LDA(At, 0, 0); PG8_STAGE(PG8_SA(1, 1), a1 + hstepA, voffA);
            PG8_WAIT_V(8); PG8_WAIT_L(0); PG8_BAR; PG8_MMA(0, 0, At, B0); PG8_MMA(0, 1, At, B1); PG8_BAR; PG8_SCHED;
            PG8_LDA(At, 0, 1); PG8_STAGE(PG8_SB(0, 0), b2, voffB); PG8_STAGE(PG8_SB(0, 1), b2 + hstepB, voffB); PG8_STAGE(PG8_SA(0, 0), a2, voffA);
            PG8_WAIT_V(8); PG8_WAIT_L(0); PG8_BAR; PG8_MMA(1, 0, At, B0); PG8_MMA(1, 1, At, B1); PG8_BAR; PG8_SCHED;
            PG8_LDB(B0, 1, 0); PG8_LDB(B1, 1, 1); PG8_SCHED; PG8_LDA(At, 1, 0); PG8_STAGE(PG8_SA(0, 1), a2 + hstepA, voffA);
            PG8_WAIT_V(8); PG8_WAIT_L(0); PG8_BAR; PG8_MMA(0, 0, At, B0); PG8_MMA(0, 1, At, B1); PG8_BAR; PG8_SCHED;
            PG8_LDA(At, 1, 1); PG8_STAGE(PG8_SB(1, 0), b3, voffB); PG8_STAGE(PG8_SB(1, 1), b3 + hstepB, voffB); PG8_STAGE(PG8_SA(1, 0), a3, voffA);
            PG8_WAIT_V(8); PG8_WAIT_L(0); PG8_BAR; PG8_MMA(1, 0, At, B0); PG8_MMA(1, 1, At, B1); PG8_BAR; PG8_SCHED;
            } else {
            PG8_LDB(B0, 0, 0); PG8_SCHED; PG8_LDA(At, 0, 0); PG8_STAGE(PG8_SA(1, 1), a1 + hstepA, voffA);
            PG8_WAIT_L(8); PG8_BAR; PG8_WAIT_L(0); PG8_MMA(0, 0, At, B0); PG8_BAR; PG8_SCHED;
            PG8_LDB(B1, 0, 1); PG8_STAGE(PG8_SB(0, 0), b2, voffB);
            PG8_BAR; PG8_WAIT_L(0); PG8_MMA(0, 1, At, B1); PG8_BAR;
            PG8_LDA(At, 0, 1); PG8_STAGE(PG8_SA(0, 0), a2, voffA);
            PG8_BAR; PG8_WAIT_L(0); PG8_MMA(1, 0, At, B0); PG8_BAR; PG8_SCHED;
            PG8_STAGE(PG8_SB(0, 1), b2 + hstepB, voffB);
            PG8_WAIT_V(6); PG8_BAR; PG8_MMA(1, 1, At, B1); PG8_BAR;
            PG8_LDB(B0, 1, 0); PG8_SCHED; PG8_LDA(At, 1, 0); PG8_STAGE(PG8_SA(0, 1), a2 + hstepA, voffA);
            PG8_WAIT_L(8); PG8_BAR; PG8_WAIT_L(0); PG8_MMA(0, 0, At, B0); PG8_BAR; PG8_SCHED;
            PG8_LDB(B1, 1, 1); PG8_STAGE(PG8_SB(1, 0), b3, voffB);
            PG8_BAR; PG8_WAIT_L(0); PG8_MMA(0, 1, At, B1); PG8_BAR;
            PG8_LDA(At, 1, 1); PG8_STAGE(PG8_SA(1, 0), a3, voffA);
            PG8_BAR; PG8_WAIT_L(0); PG8_MMA(1, 0, At, B0); PG8_BAR; PG8_SCHED;
            PG8_STAGE(PG8_SB(1, 1), b3 + hstepB, voffB);
            PG8_WAIT_V(6); PG8_BAR; PG8_MMA(1, 1, At, B1); PG8_BAR;
            }
        }
        if constexpr (ALIGN_EPI) { if (wr == 0) PG8_BAR; }
        if constexpr (!Epi::AFTER_DRAIN) { E(acc, cur, wr, wc, fr, fq); S.done(cur); }
        if (!has_next) break;
#pragma unroll
        for (int a = 0; a < 2; ++a)
#pragma unroll
            for (int b = 0; b < 2; ++b)
#pragma unroll
                for (int m = 0; m < 4; ++m)
#pragma unroll
                    for (int n = 0; n < 2; ++n) acc[a][b][m][n] = (f32x4){0.f, 0.f, 0.f, 0.f};
        cur = nxt; cA = nA; cB = nB; ++ui;
        if constexpr (ALIGN_EPI) { if (wr == 1) PG8_BAR; }
    }
    PG8_WAIT_V(0);
    if constexpr (!ALIGN_EPI) { if (wr == 0) PG8_BAR; }
    PG8_BAR;
    if constexpr (Epi::AFTER_DRAIN) { E.fused(acc, cur, wr, wc, fr, fq, lds, wid, lane); S.done(cur); }
#undef PG8_SA
#undef PG8_SB
#undef PG8_STAGE
#undef PG8_LDA
#undef PG8_LDB
#undef PG8_MMA
#undef PG8_WAIT_V
#undef PG8_WAIT_L
#undef PG8_BAR
#undef PG8_SCHED
}
}

#define LAS __attribute__((address_space(3)))
#define DI __device__ __forceinline__
typedef unsigned short bf16_t;
typedef short bf16x8 __attribute__((ext_vector_type(8)));
typedef float f32x4 __attribute__((ext_vector_type(4)));
typedef float f32x2 __attribute__((ext_vector_type(2)));
typedef float f32x16 __attribute__((ext_vector_type(16)));
typedef unsigned u32x4 __attribute__((ext_vector_type(4)));
typedef unsigned u32x2 __attribute__((ext_vector_type(2)));
typedef __bf16 bf2_t __attribute__((ext_vector_type(2)));

DI int otid() { int t = threadIdx.x; asm volatile("" : "+v"(t)); return t; }
DI unsigned pk2(float a, float b) { f32x2 v = {a, b}; bf2_t r = __builtin_convertvector(v, bf2_t); return __builtin_bit_cast(unsigned, r); }
DI float bflo(unsigned w) { return __uint_as_float(w << 16); }
DI float bfhi(unsigned w) { return __uint_as_float(w & 0xffff0000u); }
DI float bf1(bf16_t h) { return __uint_as_float(((unsigned)h) << 16); }
DI bf16_t tobf(float x) { return (bf16_t)(pk2(x, 0.f) & 0xffffu); }
DI float sigm(float x) { return __builtin_amdgcn_rcpf(1.f + __expf(-x)); }
DI float tanh_fast(float x) { return 1.f - 2.f * __builtin_amdgcn_rcpf(1.f + __expf(2.f * x)); }
DI void unpack8(const u32x4 w, float* f) { f[0] = bflo(w.x); f[1] = bfhi(w.x); f[2] = bflo(w.y); f[3] = bfhi(w.y); f[4] = bflo(w.z); f[5] = bfhi(w.z); f[6] = bflo(w.w); f[7] = bfhi(w.w); }
DI u32x4 pack8(const float* f) { u32x4 w; w.x = pk2(f[0], f[1]); w.y = pk2(f[2], f[3]); w.z = pk2(f[4], f[5]); w.w = pk2(f[6], f[7]); return w; }
template <int CTRL> DI float dpp_add(float x) { return x + __builtin_bit_cast(float, __builtin_amdgcn_update_dpp(0, __builtin_bit_cast(int, x), CTRL, 0xf, 0xf, true)); }
DI float red4(float x) { x = dpp_add<0xB1>(x); x = dpp_add<0x4E>(x); return x; }
DI float red8(float x) { x = red4(x); x = dpp_add<0x141>(x); return x; }
DI float red16(float x) { x = red8(x); x = dpp_add<0x140>(x); return x; }
DI float wave_sum(float v) {
#pragma unroll
    for (int o = 1; o < 64; o <<= 1) v += __shfl_xor(v, o);
    return v;
}
#define MFMA16(a, b, c) __builtin_amdgcn_mfma_f32_16x16x32_bf16((a), (b), (c), 0, 0, 0)
#define MFMA32(a, b, c) __builtin_amdgcn_mfma_f32_32x32x16_bf16((a), (b), (c), 0, 0, 0)

constexpr int M_TOK = 32768, DM = 1024, SEQ = 4096;
constexpr int PP = 3096;
constexpr int NPROJ = 5144, NPROJ_P = 5376;
constexpr int C_Q = 0, C_KC = 512, C_VC = 640, C_KS = 768, C_VS = 896, C_KW = 1024, C_VW = 1152, C_NG = 1280, C_R = 1304, C_K = 1816, C_V = 2328,
              C_WL = 2840, C_AL = 2904, C_GL = 2968, C_GA = 3096;
constexpr size_t MiB = 1u << 20;
constexpr size_t WS_BIASP = 0, WS_KCN = 64 * 1024, WS_VCT = WS_KCN + 512 * 1024, WS_SS = 2 * MiB, WS_BAR = 3 * MiB;
constexpr size_t WS_W = 4 * MiB, WS_PROJ = 36 * MiB, WS_GATE = 230 * MiB, WS_PREP = 294 * MiB, WS_VST = 486 * MiB, WS_VWT = 494 * MiB, WS_H = 36 * MiB;
constexpr size_t WS_U = WS_PREP, WS_MERGED = WS_PREP, WS_HN = WS_PREP + 64 * MiB;
constexpr size_t W_IN = 0, W_A = 5505024, W_B = 6029312, W_OUT = 6553600, W_UP = 7602176, W_DOWN = 11796480, W_WL = 15990784, W_AL = 16023552, W_GL = 16056320,
                 W_C1 = 16121856, W_C2 = 16646144;
constexpr int LDS_BYTES = 155648;

struct Args { const float* in[25]; float* out; unsigned char* ws; int ph_lo, ph_hi; };
enum { I_X = 0, I_MIXNORM, I_WIN, I_QGAIN, I_KGAIN, I_CMPPOS, I_CMPW1, I_CMPW2, I_WATTN, I_TOKMIX, I_W0, I_WLORA, I_A0, I_ALORA, I_GLORA, I_KK, I_KA, I_RK, I_LNW, I_LNB,
       I_WRWKV, I_WOUT, I_FFNNORM, I_WUP, I_WDOWN };

#define XB_TMO      128
#define XB_XCNT(j)  (256  + 64 * (j))
#define XB_XSUB(j)  (1280 + 64 * (j))
#define XB_XGEN(j)  (2304 + 64 * (j))
#define XB_TOP      3328
#define XB_TOPGEN   3392
#define XCD_BAR_WORDS 3456
#define XB_SPIN_CAP (1u << 18)

__device__ __forceinline__ unsigned xb_ld(unsigned* p)              { return __hip_atomic_load(p, __ATOMIC_RELAXED, __HIP_MEMORY_SCOPE_AGENT); }
__device__ __forceinline__ unsigned xb_add(unsigned* p, unsigned v) { return __hip_atomic_fetch_add(p, v, __ATOMIC_RELAXED, __HIP_MEMORY_SCOPE_AGENT); }
__device__ __forceinline__ unsigned xb_xcc_id() { return (unsigned)__builtin_amdgcn_s_getreg((3 << 11) | 20) & 0xFu; }
#define XB_SPIN(cond, bar) do { unsigned _sp = 0; while (cond) { __builtin_amdgcn_s_sleep(1); \
    if ((++_sp & 255u) == 0u) { if (xb_ld(&(bar)[XB_TMO])) break; if (_sp > XB_SPIN_CAP) { atomicAdd(&(bar)[XB_TMO], 1u); break; } } } } while (0)

struct XcdBarrier {
    unsigned* bar; unsigned x;
    volatile LAS unsigned* st;
};

__device__ __forceinline__ XcdBarrier xcd_barrier_post(unsigned* bar, volatile LAS unsigned* st) {
    XcdBarrier b; b.bar = bar; b.x = xb_xcc_id(); b.st = st;
    if (threadIdx.x == 0) (void)xb_add(&bar[XB_XCNT(b.x)], 1u);
    return b;
}
__device__ __forceinline__ void xcd_barrier_complete(unsigned* bar, unsigned x, unsigned& nloc, unsigned& nx) {
    const unsigned G = gridDim.x * gridDim.y * gridDim.z;
    unsigned sum, cnt, mine, sp = 0u;
    for (;;) {
        sum = 0u; cnt = 0u; mine = 0u;
#pragma unroll
        for (unsigned j = 0; j < 16; ++j) { const unsigned c = xb_ld(&bar[XB_XCNT(j)]); sum += c; cnt += (c > 0u) ? 1u : 0u; mine = (j == x) ? c : mine; }
        if (sum == G) break;
        __builtin_amdgcn_s_sleep(1);
        if ((++sp & 255u) == 0u) { if (xb_ld(&bar[XB_TMO])) break; if (sp > XB_SPIN_CAP) { atomicAdd(&bar[XB_TMO], 1u); break; } }
    }
    nloc = mine > 0u ? mine : 1u; nx = cnt > 0u ? cnt : 1u;
}

__device__ __forceinline__ void xcd_barrier(const XcdBarrier& b) {
    asm volatile("s_waitcnt vmcnt(0)" ::: "memory");
    __syncthreads();
    if (threadIdx.x == 0) {
        unsigned* bar = b.bar;
        __builtin_amdgcn_s_waitcnt(0);
        unsigned nloc = b.st[0], nx = b.st[1];
        if (nloc == 0u) { xcd_barrier_complete(bar, b.x, nloc, nx); b.st[0] = nloc; b.st[1] = nx; }
        const unsigned old = xb_add(&bar[XB_XSUB(b.x)], 1u);
        const unsigned gen = old / nloc;
        if (old + 1u == (gen + 1u) * nloc) {
            __builtin_amdgcn_fence(__ATOMIC_RELEASE, "agent");
            asm volatile("s_waitcnt vmcnt(0)" ::: "memory");
            const unsigned og = xb_add(&bar[XB_TOP], 1u);
            const unsigned tg = og / nx;
            if (og + 1u == (tg + 1u) * nx) xb_add(&bar[XB_TOPGEN], 1u);
            else XB_SPIN(xb_ld(&bar[XB_TOPGEN]) == tg, bar);
            __builtin_amdgcn_fence(__ATOMIC_ACQUIRE, "agent");
            xb_add(&bar[XB_XGEN(b.x)], 1u);
            asm volatile("s_waitcnt vmcnt(0)" ::: "memory");
        } else {
            XB_SPIN(xb_ld(&bar[XB_XGEN(b.x)]) == gen, bar);
            __builtin_amdgcn_fence(__ATOMIC_ACQUIRE, "agent");
            asm volatile("s_waitcnt vmcnt(0)" ::: "memory");
        }
    }
    __syncthreads();
}

namespace pg8 {
struct EpiProj {
    static constexpr bool PERM = true, AFTER_DRAIN = false;
    bf16_t* P; uint8_t* G; const float* ss;
    __device__ __forceinline__ void operator()(const f32x4 (&acc)[2][2][4][2], const Unit& u, int wr, int wc, int fr, int fq) const {
        const int row0 = u.pm * BM + wr * 64 + fr, col0 = u.pn * BM + wc * 32 + 8 * fq;
#pragma unroll
        for (int ai = 0; ai < 2; ++ai)
#pragma unroll
            for (int m = 0; m < 4; ++m) {
                const size_t row = (size_t)(row0 + ai * HALF + m * 16);
                const float rs = ss ? rsqrtf(ss[row] * (1.f / 1024.f) + 1e-6f) : 1.f;
#pragma unroll
                for (int bj = 0; bj < 2; ++bj) {
                    const int col = col0 + bj * HALF;
                    f32x4 v0 = acc[ai][bj][m][0] * rs, v1 = acc[ai][bj][m][1] * rs;
                    if (col < C_GA) {
                        if (col >= C_NG && col < C_R) {
#pragma unroll
                            for (int e = 0; e < 4; ++e) { v0[e] = sigm(v0[e]); v1[e] = sigm(v1[e]); }
                        }
                        ::u32x4 w; w.x = cvt_pk_bf16(v0[0], v0[1]); w.y = cvt_pk_bf16(v0[2], v0[3]); w.z = cvt_pk_bf16(v1[0], v1[1]); w.w = cvt_pk_bf16(v1[2], v1[3]);
                        *(::u32x4*)(P + row * PP + col) = w;
                    } else if (col < NPROJ) {
                        unsigned q[8];
#pragma unroll
                        for (int e = 0; e < 4; ++e) { q[e] = (unsigned)__builtin_rintf(sigm(v0[e]) * 255.f); q[4 + e] = (unsigned)__builtin_rintf(sigm(v1[e]) * 255.f); }
                        ::u32x2 w; w.x = q[0] | (q[1] << 8) | (q[2] << 16) | (q[3] << 24); w.y = q[4] | (q[5] << 8) | (q[6] << 16) | (q[7] << 24);
                        *(::u32x2*)(G + row * 2048 + (col - C_GA)) = w;
                    }
                }
            }
    }
};
template <bool SECOND> struct EpiMerge {
    static constexpr bool PERM = true, AFTER_DRAIN = false;
    bf16_t* O; const uint8_t* G;
    __device__ __forceinline__ void operator()(const f32x4 (&acc)[2][2][4][2], const Unit& u, int wr, int wc, int fr, int fq) const {
        const int row0 = u.pm * BM + wr * 64 + fr, col0 = u.pn * BM + wc * 32 + 8 * fq;
        ::u32x2 cg[2]; ::u32x4 ct[2];
#pragma unroll
        for (int bj = 0; bj < 2; ++bj) { cg[bj] = *(const ::u32x2*)(G + (size_t)row0 * 2048 + (SECOND ? 1024 : 0) + col0 + bj * HALF); if (SECOND) ct[bj] = *(const ::u32x4*)(O + (size_t)row0 * 1024 + col0 + bj * HALF); }
#pragma unroll
        for (int it = 0; it < 8; ++it) {
            const int ai = it >> 2, m = it & 3;
            const size_t row = (size_t)(row0 + ai * HALF + m * 16);
            ::u32x2 ng[2]; ::u32x4 nt[2];
            if (it + 1 < 8) {
                const size_t row2 = (size_t)(row0 + ((it + 1) >> 2) * HALF + ((it + 1) & 3) * 16);
#pragma unroll
                for (int bj = 0; bj < 2; ++bj) { ng[bj] = *(const ::u32x2*)(G + row2 * 2048 + (SECOND ? 1024 : 0) + col0 + bj * HALF); if (SECOND) nt[bj] = *(const ::u32x4*)(O + row2 * 1024 + col0 + bj * HALF); }
            }
#pragma unroll
            for (int bj = 0; bj < 2; ++bj) {
                const ::u32x2 gq = cg[bj];
                float v[8];
#pragma unroll
                for (int e = 0; e < 4; ++e) { v[e] = acc[ai][bj][m][0][e] * ((float)((gq.x >> (8 * e)) & 255u) * (1.f / 255.f)); v[4 + e] = acc[ai][bj][m][1][e] * ((float)((gq.y >> (8 * e)) & 255u) * (1.f / 255.f)); }
                if (SECOND) { float tf[8]; unpack8(ct[bj], tf);
#pragma unroll
                    for (int e = 0; e < 8; ++e) v[e] += tf[e]; }
                *(::u32x4*)(O + row * 1024 + col0 + bj * HALF) = pack8(v);
            }
            asm volatile("" ::: "memory");
            if (it + 1 < 8) {
#pragma unroll
                for (int bj = 0; bj < 2; ++bj) { cg[bj] = ng[bj]; if (SECOND) ct[bj] = nt[bj]; }
            }
        }
    }
};
struct EpiResF32 {
    static constexpr bool PERM = false, AFTER_DRAIN = false;
    const float* base; float* out; bf16_t* xn; const float* gain; float* ss;
    __device__ __forceinline__ void operator()(const f32x4 (&acc)[2][2][4][2], const Unit& u, int wr, int wc, int fr, int fq) const {
        const int row0 = u.pm * BM + wr * 64 + fr, col0 = u.pn * BM + wc * 32 + 4 * fq;
        f32x4 gv[2][2];
        if (xn) {
#pragma unroll
            for (int bj = 0; bj < 2; ++bj)
#pragma unroll
                for (int n = 0; n < 2; ++n) gv[bj][n] = *(const f32x4*)(gain + col0 + bj * HALF + n * 16);
        }
        f32x4 cb[2][2];
#pragma unroll
        for (int bj = 0; bj < 2; ++bj)
#pragma unroll
            for (int n = 0; n < 2; ++n) cb[bj][n] = *(const f32x4*)(base + (size_t)row0 * 1024 + col0 + bj * HALF + n * 16);
#pragma unroll
        for (int it = 0; it < 8; ++it) {
            const int ai = it >> 2, m = it & 3;
            const int row = row0 + ai * HALF + m * 16;
            const size_t off = (size_t)row * 1024 + col0;
            f32x4 nb[2][2];
            if (it + 1 < 8) {
                const size_t off2 = (size_t)(row0 + ((it + 1) >> 2) * HALF + ((it + 1) & 3) * 16) * 1024 + col0;
#pragma unroll
                for (int bj = 0; bj < 2; ++bj)
#pragma unroll
                    for (int n = 0; n < 2; ++n) nb[bj][n] = *(const f32x4*)(base + off2 + bj * HALF + n * 16);
            }
            float sq = 0.f;
#pragma unroll
            for (int bj = 0; bj < 2; ++bj)
#pragma unroll
                for (int n = 0; n < 2; ++n) {
                    const f32x4 o = cb[bj][n] + acc[ai][bj][m][n];
                    *(f32x4*)(out + off + bj * HALF + n * 16) = o;
                    if (xn) { sq += (o[0] * o[0] + o[1] * o[1]) + (o[2] * o[2] + o[3] * o[3]); const f32x4 og = o * gv[bj][n];
                        ::u32x2 w; w.x = cvt_pk_bf16(og[0], og[1]); w.y = cvt_pk_bf16(og[2], og[3]); *(::u32x2*)(xn + off + bj * HALF + n * 16) = w; }
                }
            if (xn) { sq += __shfl_xor(sq, 16); sq += __shfl_xor(sq, 32); if (fq == 0) atomicAdd(ss + row, sq); }
            asm volatile("" ::: "memory");
            if (it + 1 < 8) {
#pragma unroll
                for (int bj = 0; bj < 2; ++bj)
#pragma unroll
                    for (int n = 0; n < 2; ++n) cb[bj][n] = nb[bj][n];
            }
        }
    }
};
struct EpiRelu2 {
    static constexpr bool PERM = true, AFTER_DRAIN = false;
    bf16_t* O; const float* ss;
    __device__ __forceinline__ void operator()(const f32x4 (&acc)[2][2][4][2], const Unit& u, int wr, int wc, int fr, int fq) const {
        const int row0 = u.pm * BM + wr * 64 + fr, col0 = u.pn * BM + wc * 32 + 8 * fq;
#pragma unroll
        for (int ai = 0; ai < 2; ++ai)
#pragma unroll
            for (int m = 0; m < 4; ++m) {
                const size_t row = (size_t)(row0 + ai * HALF + m * 16);
                const float r2 = 1.f / (ss[row] * (1.f / 1024.f) + 1e-6f);
#pragma unroll
                for (int bj = 0; bj < 2; ++bj) {
                    f32x4 v0 = acc[ai][bj][m][0], v1 = acc[ai][bj][m][1];
#pragma unroll
                    for (int e = 0; e < 4; ++e) { const float a = fmaxf(v0[e], 0.f), b = fmaxf(v1[e], 0.f); v0[e] = a * a * r2; v1[e] = b * b * r2; }
                    ::u32x4 w; w.x = cvt_pk_bf16(v0[0], v0[1]); w.y = cvt_pk_bf16(v0[2], v0[3]); w.z = cvt_pk_bf16(v1[0], v1[1]); w.w = cvt_pk_bf16(v1[2], v1[3]);
                    *(::u32x4*)(O + row * 4096 + col0 + bj * HALF) = w;
                }
            }
    }
};
}

DI void tr_item(const float* __restrict__ W, int K, int N, bf16_t* WT, LAS float* scr, int item, int lane, int nblk) {
    const int kb = item / nblk, nb = item % nblk, k0 = 64 * kb, n0 = 32 * nb;
    const int nn = n0 + (lane & 31);
    float v[32];
#pragma unroll
    for (int i = 0; i < 32; ++i) { const int kk = 2 * i + (lane >> 5); v[i] = (nn < N) ? W[(size_t)(k0 + kk) * N + nn] : 0.f; }
#pragma unroll
    for (int i = 0; i < 32; ++i) { const int kk = 2 * i + (lane >> 5); scr[kk * 33 + (lane & 31)] = v[i]; }
    asm volatile("s_waitcnt lgkmcnt(0)" ::: "memory");
    const int c = lane & 7;
#pragma unroll
    for (int j = 0; j < 4; ++j) { const int n = (lane >> 3) + 8 * j; const LAS float* s = scr + (8 * c) * 33 + n;
        u32x4 o; o.x = pk2(s[0 * 33], s[1 * 33]); o.y = pk2(s[2 * 33], s[3 * 33]); o.z = pk2(s[4 * 33], s[5 * 33]); o.w = pk2(s[6 * 33], s[7 * 33]);
        *(u32x4*)(WT + (size_t)(n0 + n) * K + k0 + 8 * c) = o; }
    asm volatile("s_waitcnt lgkmcnt(0)" ::: "memory");
}
DI void conv_mat(const float* W, int K, int N, int NP, bf16_t* WT, LAS float* scr, int gw, int NGW, int lane) {
    const int nblk = NP / 32, nit = (K / 64) * nblk;
    for (int it = gw; it < nit; it += NGW) tr_item(W, K, N, WT, scr, it, lane, nblk);
}
DI void rms_row(const float* x, const float* gain, bf16_t* o, int lane) {
    const f32x4* xr = (const f32x4*)x + lane; const f32x4* gr = (const f32x4*)gain + lane;
    f32x4 v[4]; float s = 0.f;
#pragma unroll
    for (int j = 0; j < 4; ++j) { v[j] = xr[64 * j]; s += (v[j].x * v[j].x + v[j].y * v[j].y) + (v[j].z * v[j].z + v[j].w * v[j].w); }
    const float rstd = rsqrtf(wave_sum(s) * (1.f / 1024.f) + 1e-6f);
    u32x2* op = (u32x2*)o + lane;
#pragma unroll
    for (int j = 0; j < 4; ++j) { const f32x4 g = gr[64 * j]; u32x2 w; w.x = pk2(v[j].x * rstd * g.x, v[j].y * rstd * g.y); w.y = pk2(v[j].z * rstd * g.z, v[j].w * rstd * g.w); op[64 * j] = w; }
}
DI void phase_conv(const Args& a, int l, LAS unsigned char* lds) {
    const int tid = otid(), wid = tid >> 6, lane = tid & 63;
    LAS float* scr = (LAS float*)(lds + wid * 16384);
    const int gw = blockIdx.x * 8 + wid, NGW = gridDim.x * 8;
    bf16_t* W = (bf16_t*)(a.ws + WS_W);
    conv_mat(a.in[I_WIN] + (size_t)l * 1024 * NPROJ, 1024, NPROJ, NPROJ_P, W + W_IN, scr, gw, NGW, lane);
    conv_mat(a.in[I_WUP] + (size_t)l * 1024 * 4096, 1024, 4096, 4096, W + W_UP, scr, gw, NGW, lane);
    conv_mat(a.in[I_WDOWN] + (size_t)l * 1024 * 4096, 4096, 1024, 1024, W + W_DOWN, scr, gw, NGW, lane);
    conv_mat(a.in[I_WOUT] + (size_t)l * 1024 * 1024, 1024, 1024, 1024, W + W_OUT, scr, gw, NGW, lane);
    conv_mat(a.in[I_WATTN] + (size_t)l * 512 * 1024, 512, 1024, 1024, W + W_A, scr, gw, NGW, lane);
    conv_mat(a.in[I_WRWKV] + (size_t)l * 512 * 1024, 512, 1024, 1024, W + W_B, scr, gw, NGW, lane);
    conv_mat(a.in[I_WLORA] + (size_t)l * 64 * 512, 64, 512, 512, W + W_WL, scr, gw, NGW, lane);
    conv_mat(a.in[I_ALORA] + (size_t)l * 64 * 512, 64, 512, 512, W + W_AL, scr, gw, NGW, lane);
    conv_mat(a.in[I_GLORA] + (size_t)l * 128 * 512, 128, 512, 512, W + W_GL, scr, gw, NGW, lane);
    for (int kv = 0; kv < 2; ++kv) {
        conv_mat(a.in[I_CMPW1] + (size_t)(l * 2 + kv) * 2048 * 128, 2048, 128, 128, W + W_C1 + kv * 262144, scr, gw, NGW, lane);
        conv_mat(a.in[I_CMPW2] + (size_t)(l * 2 + kv) * 128 * 64, 128, 64, 64, W + W_C2 + kv * 8192, scr, gw, NGW, lane);
    }
    float* biasp = (float*)(a.ws + WS_BIASP);
    for (int u = gw; u < 64; u += NGW) {
        const int kv = u >> 5, ng = (u >> 4) & 1, kp = u & 15, n = ng * 64 + lane;
        const float* pos = a.in[I_CMPPOS] + (size_t)(l * 2 + kv) * 2048; const float* w1 = a.in[I_CMPW1] + (size_t)(l * 2 + kv) * 2048 * 128;
        float acc8[8] = {0.f, 0.f, 0.f, 0.f, 0.f, 0.f, 0.f, 0.f};
#pragma unroll 2
        for (int k = kp * 128; k < kp * 128 + 128; k += 8) {
#pragma unroll
            for (int e = 0; e < 8; ++e) acc8[e] += pos[k + e] * w1[(size_t)(k + e) * 128 + n];
        }
        biasp[(kv * 16 + kp) * 128 + n] = ((acc8[0] + acc8[1]) + (acc8[2] + acc8[3])) + ((acc8[4] + acc8[5]) + (acc8[6] + acc8[7]));
    }
    if (l == 0) {
        float* ssz = (float*)(a.ws + WS_SS);
        for (int i = blockIdx.x * 512 + tid; i < 3 * M_TOK; i += gridDim.x * 512) ssz[i] = 0.f;
        bf16_t* U = (bf16_t*)(a.ws + WS_U);
        for (int m = gw; m < M_TOK; m += NGW) rms_row(a.in[I_X] + (size_t)m * DM, a.in[I_MIXNORM], U + (size_t)m * DM, lane);
    }
}
DI void phase_norm2(const Args& a, int l) {
    const int tid = otid(), wid = tid >> 6, lane = tid & 63;
    const int gw = blockIdx.x * 8 + wid, NGW = gridDim.x * 8;
    bf16_t* HN = (bf16_t*)(a.ws + WS_HN);
    for (int m = gw; m < M_TOK; m += NGW) rms_row(a.out + (size_t)m * DM, a.in[I_FFNNORM] + l * DM, HN + (size_t)m * DM, lane);
}

DI void lerp8(const bf16_t* cur, const bf16_t* prev, bool has_prev, const float* mu, float* o) {
    const u32x4 c = *(const u32x4*)cur; u32x4 p = {0u, 0u, 0u, 0u}; if (has_prev) p = *(const u32x4*)prev;
    float cf[8], pf[8]; unpack8(c, cf); unpack8(p, pf);
    const f32x4 m0 = *(const f32x4*)mu, m1 = *(const f32x4*)(mu + 4);
#pragma unroll
    for (int i = 0; i < 8; ++i) { const float m = i < 4 ? m0[i] : m1[i - 4]; o[i] = cf[i] + (pf[i] - cf[i]) * m; }
}
DI void rwkv_prep_item(const Args& a, int l, int item, LAS unsigned char* lds) {
    const int tid = otid(), wid = tid >> 6, lane = tid & 63;
    const int b = item >> 6, t0 = (item & 63) * 64;
    bf16_t* PROJ = (bf16_t*)(a.ws + WS_PROJ); bf16_t* PREP = (bf16_t*)(a.ws + WS_PREP); const bf16_t* W = (const bf16_t*)(a.ws + WS_W);
    LAS bf16_t* A_w = (LAS bf16_t*)lds; LAS bf16_t* A_a = (LAS bf16_t*)(lds + 9216);
    LAS bf16_t* a_s = (LAS bf16_t*)(lds + 18432); LAS bf16_t* omd_s = (LAS bf16_t*)(lds + 18432 + 65536);
    const float* mu = a.in[I_TOKMIX] + l * 1792;
    {
        const int token = tid >> 3, part = tid & 7; const size_t row = (size_t)b * SEQ + t0 + token; const bool hp = (t0 + token) > 0;
        float v[8];
        lerp8(PROJ + row * PP + C_WL + part * 8, PROJ + (row - 1) * PP + C_WL + part * 8, hp, mu + (C_WL - C_R) + part * 8, v);
#pragma unroll
        for (int i = 0; i < 8; ++i) v[i] = tanh_fast(v[i]);
        *(LAS u32x4*)(A_w + token * 72 + part * 8) = pack8(v);
        lerp8(PROJ + row * PP + C_AL + part * 8, PROJ + (row - 1) * PP + C_AL + part * 8, hp, mu + (C_AL - C_R) + part * 8, v);
        *(LAS u32x4*)(A_a + token * 72 + part * 8) = pack8(v);
    }
    __syncthreads();
#pragma unroll 1
    for (int which = 0; which < 2; ++which) {
        f32x4 acc[4][4];
#pragma unroll
        for (int m = 0; m < 4; ++m)
#pragma unroll
            for (int n = 0; n < 4; ++n) acc[m][n] = (f32x4){0.f, 0.f, 0.f, 0.f};
        const int fr = lane & 15, fq = lane >> 4;
        const LAS bf16_t* As = which ? A_a : A_w; const bf16_t* Bw = W + (which ? W_AL : W_WL);
#pragma unroll
        for (int ks = 0; ks < 2; ++ks) {
            bf16x8 af[4];
#pragma unroll
            for (int m = 0; m < 4; ++m) af[m] = *(const LAS bf16x8*)(As + (m * 16 + fr) * 72 + ks * 32 + fq * 8);
#pragma unroll
            for (int n = 0; n < 4; ++n) {
                const bf16x8 bfr = *(const bf16x8*)(Bw + (size_t)(wid * 64 + n * 16 + fr) * 64 + ks * 32 + fq * 8);
#pragma unroll
                for (int m = 0; m < 4; ++m) acc[m][n] = MFMA16(af[m], bfr, acc[m][n]);
            }
        }
        LAS bf16_t* dst = which ? a_s : omd_s;
#pragma unroll
        for (int n = 0; n < 4; ++n) {
            const int c = wid * 64 + n * 16 + fr; const float c0 = a.in[which ? I_A0 : I_W0][l * 512 + c];
#pragma unroll
            for (int m = 0; m < 4; ++m)
#pragma unroll
                for (int r = 0; r < 4; ++r) {
                    const int token = m * 16 + fq * 4 + r;
                    float res;
                    if (which) res = sigm(c0 + acc[m][n][r]);
                    else {
                        const float x = -(c0 + acc[m][n][r]);
                        const float ew = 0.60653065971f * __builtin_amdgcn_rcpf(1.f + __expf(x));
                        res = ew > 0.03f ? 1.f - __expf(-ew) : ew * (1.f - ew * (0.5f - ew * (1.f / 6.f)));
                    }
                    dst[token * 512 + c] = tobf(res);
                }
        }
    }
    __syncthreads();
    {
        const int cgp = tid & 63, head = cgp >> 3, k0 = (cgp & 7) * 8, c = cgp * 8;
        float mur[8], muk[8], muv[8], kkp[8], kap[8];
        {
            const float* srcs[5] = {mu + c, mu + 512 + c, mu + 1024 + c, a.in[I_KK] + l * 512 + c, a.in[I_KA] + l * 512 + c};
            float* dsts[5] = {mur, muk, muv, kkp, kap};
#pragma unroll
            for (int q = 0; q < 5; ++q) { const f32x4 t0 = *(const f32x4*)srcs[q], t1 = *(const f32x4*)(srcs[q] + 4);
#pragma unroll
                for (int i = 0; i < 4; ++i) { dsts[q][i] = t0[i]; dsts[q][4 + i] = t1[i]; } }
        }
        u32x4 raw[6];
        auto load_unit = [&](int u) {
            const int token = u * 8 + (tid >> 6); const size_t row = (size_t)b * SEQ + t0 + token; const bool hp = (t0 + token) > 0;
            const u32x4 z = {0u, 0u, 0u, 0u};
            raw[0] = *(const u32x4*)(PROJ + row * PP + C_R + c); raw[1] = hp ? *(const u32x4*)(PROJ + (row - 1) * PP + C_R + c) : z;
            raw[2] = *(const u32x4*)(PROJ + row * PP + C_K + c); raw[3] = hp ? *(const u32x4*)(PROJ + (row - 1) * PP + C_K + c) : z;
            raw[4] = *(const u32x4*)(PROJ + row * PP + C_V + c); raw[5] = hp ? *(const u32x4*)(PROJ + (row - 1) * PP + C_V + c) : z;
        };
        load_unit(0);
#pragma unroll 1
        for (int u = 0; u < 8; ++u) {
            const int token = u * 8 + (tid >> 6);
            float r[8], k[8], v[8], av[8], od[8];
            {
                float cf[8], pf[8];
                unpack8(raw[0], cf); unpack8(raw[1], pf);
#pragma unroll
                for (int i = 0; i < 8; ++i) r[i] = cf[i] + (pf[i] - cf[i]) * mur[i];
                unpack8(raw[2], cf); unpack8(raw[3], pf);
#pragma unroll
                for (int i = 0; i < 8; ++i) k[i] = cf[i] + (pf[i] - cf[i]) * muk[i];
                unpack8(raw[4], cf); unpack8(raw[5], pf);
#pragma unroll
                for (int i = 0; i < 8; ++i) v[i] = cf[i] + (pf[i] - cf[i]) * muv[i];
            }
            if (u + 1 < 8) load_unit(u + 1);
            unpack8(*(const LAS u32x4*)(a_s + token * 512 + c), av); unpack8(*(const LAS u32x4*)(omd_s + token * 512 + c), od);
            float kk[8], bb[8], kp[8]; float ss = 0.f;
#pragma unroll
            for (int i = 0; i < 8; ++i) { kk[i] = k[i] * kkp[i]; ss += kk[i] * kk[i]; }
            ss = red8(ss);
            const float rn = rsqrtf(fmaxf(ss, 1e-24f));
#pragma unroll
            for (int i = 0; i < 8; ++i) { kk[i] *= rn; bb[i] = kk[i] * av[i]; kp[i] = k[i] * (1.f + (av[i] - 1.f) * kap[i]); }
            bf16_t* op = PREP + ((size_t)(b * 8 + head) * SEQ + t0 + token) * 384 + k0;
            *(u32x4*)(op) = pack8(r); *(u32x4*)(op + 64) = pack8(od); *(u32x4*)(op + 128) = pack8(kp); *(u32x4*)(op + 192) = pack8(kk); *(u32x4*)(op + 256) = pack8(bb); *(u32x4*)(op + 320) = pack8(v);
        }
    }
    __syncthreads();
}
DI void nsa_norm_item(const Args& a, int l, int item, LAS unsigned char* lds) {
    const int tid = otid();
    const int b = item >> 6, t0 = (item & 63) * 64;
    bf16_t* PROJ = (bf16_t*)(a.ws + WS_PROJ);
    LAS bf16_t* vt = (LAS bf16_t*)lds;
    const int token = tid >> 3, part = tid & 7, g = part >> 2, d0 = (part & 3) * 16;
    const size_t row = (size_t)b * SEQ + t0 + token;
#pragma unroll
    for (int var = 0; var < 2; ++var) {
        bf16_t* kp = PROJ + row * PP + (var ? C_KW : C_KS) + g * 64 + d0;
        float f[16]; unpack8(*(const u32x4*)kp, f); unpack8(*(const u32x4*)(kp + 8), f + 8);
        float ss = 0.f;
#pragma unroll
        for (int i = 0; i < 16; ++i) ss += f[i] * f[i];
        ss = red4(ss);
        const float rstd = rsqrtf(ss * (1.f / 64.f) + 1e-6f);
        const float* gn = a.in[I_KGAIN] + (l * 3 + 1 + var) * 64 + d0;
#pragma unroll
        for (int i = 0; i < 16; ++i) f[i] = f[i] * rstd * gn[i];
        *(u32x4*)kp = pack8(f); *(u32x4*)(kp + 8) = pack8(f + 8);
        const bf16_t* vp = PROJ + row * PP + (var ? C_VW : C_VS) + g * 64 + d0;
        const u32x4 v0 = *(const u32x4*)vp, v1 = *(const u32x4*)(vp + 8);
        const unsigned vw[8] = {v0.x, v0.y, v0.z, v0.w, v1.x, v1.y, v1.z, v1.w};
#pragma unroll
        for (int i = 0; i < 8; ++i) { vt[(var * 128 + g * 64 + d0 + 2 * i) * 72 + token] = (bf16_t)(vw[i] & 0xffffu); vt[(var * 128 + g * 64 + d0 + 2 * i + 1) * 72 + token] = (bf16_t)(vw[i] >> 16); }
    }
    __syncthreads();
#pragma unroll
    for (int u = 0; u < 4; ++u) {
        const int id = u * 512 + tid, var = id >> 10, rr = (id >> 3) & 127, seg = id & 7, gg = rr >> 6, d = rr & 63;
        bf16_t* dst = (bf16_t*)(a.ws + (var ? WS_VWT : WS_VST)) + ((size_t)(b * 2 + gg) * 64 + d) * SEQ + t0 + seg * 8;
        *(u32x4*)dst = *(const LAS u32x4*)(vt + (var * 128 + rr) * 72 + seg * 8);
    }
    __syncthreads();
}
DI float gelu_tanh(float x) { const float u = 0.7978845608f * (x + 0.044715f * x * x * x); return 0.5f * x * (1.f + tanh_fast(u)); }
DI void compress_item(const Args& a, int l, int item, LAS unsigned char* lds) {
    const int tid = otid(), wid = tid >> 6, lane = tid & 63, fr = lane & 15, fq = lane >> 4;
    const int kv = item >> 7, bg = (item >> 3) & 15, nq = item & 7, b = bg >> 1, g = bg & 1;
    const bf16_t* PROJ = (const bf16_t*)(a.ws + WS_PROJ); const bf16_t* W = (const bf16_t*)(a.ws + WS_W);
    LAS bf16_t* hs = (LAS bf16_t*)lds; LAS float* os = (LAS float*)(lds + 8704);
    const int colbase = (kv ? C_VC : C_KC) + g * 64;
    f32x4 acc[2];
#pragma unroll
    for (int m = 0; m < 2; ++m) acc[m] = (f32x4){0.f, 0.f, 0.f, 0.f};
    const bf16_t* w1 = W + W_C1 + (size_t)kv * 262144 + (size_t)(wid * 16 + fr) * 2048 + fq * 8;
    int tk0[2];
#pragma unroll
    for (int m = 0; m < 2; ++m) tk0[m] = 16 * (nq * 32 + m * 16 + fr);
#pragma unroll 1
    for (int k8 = 0; k8 < 64; k8 += 8) {
        bf16x8 bfr[8], af[8][2];
#pragma unroll
        for (int kk = 0; kk < 8; ++kk) {
            const int ks = k8 + kk, tokoff = ks >> 1, dcol = (ks & 1) * 32 + fq * 8;
            bfr[kk] = *(const bf16x8*)(w1 + ks * 32);
#pragma unroll
            for (int m = 0; m < 2; ++m) { int tk = tk0[m] + tokoff; tk = tk > SEQ - 1 ? SEQ - 1 : tk; af[kk][m] = *(const bf16x8*)(PROJ + ((size_t)b * SEQ + tk) * PP + colbase + dcol); }
        }
#pragma unroll
        for (int kk = 0; kk < 8; ++kk)
#pragma unroll
            for (int m = 0; m < 2; ++m) acc[m] = MFMA16(af[kk][m], bfr[kk], acc[m]);
    }
    {
        const int c = wid * 16 + fr; const float* biasp = (const float*)(a.ws + WS_BIASP) + kv * 16 * 128 + c;
        float bias = 0.f;
#pragma unroll
        for (int kp = 0; kp < 16; ++kp) bias += biasp[kp * 128];
#pragma unroll
        for (int m = 0; m < 2; ++m)
#pragma unroll
            for (int r = 0; r < 4; ++r) hs[(m * 16 + fq * 4 + r) * 136 + c] = tobf(gelu_tanh(acc[m][r] + bias));
    }
    __syncthreads();
    {
        const int m = wid >> 2, nt = wid & 3;
        f32x4 acc2 = {0.f, 0.f, 0.f, 0.f};
#pragma unroll
        for (int ks = 0; ks < 4; ++ks) {
            const bf16x8 af = *(const LAS bf16x8*)(hs + (m * 16 + fr) * 136 + ks * 32 + fq * 8);
            const bf16x8 bf = *(const bf16x8*)(W + W_C2 + (size_t)kv * 8192 + (size_t)(nt * 16 + fr) * 128 + ks * 32 + fq * 8);
            acc2 = MFMA16(af, bf, acc2);
        }
#pragma unroll
        for (int r = 0; r < 4; ++r) os[(m * 16 + fq * 4 + r) * 64 + nt * 16 + fr] = acc2[r];
    }
    __syncthreads();
    if (tid < 256) {
        const int rowi = tid >> 3, d0 = (tid & 7) * 8, n = nq * 32 + rowi;
        float v[8];
#pragma unroll
        for (int i = 0; i < 8; ++i) v[i] = os[rowi * 64 + d0 + i];
        if (kv == 0) {
            float ss = 0.f;
#pragma unroll
            for (int i = 0; i < 8; ++i) ss += v[i] * v[i];
            ss = red8(ss);
            const float rstd = rsqrtf(ss * (1.f / 64.f) + 1e-6f);
            const float* gn = a.in[I_KGAIN] + (l * 3 + 0) * 64 + d0;
#pragma unroll
            for (int i = 0; i < 8; ++i) v[i] = (n == 255) ? 0.f : v[i] * rstd * gn[i];
            *(u32x4*)((bf16_t*)(a.ws + WS_KCN) + ((size_t)bg * 256 + n) * 64 + d0) = pack8(v);
        } else {
            bf16_t* vct = (bf16_t*)(a.ws + WS_VCT) + (size_t)bg * 64 * 256;
#pragma unroll
            for (int i = 0; i < 8; ++i) vct[(d0 + i) * 256 + n] = tobf(n == 255 ? 0.f : v[i]);
        }
    }
    __syncthreads();
}
DI void phase_prep(const Args& a, int l, LAS unsigned char* lds) {
#ifdef DUPPREP
    for (int it = blockIdx.x; it < 768; it += gridDim.x) { if (it < 256) compress_item(a, l, it, lds); else rwkv_prep_item(a, l, it - 256, lds); }
#endif
    for (int it = blockIdx.x; it < 1280; it += gridDim.x) {
        if (it < 256) compress_item(a, l, it, lds);
        else if (it < 768) rwkv_prep_item(a, l, it - 256, lds);
        else nsa_norm_item(a, l, it - 768, lds);
    }
}

DI f32x2 red16p(f32x2 x) { x.x = red16(x.x); x.y = red16(x.y); return x; }
template <int RPL>
DI void scan_bh(const Args& a, int bh, int halfsel, LAS unsigned char* lds) {
    const int tid = otid(), wid = tid >> 6, lane = tid & 63, vq = lane >> 4, kq = lane & 15;
    const bf16_t* src = (const bf16_t*)(a.ws + WS_PREP) + (size_t)bh * SEQ * 384;
    bf16_t* PROJ = (bf16_t*)(a.ws + WS_PROJ);
    const int b = bh >> 3, h = bh & 7;
    constexpr int T = 32, CH = T * 384, NL = CH / 2048;
    LAS float* opbuf = (LAS float*)lds;
    LAS unsigned char* ybuf = lds + 2 * CH * 4;
    const int row0 = RPL == 2 ? halfsel * 32 + (wid & 3) * 8 + vq * 2 : halfsel * 32 + wid * 4 + vq;
    const bool active = RPL == 2 ? wid < 4 : true;
    f32x2 S[4];
#pragma unroll
    for (int j = 0; j < 4; ++j) S[j] = (f32x2){0.f, 0.f};
    u32x2 ld[NL]; bool isd[NL];
#pragma unroll
    for (int j = 0; j < NL; ++j) { isd[j] = (((tid * 4 + j * 2048) % 384) >> 6) == 1; ld[j] = *(const u32x2*)(src + tid * 4 + j * 2048); }
#pragma unroll
    for (int j = 0; j < NL; ++j) { f32x4 f = {bflo(ld[j].x), bfhi(ld[j].x), bflo(ld[j].y), bfhi(ld[j].y)}; if (isd[j]) f = 1.f - f; *(LAS f32x4*)(opbuf + tid * 4 + j * 2048) = f; }
    __syncthreads();
#pragma unroll 1
    for (int c = 0; c < SEQ / T; ++c) {
        if (c + 1 < SEQ / T) {
#pragma unroll
            for (int j = 0; j < NL; ++j) ld[j] = *(const u32x2*)(src + (size_t)(c + 1) * CH + tid * 4 + j * 2048);
        }
        const LAS float* cur = opbuf + (c & 1) * CH;
        LAS unsigned char* yb = ybuf + (c & 1) * (T * 128);
        f32x4 r4 = *(const LAS f32x4*)(cur + kq * 4), d4 = *(const LAS f32x4*)(cur + 64 + kq * 4), k4 = *(const LAS f32x4*)(cur + 128 + kq * 4),
              kk4 = *(const LAS f32x4*)(cur + 192 + kq * 4), b4 = *(const LAS f32x4*)(cur + 256 + kq * 4);
        f32x2 v2; if (RPL == 2) v2 = *(const LAS f32x2*)(cur + 320 + row0); else { v2.x = cur[320 + row0]; v2.y = 0.f; }
        if (active) {
#pragma unroll
        for (int st = 0; st < T; ++st) {
            f32x4 nr4, nd4, nk4, nkk4, nb4; f32x2 nv2;
            if (st < T - 1) {
                const LAS float* o = cur + (st + 1) * 384;
                nr4 = *(const LAS f32x4*)(o + kq * 4); nd4 = *(const LAS f32x4*)(o + 64 + kq * 4); nk4 = *(const LAS f32x4*)(o + 128 + kq * 4);
                nkk4 = *(const LAS f32x4*)(o + 192 + kq * 4); nb4 = *(const LAS f32x4*)(o + 256 + kq * 4);
                if (RPL == 2) nv2 = *(const LAS f32x2*)(o + 320 + row0); else { nv2.x = o[320 + row0]; nv2.y = 0.f; }
            }
            if (RPL == 2) {
                f32x2 sa = S[0] * kk4[0]; sa += S[1] * kk4[1]; f32x2 sb = S[2] * kk4[2]; sb += S[3] * kk4[3]; sa += sb;
                sa = red16p(sa); sa = -sa;
#pragma unroll
                for (int j = 0; j < 4; ++j) S[j] = S[j] * d4[j] + sa * b4[j] + v2 * k4[j];
                f32x2 y = S[0] * r4[0]; y += S[1] * r4[1]; f32x2 yc = S[2] * r4[2]; yc += S[3] * r4[3]; y += yc;
                y = red16p(y);
                *(LAS unsigned*)(yb + st * 128 + row0 * 2) = pk2(y.x, y.y);
            } else {
                const f32x2 kk01 = {kk4[0], kk4[1]}, kk23 = {kk4[2], kk4[3]}, d01 = {d4[0], d4[1]}, d23 = {d4[2], d4[3]}, b01 = {b4[0], b4[1]}, b23 = {b4[2], b4[3]},
                            k01 = {k4[0], k4[1]}, k23 = {k4[2], k4[3]}, r01 = {r4[0], r4[1]}, r23 = {r4[2], r4[3]};
                f32x2 sa2 = S[0] * kk01; sa2 += S[1] * kk23;
                const float sa = -red16(sa2.x + sa2.y);
                S[0] = S[0] * d01 + sa * b01 + v2.x * k01; S[1] = S[1] * d23 + sa * b23 + v2.x * k23;
                f32x2 y2 = S[0] * r01; y2 += S[1] * r23;
                const float y = red16(y2.x + y2.y);
                if (kq == 0) *(LAS bf16_t*)(yb + st * 128 + row0 * 2) = tobf(y);
            }
            if (st < T - 1) { r4 = nr4; d4 = nd4; k4 = nk4; kk4 = nkk4; b4 = nb4; v2 = nv2; }
        }
        }
        if (c + 1 < SEQ / T) {
            LAS float* nb = opbuf + ((c + 1) & 1) * CH;
#pragma unroll
            for (int j = 0; j < NL; ++j) { f32x4 f = {bflo(ld[j].x), bfhi(ld[j].x), bflo(ld[j].y), bfhi(ld[j].y)}; if (isd[j]) f = 1.f - f; *(LAS f32x4*)(nb + tid * 4 + j * 2048) = f; }
        }
        __syncthreads();
        { if (tid < T * 4) { const int rowi = tid >> 2, seg = tid & 3;
            *(u32x4*)(PROJ + ((size_t)b * SEQ + c * T + rowi) * PP + C_R + h * 64 + halfsel * 32 + seg * 8) = *(const LAS u32x4*)(yb + rowi * 128 + halfsel * 64 + seg * 16); } }
    }
    __syncthreads();
}

constexpr int AT_IMP = 0, AT_SEL = 65536, AT_LINV = 66048, AT_BUF = 67072, AT_BUFSZ = 18432, AT_VOFF = 9216;
struct AttnCtx {
    bf16x8 q[4]; int t, tw, qi, hi, tid; unsigned long long mymask; int ncv, ncvw, ncvmin; float inv; LAS float* impw; LAS unsigned char* lds; bool nocompute;
};
template <int BR>
DI void attn_branch(const AttnCtx& c, unsigned long long tmask, const bf16_t* kbase, size_t kpitch, const bf16_t* vbase, size_t vpitch, f32x16 (&o)[2], float& lsum) {
    if (tmask == 0ull) return;
    const int rowi = c.tid >> 3, seg = c.tid & 7;
    const bf16_t* kg = kbase + (size_t)rowi * kpitch + seg * 8;
    const bf16_t* vg = vbase + (size_t)rowi * vpitch + seg * 8;
    unsigned long long m = tmask;
    int j = __ffsll((long long)m) - 1; m &= m - 1;
    u32x4 kr = *(const u32x4*)(kg + (size_t)j * 64 * kpitch), vr;
    if (BR != 0) vr = *(const u32x4*)(vg + j * 64);
    int it = 0;
    for (;;) {
        LAS bf16_t* Ks = (LAS bf16_t*)(c.lds + AT_BUF + (it & 1) * AT_BUFSZ); LAS bf16_t* Vs = (LAS bf16_t*)(c.lds + AT_BUF + (it & 1) * AT_BUFSZ + AT_VOFF);
        *(LAS u32x4*)(Ks + rowi * 72 + seg * 8) = kr;
        if (BR != 0) { *(LAS u32x2*)(Vs + rowi * 68 + seg * 8) = (u32x2){vr.x, vr.y}; *(LAS u32x2*)(Vs + rowi * 68 + seg * 8 + 4) = (u32x2){vr.z, vr.w}; }
        __syncthreads();
        const int jc = j; const bool more = m != 0ull;
        if (more) { j = __ffsll((long long)m) - 1; m &= m - 1; kr = *(const u32x4*)(kg + (size_t)j * 64 * kpitch); if (BR != 0) vr = *(const u32x4*)(vg + j * 64); }
        bool mine = true;
        if (BR == 2) mine = (c.mymask >> jc) & 1ull;
        const bool wave_on = (BR == 2 ? (__ballot(mine) != 0ull) : true) && !c.nocompute;
        if (wave_on) {
            const float sbias = (BR == 2 && !mine) ? -1e30f : 0.f;
            bool interior;
            if (BR <= 1) interior = jc * 64 + 64 <= c.ncvmin;
            else if (BR == 2) interior = jc * 64 + 63 <= c.tw;
            else interior = (jc * 64 + 63 <= c.tw) && (jc * 64 > c.tw + 31 - 512);
            if (interior) {
                f32x16 s0, s1;
#pragma unroll
                for (int i = 0; i < 16; ++i) { s0[i] = sbias; s1[i] = sbias; }
#pragma unroll
                for (int st = 0; st < 4; ++st) {
                    const bf16x8 kf0 = *(const LAS bf16x8*)(Ks + c.qi * 72 + 16 * st + 8 * c.hi), kf1 = *(const LAS bf16x8*)(Ks + (32 + c.qi) * 72 + 16 * st + 8 * c.hi);
                    s0 = MFMA32(kf0, c.q[st], s0); s1 = MFMA32(kf1, c.q[st], s1);
                }
                float p0[16], p1[16];
#pragma unroll
                for (int i = 0; i < 16; ++i) { p0[i] = __builtin_amdgcn_exp2f(s0[i]); p1[i] = __builtin_amdgcn_exp2f(s1[i]); }
                {
                    float l0 = 0.f, l1 = 0.f;
#pragma unroll
                    for (int i = 0; i < 16; ++i) { l0 += p0[i]; l1 += p1[i]; }
                    lsum += l0 + l1;
                }
                if (BR == 1) {
#pragma unroll
                    for (int gq = 0; gq < 4; ++gq) {
                        const int jj = jc * 16 + gq * 2 + c.hi;
                        __hip_atomic_fetch_add(c.impw + jj, (p0[4 * gq] + p0[4 * gq + 1]) + (p0[4 * gq + 2] + p0[4 * gq + 3]), __ATOMIC_RELAXED, __HIP_MEMORY_SCOPE_WORKGROUP);
                        __hip_atomic_fetch_add(c.impw + jj + 1, p0[4 * gq + 3], __ATOMIC_RELAXED, __HIP_MEMORY_SCOPE_WORKGROUP);
                    }
#pragma unroll
                    for (int gq = 0; gq < 4; ++gq) {
                        const int jj = jc * 16 + 8 + gq * 2 + c.hi;
                        __hip_atomic_fetch_add(c.impw + jj, (p1[4 * gq] + p1[4 * gq + 1]) + (p1[4 * gq + 2] + p1[4 * gq + 3]), __ATOMIC_RELAXED, __HIP_MEMORY_SCOPE_WORKGROUP);
                        if (jj + 1 < 64) __hip_atomic_fetch_add(c.impw + jj + 1, p1[4 * gq + 3], __ATOMIC_RELAXED, __HIP_MEMORY_SCOPE_WORKGROUP);
                    }
                }
                if (BR != 0) {
                    unsigned pa[8], pb[8];
#pragma unroll
                    for (int i = 0; i < 8; ++i) { pa[i] = pk2(p0[2 * i], p0[2 * i + 1]); pb[i] = pk2(p1[2 * i], p1[2 * i + 1]); }
#pragma unroll
                    for (int f = 0; f < 2; ++f) {
                        const u32x4 bw0 = {pa[4 * f], pa[4 * f + 1], pa[4 * f + 2], pa[4 * f + 3]}, bw1 = {pb[4 * f], pb[4 * f + 1], pb[4 * f + 2], pb[4 * f + 3]};
#pragma unroll
                        for (int mt = 0; mt < 2; ++mt) {
                            const LAS bf16_t* vp = Vs + (mt * 32 + c.qi) * 68 + f * 16 + 4 * c.hi;
                            const u32x2 a0 = *(const LAS u32x2*)vp, a1 = *(const LAS u32x2*)(vp + 8), a2 = *(const LAS u32x2*)(vp + 32), a3 = *(const LAS u32x2*)(vp + 40);
                            const u32x4 aw0 = {a0.x, a0.y, a1.x, a1.y}, aw1 = {a2.x, a2.y, a3.x, a3.y};
                            o[mt] = MFMA32(__builtin_bit_cast(bf16x8, aw0), __builtin_bit_cast(bf16x8, bw0), o[mt]);
                            o[mt] = MFMA32(__builtin_bit_cast(bf16x8, aw1), __builtin_bit_cast(bf16x8, bw1), o[mt]);
                        }
                    }
                }
            } else {
#pragma unroll
            for (int sub = 0; sub < 2; ++sub) {
                const int key0 = jc * 64 + sub * 32;
                bool skip;
                if (BR <= 1) skip = key0 >= c.ncvw;
                else if (BR == 2) skip = key0 > c.tw + 31;
                else skip = (key0 + 31 < c.tw - 511) || (key0 > c.tw + 31);
                if (skip) continue;
                f32x16 s;
#pragma unroll
                for (int i = 0; i < 16; ++i) s[i] = sbias;
#pragma unroll
                for (int st = 0; st < 4; ++st) { const bf16x8 kf = *(const LAS bf16x8*)(Ks + (sub * 32 + c.qi) * 72 + 16 * st + 8 * c.hi); s = MFMA32(kf, c.q[st], s); }
                float p[16];
#pragma unroll
                for (int i = 0; i < 16; ++i) p[i] = __builtin_amdgcn_exp2f(s[i]);
                int lim;
                if (BR <= 1) lim = c.ncv - 1 - key0 - 4 * c.hi; else lim = c.t - key0 - 4 * c.hi;
#pragma unroll
                for (int i = 0; i < 16; ++i) { const int cst = (i & 3) + 8 * (i >> 2); bool valid = cst <= lim; if (BR == 3) valid = valid && (cst > lim - 512); p[i] = valid ? p[i] : 0.f; }
#pragma unroll
                for (int i = 0; i < 16; ++i) lsum += p[i];
                if (BR == 0) continue;
                if (BR == 1) {
#pragma unroll
                    for (int gq = 0; gq < 4; ++gq) {
                        const int jj = jc * 16 + sub * 8 + gq * 2 + c.hi;
                        __hip_atomic_fetch_add(c.impw + jj, (p[4 * gq] + p[4 * gq + 1]) + (p[4 * gq + 2] + p[4 * gq + 3]), __ATOMIC_RELAXED, __HIP_MEMORY_SCOPE_WORKGROUP);
                        if (jj + 1 < 64) __hip_atomic_fetch_add(c.impw + jj + 1, p[4 * gq + 3], __ATOMIC_RELAXED, __HIP_MEMORY_SCOPE_WORKGROUP);
                    }
                }
                unsigned pp[8];
#pragma unroll
                for (int i = 0; i < 8; ++i) pp[i] = pk2(p[2 * i], p[2 * i + 1]);
#pragma unroll
                for (int f = 0; f < 2; ++f) {
                    const u32x4 bw = {pp[4 * f], pp[4 * f + 1], pp[4 * f + 2], pp[4 * f + 3]};
                    const bf16x8 bfr = __builtin_bit_cast(bf16x8, bw);
#pragma unroll
                    for (int mt = 0; mt < 2; ++mt) {
                        const LAS bf16_t* vp = Vs + (mt * 32 + c.qi) * 68 + sub * 32 + f * 16 + 4 * c.hi;
                        const u32x2 a0 = *(const LAS u32x2*)vp, a1 = *(const LAS u32x2*)(vp + 8);
                        const u32x4 aw = {a0.x, a0.y, a1.x, a1.y};
                        o[mt] = MFMA32(__builtin_bit_cast(bf16x8, aw), bfr, o[mt]);
                    }
                }
            }
            }
        }
        if (!more) break;
        ++it;
    }
    __syncthreads();
}
DI void attn_item(const Args& a, int l, int item, LAS unsigned char* lds, bool dry = false) {
    const int tid = otid(), wid = tid >> 6, lane = tid & 63, qi = lane & 31, hi = lane >> 5;
    const int qb = item >> 4, bg = item & 15, b = bg >> 1, g = bg & 1;
    const int hh = wid >> 1, half = wid & 1, head = g * 4 + hh;
    const int t0 = qb * 64, tw = t0 + half * 32, t = tw + qi, tq = half * 32 + qi;
    bf16_t* PROJ = (bf16_t*)(a.ws + WS_PROJ);
    LAS float* imp = (LAS float*)(lds + AT_IMP);
    LAS unsigned long long* selm = (LAS unsigned long long*)(lds + AT_SEL);
    LAS float* linv = (LAS float*)(lds + AT_LINV);
    for (int i = tid; i < 16384; i += 512) imp[i] = 0.f;
    const size_t qrow = (size_t)b * SEQ + t;
    AttnCtx c; c.nocompute = false;
#ifdef DRY_NOCOMPUTE
    c.nocompute = dry;
#endif
    c.t = t; c.tw = tw; c.qi = qi; c.hi = hi; c.tid = tid; c.lds = lds; c.mymask = 0ull; c.inv = 0.f;
    c.ncv = t >= 31 ? (t - 15) >> 4 : 0; c.ncvw = (tw + 16) >> 4; c.ncvmin = tw >= 31 ? (tw - 15) >> 4 : 0; c.impw = imp + (hh * 64 + tq) * 64;
    {
        const bf16_t* qp = PROJ + qrow * PP + C_Q + head * 64 + 8 * hi;
        float qf[4][8]; float ss = 0.f;
#pragma unroll
        for (int st = 0; st < 4; ++st) { unpack8(*(const u32x4*)(qp + 16 * st), qf[st]);
#pragma unroll
            for (int j = 0; j < 8; ++j) ss += qf[st][j] * qf[st][j]; }
        ss += __shfl_xor(ss, 32);
        const float sc = rsqrtf(ss * (1.f / 64.f) + 1e-6f) * 0.125f * 1.4426950408889634f;
        const float* qg = a.in[I_QGAIN] + l * 64 + 8 * hi;
#pragma unroll
        for (int st = 0; st < 4; ++st) {
#pragma unroll
            for (int j = 0; j < 8; ++j) qf[st][j] *= sc * qg[16 * st + j];
            c.q[st] = __builtin_bit_cast(bf16x8, pack8(qf[st]));
        }
    }
    const float g_c = bf1(PROJ[qrow * PP + C_NG + head * 3 + 0]), g_s = bf1(PROJ[qrow * PP + C_NG + head * 3 + 1]), g_w = bf1(PROJ[qrow * PP + C_NG + head * 3 + 2]);
    f32x16 ot[2], ob[2];
#pragma unroll
    for (int i = 0; i < 16; ++i) { ot[0][i] = 0.f; ot[1][i] = 0.f; ob[0][i] = 0.f; ob[1][i] = 0.f; }
    __syncthreads();
    {
        const int ntc = (((t0 + 48) >> 4) + 63) >> 6;
        const unsigned long long cm = (1ull << ntc) - 1ull;
        const bf16_t* kc = (const bf16_t*)(a.ws + WS_KCN) + (size_t)bg * 256 * 64;
        const bf16_t* vct = (const bf16_t*)(a.ws + WS_VCT) + (size_t)bg * 64 * 256;
        float lsum = 0.f;
        attn_branch<1>(c, cm, kc, 64, vct, 256, ob, lsum);
        lsum += __shfl_xor(lsum, 32);
        const float inv = lsum > 0.f ? 1.f / lsum : 0.f;
        if (hi == 0) linv[hh * 64 + tq] = inv;
        const float sc = g_c * inv;
#pragma unroll
        for (int i = 0; i < 16; ++i) { ot[0][i] += ob[0][i] * sc; ot[1][i] += ob[1][i] * sc; ob[0][i] = 0.f; ob[1][i] = 0.f; }
    }
    __syncthreads();
    if (qb < 16) { if (lane < 8) selm[wid * 8 + lane] = (2ull << qb) - 1ull; }
    else
    for (int k = 0; k < 8; ++k) {
        const int tk = wid * 8 + k;
        float val = (imp[(0 * 64 + tk) * 64 + lane] * linv[tk] + imp[(1 * 64 + tk) * 64 + lane] * linv[64 + tk]) + (imp[(2 * 64 + tk) * 64 + lane] * linv[128 + tk] + imp[(3 * 64 + tk) * 64 + lane] * linv[192 + tk]);
        const bool causal = lane <= qb, forced = (lane == 0) || (lane == qb) || (lane == qb - 1);
        val = causal ? val + (forced ? 1000.f : 0.f) : -1.f;
        int rank = 0;
#pragma unroll
        for (int j = 0; j < 64; ++j) { const float vj = __builtin_bit_cast(float, __builtin_amdgcn_readlane(__builtin_bit_cast(int, val), j)); rank += (vj > val || (vj == val && j < lane)) ? 1 : 0; }
        const unsigned long long mk = __ballot(rank < 16 && causal);
        if (lane == 0) selm[tk] = mk;
    }
    __syncthreads();
    {
        c.mymask = selm[tq];
        const unsigned long long all = selm[lane];
        unsigned long long um = 0ull;
        for (int j = 0; j <= qb; ++j) if (__ballot((all >> j) & 1ull) != 0ull) um |= 1ull << j;
        float lsum = 0.f;
        attn_branch<2>(c, um, PROJ + (size_t)b * SEQ * PP + C_KS + g * 64, PP, (const bf16_t*)(a.ws + WS_VST) + (size_t)bg * 64 * SEQ, SEQ, ob, lsum);
        lsum += __shfl_xor(lsum, 32);
        const float sc = lsum > 0.f ? g_s / lsum : 0.f;
#pragma unroll
        for (int i = 0; i < 16; ++i) { ot[0][i] += ob[0][i] * sc; ot[1][i] += ob[1][i] * sc; ob[0][i] = 0.f; ob[1][i] = 0.f; }
    }
    {
        const int jlo = qb >= 8 ? qb - 8 : 0;
        const unsigned long long wm = ((qb == 63 ? ~0ull : ((1ull << (qb + 1)) - 1ull)) >> jlo) << jlo;
        float lsum = 0.f;
        attn_branch<3>(c, wm, PROJ + (size_t)b * SEQ * PP + C_KW + g * 64, PP, (const bf16_t*)(a.ws + WS_VWT) + (size_t)bg * 64 * SEQ, SEQ, ob, lsum);
        lsum += __shfl_xor(lsum, 32);
        const float sc = lsum > 0.f ? g_w / lsum : 0.f;
#pragma unroll
        for (int i = 0; i < 16; ++i) { ot[0][i] += ob[0][i] * sc; ot[1][i] += ob[1][i] * sc; }
    }
    if (!dry || a.ph_hi == 12345) {
        bf16_t* op = PROJ + qrow * PP + C_Q + head * 64 + 4 * hi;
#pragma unroll
        for (int mt = 0; mt < 2; ++mt)
#pragma unroll
            for (int gq = 0; gq < 4; ++gq) { u32x2 w; w.x = pk2(ot[mt][4 * gq], ot[mt][4 * gq + 1]); w.y = pk2(ot[mt][4 * gq + 2], ot[mt][4 * gq + 3]); *(u32x2*)(op + mt * 32 + gq * 8) = w; }
    }
    __syncthreads();
}
#ifndef SCAN_RPL
#define SCAN_RPL 2
#endif
DI void phase_mix(const Args& a, int l, LAS unsigned char* lds) {
    const int nscan = 128;
    if ((int)blockIdx.x < nscan) {
#ifdef DUPSCAN
        for (int rep = 0; rep < 2; ++rep)
#endif
        { scan_bh<SCAN_RPL>(a, blockIdx.x >> 1, blockIdx.x & 1, lds); }
        if (gridDim.x - nscan == 128) { const int sb = blockIdx.x, xcd = sb & 7, slot = sb >> 3; attn_item(a, l, slot * 16 + 2 * xcd, lds); }
    } else { const int na = gridDim.x - nscan;
#ifdef DUPATTN
        for (int it = blockIdx.x - nscan; it < 1024; it += na) attn_item(a, l, it, lds, true);
#endif
        if (na == 128) {
            const int ab = blockIdx.x - nscan, xcd = ab & 7, slot = ab >> 3;
            for (int r = 0; r < 8; ++r) {
                const int bg = 2 * xcd + (r >> 2), rr = r & 3;
                const int qb = rr == 0 ? 63 - slot : rr == 1 ? slot : rr == 2 ? 47 - slot : 16 + slot;
                if (r == 1) continue;
                attn_item(a, l, qb * 16 + bg, lds);
            }
        } else { for (int it = blockIdx.x - nscan; it < 1024; it += na) attn_item(a, l, it, lds); } }
}

DI void post_item(const Args& a, int l, int item, LAS unsigned char* lds) {
    const int tid = otid(), wid = tid >> 6, lane = tid & 63, fr = lane & 15, fq = lane >> 4;
    const int b = item >> 6, t0 = (item & 63) * 64;
    bf16_t* PROJ = (bf16_t*)(a.ws + WS_PROJ); const bf16_t* PREP = (const bf16_t*)(a.ws + WS_PREP); const bf16_t* W = (const bf16_t*)(a.ws + WS_W);
    LAS bf16_t* A_g = (LAS bf16_t*)lds; LAS bf16_t* z_s = (LAS bf16_t*)(lds + 17408);
    const float* mu = a.in[I_TOKMIX] + l * 1792;
    {
        const int token = tid >> 3, part = tid & 7; const size_t row = (size_t)b * SEQ + t0 + token; const bool hp = (t0 + token) > 0;
#pragma unroll
        for (int hf = 0; hf < 2; ++hf) {
            float v[8]; const int cc = part * 16 + hf * 8;
            lerp8(PROJ + row * PP + C_GL + cc, PROJ + (row - 1) * PP + C_GL + cc, hp, mu + (C_GL - C_R) + cc, v);
#pragma unroll
            for (int i = 0; i < 8; ++i) v[i] = sigm(v[i]);
            *(LAS u32x4*)(A_g + token * 136 + cc) = pack8(v);
        }
    }
    {
        const int cgp = tid & 63, head = cgp >> 3, k0 = (cgp & 7) * 8, c = cgp * 8;
        float rk[8], lw[8], lb[8];
        {
            const float* srcs[3] = {a.in[I_RK] + l * 512 + c, a.in[I_LNW] + l * 512 + c, a.in[I_LNB] + l * 512 + c};
            float* dsts[3] = {rk, lw, lb};
#pragma unroll
            for (int q = 0; q < 3; ++q) { const f32x4 t0v = *(const f32x4*)srcs[q], t1v = *(const f32x4*)(srcs[q] + 4);
#pragma unroll
                for (int i = 0; i < 4; ++i) { dsts[q][i] = t0v[i]; dsts[q][4 + i] = t1v[i]; } }
        }
        u32x4 raw[4];
        auto load_unit = [&](int u) {
            const int token = u * 8 + (tid >> 6); const size_t row = (size_t)b * SEQ + t0 + token;
            raw[0] = *(const u32x4*)(PROJ + row * PP + C_R + c);
            const bf16_t* ip = PREP + ((size_t)(b * 8 + head) * SEQ + t0 + token) * 384 + k0;
            raw[1] = *(const u32x4*)ip; raw[2] = *(const u32x4*)(ip + 128); raw[3] = *(const u32x4*)(ip + 320);
        };
        load_unit(0);
#pragma unroll 1
        for (int u = 0; u < 8; ++u) {
            const int token = u * 8 + (tid >> 6);
            float y[8], r[8], k[8], v[8];
            unpack8(raw[0], y); unpack8(raw[1], r); unpack8(raw[2], k); unpack8(raw[3], v);
            if (u + 1 < 8) load_unit(u + 1);
            float sm = 0.f;
#pragma unroll
            for (int i = 0; i < 8; ++i) sm += y[i];
            const float mean = red8(sm) * (1.f / 64.f);
            float sv = 0.f;
#pragma unroll
            for (int i = 0; i < 8; ++i) { y[i] -= mean; sv += y[i] * y[i]; }
            const float rstd = rsqrtf(red8(sv) * (1.f / 64.f) + 64e-5f);
            float dot = 0.f;
#pragma unroll
            for (int i = 0; i < 8; ++i) dot += r[i] * k[i] * rk[i];
            dot = red8(dot);
            float z[8];
#pragma unroll
            for (int i = 0; i < 8; ++i) z[i] = y[i] * rstd * lw[i] + lb[i] + dot * v[i];
            *(LAS u32x4*)(z_s + token * 512 + c) = pack8(z);
        }
    }
    __syncthreads();
    {
        f32x4 acc[4][4];
#pragma unroll
        for (int m = 0; m < 4; ++m)
#pragma unroll
            for (int n = 0; n < 4; ++n) acc[m][n] = (f32x4){0.f, 0.f, 0.f, 0.f};
#pragma unroll
        for (int ks = 0; ks < 4; ++ks) {
            bf16x8 ag[4];
#pragma unroll
            for (int m = 0; m < 4; ++m) ag[m] = *(const LAS bf16x8*)(A_g + (m * 16 + fr) * 136 + ks * 32 + fq * 8);
#pragma unroll
            for (int n = 0; n < 4; ++n) {
                const bf16x8 bgf = *(const bf16x8*)(W + W_GL + (size_t)(wid * 64 + n * 16 + fr) * 128 + ks * 32 + fq * 8);
#pragma unroll
                for (int m = 0; m < 4; ++m) acc[m][n] = MFMA16(ag[m], bgf, acc[m][n]);
            }
        }
#pragma unroll
        for (int m = 0; m < 4; ++m)
#pragma unroll
            for (int n = 0; n < 4; ++n)
#pragma unroll
                for (int r = 0; r < 4; ++r) { const int idx = (m * 16 + fq * 4 + r) * 512 + wid * 64 + n * 16 + fr; z_s[idx] = tobf(bf1(z_s[idx]) * acc[m][n][r]); }
    }
    __syncthreads();
#pragma unroll
    for (int u = 0; u < 8; ++u) {
        const int id = u * 512 + tid, token = id >> 6, cgp = id & 63;
        *(u32x4*)(PROJ + ((size_t)b * SEQ + t0 + token) * PP + C_R + cgp * 8) = *(const LAS u32x4*)(z_s + token * 512 + cgp * 8);
    }
    __syncthreads();
}

#ifndef PHMASK
#define PHMASK 0x3ff
#endif
#define PHEN(k) ((PHMASK >> (k)) & 1)
__global__ void __launch_bounds__(512, 2) fwd_kernel(Args a) {
    extern __shared__ __attribute__((aligned(16))) unsigned char lds_raw[];
    LAS unsigned char* lds = (LAS unsigned char*)lds_raw;
    cg::grid_group grid = cg::this_grid();
    volatile LAS unsigned* xst = (volatile LAS unsigned*)(lds + LDS_BYTES - 16);
    if (threadIdx.x == 0) { xst[0] = 0u; xst[1] = 0u; }
    __syncthreads();
    const XcdBarrier xb = xcd_barrier_post((unsigned*)(a.ws + WS_BAR), xst);
#pragma unroll 1
    for (int ph = a.ph_lo; ph < a.ph_hi; ++ph) {
        const int l = ph / 10, p = ph % 10;
        if (p == 7) continue;
        if (ph > a.ph_lo) { if (a.ph_hi == 12345) grid.sync(); else xcd_barrier(xb); }
        { size_t z_ = 0; asm volatile("" : "+s"(z_)); a.ws = a.ws + z_; a.out = a.out + z_; }
        bf16_t* W = (bf16_t*)(a.ws + WS_W);
        bf16_t* PROJ = (bf16_t*)(a.ws + WS_PROJ);
#ifdef DUPMASK
        const int nrep = ((DUPMASK >> p) & 1) ? 2 : 1;
#else
        const int nrep = 1;
#endif
#pragma unroll 1
        for (int rep = 0; rep < nrep; ++rep) {
        if (rep) grid.sync();
        if (PHEN(0) && p == 0) { phase_conv(a, l, lds); __syncthreads(); }
        else if (PHEN(1) && p == 1) {
            pg8::Gemm g{(const bf16_t*)(a.ws + WS_U), W + W_IN, M_TOK, NPROJ_P, DM, DM}; pg8::StaticOrder S; S.init(M_TOK, NPROJ_P, gridDim.x, (int)blockIdx.x);
            pg8::EpiProj E{PROJ, (uint8_t*)(a.ws + WS_GATE), l == 0 ? nullptr : (const float*)(a.ws + WS_SS) + M_TOK};
            pg8::gemm_phase<pg8::EpiProj, pg8::StaticOrder, true, true>(lds, g, S, E);
        }
        else if (PHEN(2) && p == 2) phase_prep(a, l, lds);
        else if (PHEN(3) && p == 3) phase_mix(a, l, lds);
        else if (PHEN(4) && p == 4) { for (int it = blockIdx.x; it < 512; it += gridDim.x) post_item(a, l, it, lds); }
        else if (PHEN(5) && p == 5) {
            { pg8::Gemm g{PROJ + C_Q, W + W_A, M_TOK, DM, 512, PP}; pg8::StaticOrder S; S.init(M_TOK, DM, gridDim.x, (int)blockIdx.x);
              pg8::EpiMerge<false> E{(bf16_t*)(a.ws + WS_MERGED), (const uint8_t*)(a.ws + WS_GATE)};
              pg8::gemm_phase<pg8::EpiMerge<false>, pg8::StaticOrder, true, true>(lds, g, S, E); }
            { pg8::Gemm g{PROJ + C_R, W + W_B, M_TOK, DM, 512, PP}; pg8::StaticOrder S; S.init(M_TOK, DM, gridDim.x, (int)blockIdx.x);
              pg8::EpiMerge<true> E{(bf16_t*)(a.ws + WS_MERGED), (const uint8_t*)(a.ws + WS_GATE)};
              pg8::gemm_phase<pg8::EpiMerge<true>, pg8::StaticOrder, true, true>(lds, g, S, E); }
        }
        else if (PHEN(6) && p == 6) {
            pg8::Gemm g{(const bf16_t*)(a.ws + WS_MERGED), W + W_OUT, M_TOK, DM, DM, DM}; pg8::StaticOrder S; S.init(M_TOK, DM, gridDim.x, (int)blockIdx.x);
            pg8::EpiResF32 E{l == 0 ? a.in[I_X] : a.out, a.out, (bf16_t*)(a.ws + WS_HN), a.in[I_FFNNORM] + l * DM, (float*)(a.ws + WS_SS) + (l == 0 ? 0 : 2 * M_TOK)};
            pg8::gemm_phase<pg8::EpiResF32, pg8::StaticOrder, true, true>(lds, g, S, E);
        }
        else if (PHEN(7) && p == 7) phase_norm2(a, l);
        else if (PHEN(8) && p == 8) {
            pg8::Gemm g{(const bf16_t*)(a.ws + WS_HN), W + W_UP, M_TOK, 4096, DM, DM}; pg8::StaticOrder S; S.init(M_TOK, 4096, gridDim.x, (int)blockIdx.x);
            pg8::EpiRelu2 E{(bf16_t*)(a.ws + WS_H), (const float*)(a.ws + WS_SS) + (l == 0 ? 0 : 2 * M_TOK)};
            pg8::gemm_phase<pg8::EpiRelu2, pg8::StaticOrder, true, true>(lds, g, S, E);
        }
        else if (PHEN(9)) {
            pg8::Gemm g{(const bf16_t*)(a.ws + WS_H), W + W_DOWN, M_TOK, DM, 4096, 4096}; pg8::StaticOrder S; S.init(M_TOK, DM, gridDim.x, (int)blockIdx.x);
            pg8::EpiResF32 E{a.out, a.out, l == 0 ? (bf16_t*)(a.ws + WS_U) : nullptr, a.in[I_MIXNORM] + DM, (float*)(a.ws + WS_SS) + M_TOK};
            pg8::gemm_phase<pg8::EpiResF32, pg8::StaticOrder, true, true>(lds, g, S, E);
        }
        }
    }
}

#ifndef N_PHASE_LAUNCH
#define N_PHASE_LAUNCH 20
#endif
extern "C" void kernel_launch(void* const* d_in, const int* in_sizes, int n_in, void* d_out, int out_size, void* d_ws, size_t ws_size, hipStream_t stream) {
    static int grid = 0;
    if (grid == 0) {
        int dev = 0, cus = 0, per_cu = 0;
        (void)hipGetDevice(&dev);
        (void)hipDeviceGetAttribute(&cus, hipDeviceAttributeMultiprocessorCount, dev);
        if (hipFuncSetAttribute((const void*)fwd_kernel, hipFuncAttributeMaxDynamicSharedMemorySize, LDS_BYTES) != hipSuccess) { fprintf(stderr, "hipFuncSetAttribute failed\n"); grid = -1; return; }
        (void)hipOccupancyMaxActiveBlocksPerMultiprocessor(&per_cu, (const void*)fwd_kernel, 512, LDS_BYTES);
        if (per_cu < 1) { fprintf(stderr, "occupancy query says %d blocks per CU\n", per_cu); per_cu = 1; }
        (void)hipGetLastError();
        grid = cus;
        if (ws_size < 502 * MiB) { fprintf(stderr, "workspace too small: %zu\n", ws_size); grid = -1; return; }
    }
    if (grid < 0) return;
    if (hipMemsetAsync((char*)d_ws + WS_BAR, 0, XCD_BAR_WORDS * 4, stream) != hipSuccess) { fprintf(stderr, "memset of the barrier words failed\n"); return; }
    Args a{};
    for (int i = 0; i < 25; ++i) a.in[i] = (const float*)d_in[i];
    a.out = (float*)d_out; a.ws = (unsigned char*)d_ws;
    for (int lo = 0; lo < 20; lo += N_PHASE_LAUNCH) {
        a.ph_lo = lo; a.ph_hi = lo + N_PHASE_LAUNCH > 20 ? 20 : lo + N_PHASE_LAUNCH;
        void* args[] = {&a};
        hipError_t e;
        if (N_PHASE_LAUNCH > 1) e = hipLaunchCooperativeKernel((const void*)fwd_kernel, dim3(grid), dim3(512), args, LDS_BYTES, stream);
        else e = hipLaunchKernel((const void*)fwd_kernel, dim3(grid), dim3(512), args, LDS_BYTES, stream);
        if (e != hipSuccess) { fprintf(stderr, "launch failed: %s\n", hipGetErrorString(e)); break; }
    }
}
```

```cpp
#include <hip/hip_runtime.h>
#include <hip/hip_cooperative_groups.h>
#include <cstdio>
#include <cstdint>
namespace cg = cooperative_groups;
namespace pg8 {
#define PG8_LAS __attribute__((address_space(3)))
typedef unsigned short bf16_t;
typedef short bf16x8 __attribute__((ext_vector_type(8)));
typedef float f32x4 __attribute__((ext_vector_type(4)));
typedef unsigned u32x4 __attribute__((ext_vector_type(4)));
constexpr int BM = 256, BK = 64, HALF = 128, HTB = HALF * BK * 2  , STAGE_BYTES = 8 * HTB, NXCD = 8, WGM = 8;

__host__ __device__ __forceinline__ int lds_byte(int r, int c) { const int st = (r >> 4) * 2 + (c >> 5), rr = r & 15, cc = c & 31, ob = rr * 64 + cc * 2; return st * 1024 + (ob ^ (((ob >> 9) & 1) << 5)); }
__host__ __device__ __forceinline__ void stage_rc(int b, int& R, int& C) { const int st = b / 1024, sb = b % 1024, swz = sb ^ (((sb >> 9) & 1) << 5); R = (st >> 1) * 16 + swz / 64; C = (st & 1) * 32 + (swz % 64) / 2; }
__host__ __device__ __forceinline__ int perm32(int rho) { const int n = rho >> 4, i = rho & 15; return 8 * (i >> 2) + 4 * n + (i & 3); }

struct Unit { int pm, pn; };
struct Gemm { const bf16_t* A; const bf16_t* Bt; int M, N, K, lda; };

struct StaticOrder {
    int nM, nN, nwg, G, c;
    __host__ __device__ void init(int M, int N, int G_, int c_) { nM = M / BM; nN = N / BM; nwg = nM * nN; G = G_; c = c_; }
    __host__ __device__ bool next(int i, Unit& u) const {
        const long L = (long)i * G + c; if (L >= nwg) return false;
        int wgid = (int)L; { const int q = nwg / NXCD, r = nwg % NXCD, xcd = wgid % NXCD, off = wgid / NXCD; wgid = (xcd < r ? xcd * (q + 1) : r * (q + 1) + (xcd - r) * q) + off; }
        const int nig = WGM * nN, gid = wgid / nig, fm = gid * WGM, gsz = (nM - fm) < WGM ? (nM - fm) : WGM;
        u.pm = fm + ((wgid % nig) % gsz); u.pn = (wgid % nig) / gsz; return true;
    }
    __device__ __forceinline__ void a_ready(const Unit&) const {}
    __device__ __forceinline__ void done(const Unit&) const {}
};
__device__ __forceinline__ unsigned cvt_pk_bf16(float lo, float hi) { unsigned r; asm volatile("v_cvt_pk_bf16_f32 %0, %1, %2" : "=v"(r) : "v"(lo), "v"(hi)); return r; }
template <class Epi, class Sched, bool ALIGN_EPI = false, bool SP2 = false>
__device__ __forceinline__ void gemm_phase(PG8_LAS unsigned char* lds, const Gemm g, const Sched& S, const Epi& E) {
    int tid_ = threadIdx.x; asm volatile("" : "+v"(tid_));
    const int tid = tid_, wid = __builtin_amdgcn_readfirstlane(tid >> 6), lane = tid & 63, wr = wid >> 2, wc = wid & 3, fr = lane & 15, fq = lane >> 4;
    const int K = g.K, nt = K / BK;
    unsigned voffA[2], voffB[2];
#pragma unroll
    for (int i = 0; i < 2; ++i) { int R, C; stage_rc(tid * 16 + i * 8192, R, C); const int Rb = Epi::PERM ? ((R & ~31) + perm32(R & 31)) : R;
        voffA[i] = (unsigned)(R * g.lda + C) * 2u; voffB[i] = (unsigned)(Rb * K + C) * 2u; }
    const size_t kstep = (size_t)(BK * 2);
    const size_t hstepB = (size_t)HALF * K * 2, hstepA = (size_t)HALF * g.lda * 2;
    const size_t tstepA = 2 * hstepA, tstepB = 2 * hstepB;
    const unsigned ldsw = (unsigned)wid * 1024u;
    const int aoff = lds_byte(wr * 64 + fr, fq * 8), boff = lds_byte(wc * 32 + fr, fq * 8);
#define PG8_SA(b, h) (((b) * 2 + (h)) * HTB)
#define PG8_SB(b, h) ((4 + (b) * 2 + (h)) * HTB)
#define PG8_STAGE(bufoff, gbase, voff) do { _Pragma("unroll") for (int _i = 0; _i < 2; ++_i) \
        __builtin_amdgcn_global_load_lds((const unsigned*)((const char*)(gbase) + (voff)[_i]), (PG8_LAS unsigned*)(lds + (bufoff) + ldsw + _i * 8192), 16, 0, 0); } while (0)
#define PG8_LDA(dst, b, h) do { _Pragma("unroll") for (int m = 0; m < 4; ++m) _Pragma("unroll") for (int k = 0; k < 2; ++k) dst[m][k] = *(const PG8_LAS bf16x8*)(lds + PG8_SA(b, h) + aoff + m * 2048 + k * 1024); } while (0)
#define PG8_LDB(dst, b, h) do { _Pragma("unroll") for (int n = 0; n < 2; ++n) _Pragma("unroll") for (int k = 0; k < 2; ++k) dst[n][k] = *(const PG8_LAS bf16x8*)(lds + PG8_SB(b, h) + boff + n * 2048 + k * 1024); } while (0)
#define PG8_MMA(ai, bj, At, Bt) do { __builtin_amdgcn_s_setprio(1); _Pragma("unroll") for (int m = 0; m < 4; ++m) _Pragma("unroll") for (int n = 0; n < 2; ++n) _Pragma("unroll") for (int k = 0; k < 2; ++k) \
        acc[ai][bj][m][n] = __builtin_amdgcn_mfma_f32_16x16x32_bf16(Bt[n][k], At[m][k], acc[ai][bj][m][n], 0, 0, 0); __builtin_amdgcn_s_setprio(0); } while (0)
#define PG8_WAIT_V(n) asm volatile("s_waitcnt vmcnt(" #n ")" ::: "memory")
#define PG8_WAIT_L(n) asm volatile("s_waitcnt lgkmcnt(" #n ")" ::: "memory")
#define PG8_BAR __builtin_amdgcn_s_barrier()
#define PG8_SCHED __builtin_amdgcn_sched_barrier(0)
    Unit cur, nxt; int ui = 0;
    if (!S.next(0, cur)) return;
    f32x4 acc[2][2][4][2];
#pragma unroll
    for (int a = 0; a < 2; ++a)
#pragma unroll
        for (int b = 0; b < 2; ++b)
#pragma unroll
            for (int m = 0; m < 4; ++m)
#pragma unroll
                for (int n = 0; n < 2; ++n) acc[a][b][m][n] = (f32x4){0.f, 0.f, 0.f, 0.f};
    bf16x8 At[4][2], B0[2][2], B1[2][2];
    const char* cA = (const char*)g.A + (size_t)cur.pm * tstepA; const char* cB = (const char*)g.Bt + (size_t)cur.pn * tstepB;
    S.a_ready(cur);
    if constexpr (SP2) {
        PG8_STAGE(PG8_SB(0, 0), cB, voffB); PG8_STAGE(PG8_SB(0, 1), cB + hstepB, voffB); PG8_STAGE(PG8_SA(0, 0), cA, voffA); PG8_STAGE(PG8_SA(0, 1), cA + hstepA, voffA);
        if (wr == 1) PG8_BAR;
        PG8_WAIT_V(2); PG8_BAR;
        PG8_STAGE(PG8_SB(1, 0), cB + kstep, voffB); PG8_STAGE(PG8_SA(1, 0), cA + kstep, voffA); PG8_STAGE(PG8_SB(1, 1), cB + hstepB + kstep, voffB);
        PG8_WAIT_V(6); PG8_BAR;
    } else {
        PG8_STAGE(PG8_SB(0, 0), cB, voffB); PG8_STAGE(PG8_SA(0, 0), cA, voffA); PG8_STAGE(PG8_SB(0, 1), cB + hstepB, voffB); PG8_STAGE(PG8_SA(0, 1), cA + hstepA, voffA);
        if (wr == 1) PG8_BAR;
        PG8_WAIT_V(4); PG8_BAR;
        PG8_STAGE(PG8_SB(1, 0), cB + kstep, voffB); PG8_STAGE(PG8_SA(1, 0), cA + kstep, voffA); PG8_STAGE(PG8_SB(1, 1), cB + hstepB + kstep, voffB);
        PG8_WAIT_V(6); PG8_BAR;
    }
    for (;;) {
        const bool has_next = S.next(ui + 1, nxt);
        const char* nA = has_next ? (const char*)g.A + (size_t)nxt.pm * tstepA : cA; const char* nB = has_next ? (const char*)g.Bt + (size_t)nxt.pn * tstepB : cB;
        for (int t = 0; t < nt; t += 2) {
            const bool last = (t == nt - 2);
            const char* a1 = cA + (size_t)(t + 1) * kstep;
            const char* a2 = last ? nA : cA + (size_t)(t + 2) * kstep; const char* b2 = last ? nB : cB + (size_t)(t + 2) * kstep;
            const char* a3 = a2 + kstep; const char* b3 = b2 + kstep;
            if (last && has_next) S.a_ready(nxt);
            if constexpr (SP2) {
            PG8_LDB(B0, 0, 0); PG8_LDB(B1, 0, 1); PG8_SCHED; PG8_LDA(At, 0, 0); PG8_STAGE(PG8_SA(1, 1), a1 + hstepA, voffA);
            PG8_WAIT_V(8); PG8_WAIT_L(0); PG8_BAR; PG8_MMA(0, 0, At, B0); PG8_MMA(0, 1, At, B1); PG8_BAR; PG8_SCHED;
            PG8_LDA(At, 0, 1); PG8_STAGE(PG8_SB(0, 0), b2, voffB); PG8_STAGE(PG8_SB(0, 1), b2 + hstepB, voffB); PG8_STAGE(PG8_SA(0, 0), a2, voffA);
            PG8_WAIT_V(8); PG8_WAIT_L(0); PG8_BAR; PG8_MMA(1, 0, At, B0); PG8_MMA(1, 1, At, B1); PG8_BAR; PG8_SCHED;
            PG8_LDB(B0, 1, 0); PG8_LDB(B1, 1, 1); PG8_SCHED; PG8_LDA(At, 1, 0); PG8_STAGE(PG8_SA(0, 1), a2 + hstepA, voffA);
            PG8_WAIT_V(8); PG8_WAIT_L(0); PG8_BAR; PG8_MMA(0, 0, At, B0); PG8_MMA(0, 1, At, B1); PG8_BAR; PG8_SCHED;
            PG8_LDA(At, 1, 1); PG8_STAGE(PG8_SB(1, 0), b3, voffB); PG8_STAGE(PG8_SB(1, 1), b3 + hstepB, voffB); PG8_STAGE(PG8_SA(1, 0), a3, voffA);
            PG8_WAIT_V(8); PG8_WAIT_L(0); PG8_BAR; PG8_MMA(1, 0, At, B0); PG8_MMA(1, 1, At, B1); PG8_BAR; PG8_SCHED;
            } else {
            PG8_LDB(B0, 0, 0); PG8_SCHED; PG8_LDA(At, 0, 0); PG8_STAGE(PG8_SA(1, 1), a1 + hstepA, voffA);
            PG8_WAIT_L(8); PG8_BAR; PG8_WAIT_L(0); PG8_MMA(0, 0, At, B0); PG8_BAR; PG8_SCHED;
            PG8_LDB(B1, 0, 1); PG8_STAGE(PG8_SB(0, 0), b2, voffB);
            PG8_BAR; PG8_WAIT_L(0); PG8_MMA(0, 1, At, B1); PG8_BAR;
            PG8_LDA(At, 0, 1); PG8_STAGE(PG8_SA(0, 0), a2, voffA);
            PG8_BAR; PG8_WAIT_L(0); PG8_MMA(1, 0, At, B0); PG8_BAR; PG8_SCHED;
            PG8_STAGE(PG8_SB(0, 1), b2 + hstepB, voffB);
            PG8_WAIT_V(6); PG8_BAR; PG8_MMA(1, 1, At, B1); PG8_BAR;
            PG8_LDB(B0, 1, 0); PG8_SCHED; PG8_LDA(At, 1, 0); PG8_STAGE(PG8_SA(0, 1), a2 + hstepA, voffA);
            PG8_WAIT_L(8); PG8_BAR; PG8_WAIT_L(0); PG8_MMA(0, 0, At, B0); PG8_BAR; PG8_SCHED;
            PG8_LDB(B1, 1, 1); PG8_STAGE(PG8_SB(1, 0), b3, voffB);
            PG8_BAR; PG8_WAIT_L(0); PG8_MMA(0, 1, At, B1); PG8_BAR;
            PG8_LDA(At, 1, 1); PG8_STAGE(PG8_SA(1, 0), a3, voffA);
            PG8_BAR; PG8_WAIT_L(0); PG8_MMA(1, 0, At, B0); PG8_BAR; PG8_SCHED;
            PG8_STAGE(PG8_SB(1, 1), b3 + hstepB, voffB);
            PG8_WAIT_V(6); PG8_BAR; PG8_MMA(1, 1, At, B1); PG8_BAR;
            }
        }
        if constexpr (ALIGN_EPI) { if (wr == 0) PG8_BAR; }
        if constexpr (!Epi::AFTER_DRAIN) { E(acc, cur, wr, wc, fr, fq); S.done(cur); }
        if (!has_next) break;
#pragma unroll
        for (int a = 0; a < 2; ++a)
#pragma unroll
            for (int b = 0; b < 2; ++b)
#pragma unroll
                for (int m = 0; m < 4; ++m)
#pragma unroll
                    for (int n = 0; n < 2; ++n) acc[a][b][m][n] = (f32x4){0.f, 0.f, 0.f, 0.f};
        cur = nxt; cA = nA; cB = nB; ++ui;
        if constexpr (ALIGN_EPI) { if (wr == 1) PG8_BAR; }
    }
    PG8_WAIT_V(0);
    if constexpr (!ALIGN_EPI) { if (wr == 0) PG8_BAR; }
    PG8_BAR;
    if constexpr (Epi::AFTER_DRAIN) { E.fused(acc, cur, wr, wc, fr, fq, lds, wid, lane); S.done(cur); }
#undef PG8_SA
#undef PG8_SB
#undef PG8_STAGE
#undef PG8_LDA
#undef PG8_LDB
#undef PG8_MMA
#undef PG8_WAIT_V
#undef PG8_WAIT_L
#undef PG8_BAR
#undef PG8_SCHED
}
}

#define LAS __attribute__((address_space(3)))
#define DI __device__ __forceinline__
typedef unsigned short bf16_t;
typedef short bf16x8 __attribute__((ext_vector_type(8)));
typedef float f32x4 __attribute__((ext_vector_type(4)));
typedef float f32x2 __attribute__((ext_vector_type(2)));
typedef float f32x16 __attribute__((ext_vector_type(16)));
typedef unsigned u32x4 __attribute__((ext_vector_type(4)));
typedef unsigned u32x2 __attribute__((ext_vector_type(2)));
typedef __bf16 bf2_t __attribute__((ext_vector_type(2)));

DI int otid() { int t = threadIdx.x; asm volatile("" : "+v"(t)); return t; }
DI unsigned pk2(float a, float b) { f32x2 v = {a, b}; bf2_t r = __builtin_convertvector(v, bf2_t); return __builtin_bit_cast(unsigned, r); }
DI float bflo(unsigned w) { return __uint_as_float(w << 16); }
DI float bfhi(unsigned w) { return __uint_as_float(w & 0xffff0000u); }
DI float bf1(bf16_t h) { return __uint_as_float(((unsigned)h) << 16); }
DI bf16_t tobf(float x) { return (bf16_t)(pk2(x, 0.f) & 0xffffu); }
DI float sigm(float x) { return __builtin_amdgcn_rcpf(1.f + __expf(-x)); }
DI float tanh_fast(float x) { return 1.f - 2.f * __builtin_amdgcn_rcpf(1.f + __expf(2.f * x)); }
DI void unpack8(const u32x4 w, float* f) { f[0] = bflo(w.x); f[1] = bfhi(w.x); f[2] = bflo(w.y); f[3] = bfhi(w.y); f[4] = bflo(w.z); f[5] = bfhi(w.z); f[6] = bflo(w.w); f[7] = bfhi(w.w); }
DI u32x4 pack8(const float* f) { u32x4 w; w.x = pk2(f[0], f[1]); w.y = pk2(f[2], f[3]); w.z = pk2(f[4], f[5]); w.w = pk2(f[6], f[7]); return w; }
template <int CTRL> DI float dpp_add(float x) { return x + __builtin_bit_cast(float, __builtin_amdgcn_update_dpp(0, __builtin_bit_cast(int, x), CTRL, 0xf, 0xf, true)); }
DI float red4(float x) { x = dpp_add<0xB1>(x); x = dpp_add<0x4E>(x); return x; }
DI float red8(float x) { x = red4(x); x = dpp_add<0x141>(x); return x; }
DI float red16(float x) { x = red8(x); x = dpp_add<0x140>(x); return x; }
DI float wave_sum(float v) {
#pragma unroll
    for (int o = 1; o < 64; o <<= 1) v += __shfl_xor(v, o);
    return v;
}
#define MFMA16(a, b, c) __builtin_amdgcn_mfma_f32_16x16x32_bf16((a), (b), (c), 0, 0, 0)
#define MFMA32(a, b, c) __builtin_amdgcn_mfma_f32_32x32x16_bf16((a), (b), (c), 0, 0, 0)

constexpr int M_TOK = 32768, DM = 1024, SEQ = 4096;
constexpr int PP = 3096;
constexpr int NPROJ = 5144, NPROJ_P = 5376;
constexpr int C_Q = 0, C_KC = 512, C_VC = 640, C_KS = 768, C_VS = 896, C_KW = 1024, C_VW = 1152, C_NG = 1280, C_R = 1304, C_K = 1816, C_V = 2328,
              C_WL = 2840, C_AL = 2904, C_GL = 2968, C_GA = 3096;
constexpr size_t MiB = 1u << 20;
constexpr size_t WS_BIASP = 0, WS_KCN = 64 * 1024, WS_VCT = WS_KCN + 512 * 1024, WS_SS = 2 * MiB, WS_BAR = 3 * MiB;
constexpr size_t WS_W = 4 * MiB, WS_PROJ = 36 * MiB, WS_GATE = 230 * MiB, WS_PREP = 294 * MiB, WS_VST = 486 * MiB, WS_VWT = 494 * MiB, WS_H = 36 * MiB;
constexpr size_t WS_U = WS_PREP, WS_MERGED = WS_PREP, WS_HN = WS_PREP + 64 * MiB;
constexpr size_t WS_Y = WS_PREP + 96 * MiB;
constexpr size_t W_IN = 0, W_A = 5505024, W_B = 6029312, W_OUT = 6553600, W_UP = 7602176, W_DOWN = 11796480, W_WL = 15990784, W_AL = 16023552, W_GL = 16056320,
                 W_C1 = 16121856, W_C2 = 16646144;
constexpr int LDS_BYTES = 155648;

struct Args { const float* in[25]; float* out; unsigned char* ws; int ph_lo, ph_hi; };
enum { I_X = 0, I_MIXNORM, I_WIN, I_QGAIN, I_KGAIN, I_CMPPOS, I_CMPW1, I_CMPW2, I_WATTN, I_TOKMIX, I_W0, I_WLORA, I_A0, I_ALORA, I_GLORA, I_KK, I_KA, I_RK, I_LNW, I_LNB,
       I_WRWKV, I_WOUT, I_FFNNORM, I_WUP, I_WDOWN };

#define XB_TMO      128
#define XB_XCNT(j)  (256  + 64 * (j))
#define XB_XSUB(j)  (1280 + 64 * (j))
#define XB_XGEN(j)  (2304 + 64 * (j))
#define XB_TOP      3328
#define XB_TOPGEN   3392
#define XCD_BAR_WORDS 3456
#define XB_SPIN_CAP (1u << 18)

__device__ __forceinline__ unsigned xb_ld(unsigned* p)              { return __hip_atomic_load(p, __ATOMIC_RELAXED, __HIP_MEMORY_SCOPE_AGENT); }
__device__ __forceinline__ unsigned xb_add(unsigned* p, unsigned v) { return __hip_atomic_fetch_add(p, v, __ATOMIC_RELAXED, __HIP_MEMORY_SCOPE_AGENT); }
__device__ __forceinline__ unsigned xb_xcc_id() { return (unsigned)__builtin_amdgcn_s_getreg((3 << 11) | 20) & 0xFu; }
#define XB_SPIN(cond, bar) do { unsigned _sp = 0; while (cond) { __builtin_amdgcn_s_sleep(1); \
    if ((++_sp & 255u) == 0u) { if (xb_ld(&(bar)[XB_TMO])) break; if (_sp > XB_SPIN_CAP) { atomicAdd(&(bar)[XB_TMO], 1u); break; } } } } while (0)

struct XcdBarrier {
    unsigned* bar; unsigned x;
    volatile LAS unsigned* st;
};

__device__ __forceinline__ XcdBarrier xcd_barrier_post(unsigned* bar, volatile LAS unsigned* st) {
    XcdBarrier b; b.bar = bar; b.x = xb_xcc_id(); b.st = st;
    if (threadIdx.x == 0) (void)xb_add(&bar[XB_XCNT(b.x)], 1u);
    return b;
}
__device__ __forceinline__ void xcd_barrier_complete(unsigned* bar, unsigned x, unsigned& nloc, unsigned& nx) {
    const unsigned G = gridDim.x * gridDim.y * gridDim.z;
    unsigned sum, cnt, mine, sp = 0u;
    for (;;) {
        sum = 0u; cnt = 0u; mine = 0u;
#pragma unroll
        for (unsigned j = 0; j < 16; ++j) { const unsigned c = xb_ld(&bar[XB_XCNT(j)]); sum += c; cnt += (c > 0u) ? 1u : 0u; mine = (j == x) ? c : mine; }
        if (sum == G) break;
        __builtin_amdgcn_s_sleep(1);
        if ((++sp & 255u) == 0u) { if (xb_ld(&bar[XB_TMO])) break; if (sp > XB_SPIN_CAP) { atomicAdd(&bar[XB_TMO], 1u); break; } }
    }
    nloc = mine > 0u ? mine : 1u; nx = cnt > 0u ? cnt : 1u;
}

__device__ __forceinline__ void xcd_barrier(const XcdBarrier& b) {
    asm volatile("s_waitcnt vmcnt(0)" ::: "memory");
    __syncthreads();
    if (threadIdx.x == 0) {
        unsigned* bar = b.bar;
        __builtin_amdgcn_s_waitcnt(0);
        unsigned nloc = b.st[0], nx = b.st[1];
        if (nloc == 0u) { xcd_barrier_complete(bar, b.x, nloc, nx); b.st[0] = nloc; b.st[1] = nx; }
        const unsigned old = xb_add(&bar[XB_XSUB(b.x)], 1u);
        const unsigned gen = old / nloc;
        if (old + 1u == (gen + 1u) * nloc) {
            __builtin_amdgcn_fence(__ATOMIC_RELEASE, "agent");
            asm volatile("s_waitcnt vmcnt(0)" ::: "memory");
            const unsigned og = xb_add(&bar[XB_TOP], 1u);
            const unsigned tg = og / nx;
            if (og + 1u == (tg + 1u) * nx) xb_add(&bar[XB_TOPGEN], 1u);
            else XB_SPIN(xb_ld(&bar[XB_TOPGEN]) == tg, bar);
            __builtin_amdgcn_fence(__ATOMIC_ACQUIRE, "agent");
            xb_add(&bar[XB_XGEN(b.x)], 1u);
            asm volatile("s_waitcnt vmcnt(0)" ::: "memory");
        } else {
            XB_SPIN(xb_ld(&bar[XB_XGEN(b.x)]) == gen, bar);
            __builtin_amdgcn_fence(__ATOMIC_ACQUIRE, "agent");
            asm volatile("s_waitcnt vmcnt(0)" ::: "memory");
        }
    }
    __syncthreads();
}

namespace pg8 {
struct EpiProj {
    static constexpr bool PERM = true, AFTER_DRAIN = false;
    bf16_t* P; uint8_t* G; const float* ss;
    __device__ __forceinline__ void operator()(const f32x4 (&acc)[2][2][4][2], const Unit& u, int wr, int wc, int fr, int fq) const {
        const int row0 = u.pm * BM + wr * 64 + fr, col0 = u.pn * BM + wc * 32 + 8 * fq;
#pragma unroll
        for (int ai = 0; ai < 2; ++ai)
#pragma unroll
            for (int m = 0; m < 4; ++m) {
                const size_t row = (size_t)(row0 + ai * HALF + m * 16);
                const float rs = ss ? rsqrtf(ss[row] * (1.f / 1024.f) + 1e-6f) : 1.f;
#pragma unroll
                for (int bj = 0; bj < 2; ++bj) {
                    const int col = col0 + bj * HALF;
                    f32x4 v0 = acc[ai][bj][m][0] * rs, v1 = acc[ai][bj][m][1] * rs;
                    if (col < C_GA) {
                        if (col >= C_NG && col < C_R) {
#pragma unroll
                            for (int e = 0; e < 4; ++e) { v0[e] = sigm(v0[e]); v1[e] = sigm(v1[e]); }
                        }
                        ::u32x4 w; w.x = cvt_pk_bf16(v0[0], v0[1]); w.y = cvt_pk_bf16(v0[2], v0[3]); w.z = cvt_pk_bf16(v1[0], v1[1]); w.w = cvt_pk_bf16(v1[2], v1[3]);
                        *(::u32x4*)(P + row * PP + col) = w;
                    } else if (col < NPROJ) {
                        unsigned q[8];
#pragma unroll
                        for (int e = 0; e < 4; ++e) { q[e] = (unsigned)__builtin_rintf(sigm(v0[e]) * 255.f); q[4 + e] = (unsigned)__builtin_rintf(sigm(v1[e]) * 255.f); }
                        ::u32x2 w; w.x = q[0] | (q[1] << 8) | (q[2] << 16) | (q[3] << 24); w.y = q[4] | (q[5] << 8) | (q[6] << 16) | (q[7] << 24);
                        *(::u32x2*)(G + row * 2048 + (col - C_GA)) = w;
                    }
                }
            }
    }
};
template <bool SECOND> struct EpiMerge {
    static constexpr bool PERM = true, AFTER_DRAIN = false;
    bf16_t* O; const uint8_t* G;
    __device__ __forceinline__ void operator()(const f32x4 (&acc)[2][2][4][2], const Unit& u, int wr, int wc, int fr, int fq) const {
        const int row0 = u.pm * BM + wr * 64 + fr, col0 = u.pn * BM + wc * 32 + 8 * fq;
#pragma unroll
        for (int ai = 0; ai < 2; ++ai)
#pragma unroll
            for (int m = 0; m < 4; ++m) {
                const size_t row = (size_t)(row0 + ai * HALF + m * 16);
#pragma unroll
                for (int bj = 0; bj < 2; ++bj) {
                    const int col = col0 + bj * HALF;
                    const ::u32x2 gq = *(const ::u32x2*)(G + row * 2048 + (SECOND ? 1024 : 0) + col);
                    float v[8];
#pragma unroll
                    for (int e = 0; e < 4; ++e) { v[e] = acc[ai][bj][m][0][e] * ((float)((gq.x >> (8 * e)) & 255u) * (1.f / 255.f)); v[4 + e] = acc[ai][bj][m][1][e] * ((float)((gq.y >> (8 * e)) & 255u) * (1.f / 255.f)); }
                    ::u32x4* op = (::u32x4*)(O + row * 1024 + col);
                    if (SECOND) { const ::u32x4 t = *op; float tf[8]; unpack8(t, tf);
#pragma unroll
                        for (int e = 0; e < 8; ++e) v[e] += tf[e]; }
                    *op = pack8(v);
                }
                asm volatile("" ::: "memory");
            }
    }
};
struct EpiResF32 {
    static constexpr bool PERM = false, AFTER_DRAIN = false;
    const float* base; float* out; bf16_t* xn; const float* gain; float* ss;
    __device__ __forceinline__ void operator()(const f32x4 (&acc)[2][2][4][2], const Unit& u, int wr, int wc, int fr, int fq) const {
        const int row0 = u.pm * BM + wr * 64 + fr, col0 = u.pn * BM + wc * 32 + 4 * fq;
        f32x4 gv[2][2];
        if (xn) {
#pragma unroll
            for (int bj = 0; bj < 2; ++bj)
#pragma unroll
                for (int n = 0; n < 2; ++n) gv[bj][n] = *(const f32x4*)(gain + col0 + bj * HALF + n * 16);
        }
#pragma unroll
        for (int ai = 0; ai < 2; ++ai)
#pragma unroll
            for (int m = 0; m < 4; ++m) {
                const int row = row0 + ai * HALF + m * 16;
                const size_t off = (size_t)row * 1024 + col0;
                float sq = 0.f;
#pragma unroll
                for (int bj = 0; bj < 2; ++bj)
#pragma unroll
                    for (int n = 0; n < 2; ++n) {
                        const f32x4 b = *(const f32x4*)(base + off + bj * HALF + n * 16); const f32x4 o = b + acc[ai][bj][m][n];
                        *(f32x4*)(out + off + bj * HALF + n * 16) = o;
                        if (xn) { sq += (o[0] * o[0] + o[1] * o[1]) + (o[2] * o[2] + o[3] * o[3]); const f32x4 og = o * gv[bj][n];
                            ::u32x2 w; w.x = cvt_pk_bf16(og[0], og[1]); w.y = cvt_pk_bf16(og[2], og[3]); *(::u32x2*)(xn + off + bj * HALF + n * 16) = w; }
                    }
                if (xn) { sq += __shfl_xor(sq, 16); sq += __shfl_xor(sq, 32); if (fq == 0) atomicAdd(ss + row, sq); }
                asm volatile("" ::: "memory");
            }
    }
};
struct EpiRelu2 {
    static constexpr bool PERM = true, AFTER_DRAIN = false;
    bf16_t* O; const float* ss;
    __device__ __forceinline__ void operator()(const f32x4 (&acc)[2][2][4][2], const Unit& u, int wr, int wc, int fr, int fq) const {
        const int row0 = u.pm * BM + wr * 64 + fr, col0 = u.pn * BM + wc * 32 + 8 * fq;
#pragma unroll
        for (int ai = 0; ai < 2; ++ai)
#pragma unroll
            for (int m = 0; m < 4; ++m) {
                const size_t row = (size_t)(row0 + ai * HALF + m * 16);
                const float r2 = 1.f / (ss[row] * (1.f / 1024.f) + 1e-6f);
#pragma unroll
                for (int bj = 0; bj < 2; ++bj) {
                    f32x4 v0 = acc[ai][bj][m][0], v1 = acc[ai][bj][m][1];
#pragma unroll
                    for (int e = 0; e < 4; ++e) { const float a = fmaxf(v0[e], 0.f), b = fmaxf(v1[e], 0.f); v0[e] = a * a * r2; v1[e] = b * b * r2; }
                    ::u32x4 w; w.x = cvt_pk_bf16(v0[0], v0[1]); w.y = cvt_pk_bf16(v0[2], v0[3]); w.z = cvt_pk_bf16(v1[0], v1[1]); w.w = cvt_pk_bf16(v1[2], v1[3]);
                    *(::u32x4*)(O + row * 4096 + col0 + bj * HALF) = w;
                }
            }
    }
};
}

DI void tr_item(const float* __restrict__ W, int K, int N, bf16_t* WT, LAS float* scr, int item, int lane, int nblk) {
    const int kb = item / nblk, nb = item % nblk, k0 = 64 * kb, n0 = 32 * nb;
    const int nn = n0 + (lane & 31);
    float v[32];
#pragma unroll
    for (int i = 0; i < 32; ++i) { const int kk = 2 * i + (lane >> 5); v[i] = (nn < N) ? W[(size_t)(k0 + kk) * N + nn] : 0.f; }
#pragma unroll
    for (int i = 0; i < 32; ++i) { const int kk = 2 * i + (lane >> 5); scr[kk * 33 + (lane & 31)] = v[i]; }
    asm volatile("s_waitcnt lgkmcnt(0)" ::: "memory");
    const int c = lane & 7;
#pragma unroll
    for (int j = 0; j < 4; ++j) { const int n = (lane >> 3) + 8 * j; const LAS float* s = scr + (8 * c) * 33 + n;
        u32x4 o; o.x = pk2(s[0 * 33], s[1 * 33]); o.y = pk2(s[2 * 33], s[3 * 33]); o.z = pk2(s[4 * 33], s[5 * 33]); o.w = pk2(s[6 * 33], s[7 * 33]);
        *(u32x4*)(WT + (size_t)(n0 + n) * K + k0 + 8 * c) = o; }
    asm volatile("s_waitcnt lgkmcnt(0)" ::: "memory");
}
DI void conv_mat(const float* W, int K, int N, int NP, bf16_t* WT, LAS float* scr, int gw, int NGW, int lane) {
    const int nblk = NP / 32, nit = (K / 64) * nblk;
    for (int it = gw; it < nit; it += NGW) tr_item(W, K, N, WT, scr, it, lane, nblk);
}
DI void rms_row(const float* x, const float* gain, bf16_t* o, int lane) {
    const f32x4* xr = (const f32x4*)x + lane; const f32x4* gr = (const f32x4*)gain + lane;
    f32x4 v[4]; float s = 0.f;
#pragma unroll
    for (int j = 0; j < 4; ++j) { v[j] = xr[64 * j]; s += (v[j].x * v[j].x + v[j].y * v[j].y) + (v[j].z * v[j].z + v[j].w * v[j].w); }
    const float rstd = rsqrtf(wave_sum(s) * (1.f / 1024.f) + 1e-6f);
    u32x2* op = (u32x2*)o + lane;
#pragma unroll
    for (int j = 0; j < 4; ++j) { const f32x4 g = gr[64 * j]; u32x2 w; w.x = pk2(v[j].x * rstd * g.x, v[j].y * rstd * g.y); w.y = pk2(v[j].z * rstd * g.z, v[j].w * rstd * g.w); op[64 * j] = w; }
}
DI void phase_conv(const Args& a, int l, LAS unsigned char* lds) {
    const int tid = otid(), wid = tid >> 6, lane = tid & 63;
    LAS float* scr = (LAS float*)(lds + wid * 16384);
    const int gw = blockIdx.x * 8 + wid, NGW = gridDim.x * 8;
    bf16_t* W = (bf16_t*)(a.ws + WS_W);
    conv_mat(a.in[I_WIN] + (size_t)l * 1024 * NPROJ, 1024, NPROJ, NPROJ_P, W + W_IN, scr, gw, NGW, lane);
    conv_mat(a.in[I_WUP] + (size_t)l * 1024 * 4096, 1024, 4096, 4096, W + W_UP, scr, gw, NGW, lane);
    conv_mat(a.in[I_WDOWN] + (size_t)l * 1024 * 4096, 4096, 1024, 1024, W + W_DOWN, scr, gw, NGW, lane);
    conv_mat(a.in[I_WOUT] + (size_t)l * 1024 * 1024, 1024, 1024, 1024, W + W_OUT, scr, gw, NGW, lane);
    conv_mat(a.in[I_WATTN] + (size_t)l * 512 * 1024, 512, 1024, 1024, W + W_A, scr, gw, NGW, lane);
    conv_mat(a.in[I_WRWKV] + (size_t)l * 512 * 1024, 512, 1024, 1024, W + W_B, scr, gw, NGW, lane);
    conv_mat(a.in[I_WLORA] + (size_t)l * 64 * 512, 64, 512, 512, W + W_WL, scr, gw, NGW, lane);
    conv_mat(a.in[I_ALORA] + (size_t)l * 64 * 512, 64, 512, 512, W + W_AL, scr, gw, NGW, lane);
    conv_mat(a.in[I_GLORA] + (size_t)l * 128 * 512, 128, 512, 512, W + W_GL, scr, gw, NGW, lane);
    for (int kv = 0; kv < 2; ++kv) {
        conv_mat(a.in[I_CMPW1] + (size_t)(l * 2 + kv) * 2048 * 128, 2048, 128, 128, W + W_C1 + kv * 262144, scr, gw, NGW, lane);
        conv_mat(a.in[I_CMPW2] + (size_t)(l * 2 + kv) * 128 * 64, 128, 64, 64, W + W_C2 + kv * 8192, scr, gw, NGW, lane);
    }
    float* biasp = (float*)(a.ws + WS_BIASP);
    for (int u = gw; u < 64; u += NGW) {
        const int kv = u >> 5, ng = (u >> 4) & 1, kp = u & 15, n = ng * 64 + lane;
        const float* pos = a.in[I_CMPPOS] + (size_t)(l * 2 + kv) * 2048; const float* w1 = a.in[I_CMPW1] + (size_t)(l * 2 + kv) * 2048 * 128;
        float acc8[8] = {0.f, 0.f, 0.f, 0.f, 0.f, 0.f, 0.f, 0.f};
#pragma unroll 2
        for (int k = kp * 128; k < kp * 128 + 128; k += 8) {
#pragma unroll
            for (int e = 0; e < 8; ++e) acc8[e] += pos[k + e] * w1[(size_t)(k + e) * 128 + n];
        }
        biasp[(kv * 16 + kp) * 128 + n] = ((acc8[0] + acc8[1]) + (acc8[2] + acc8[3])) + ((acc8[4] + acc8[5]) + (acc8[6] + acc8[7]));
    }
    if (l == 0) {
        float* ssz = (float*)(a.ws + WS_SS);
        for (int i = blockIdx.x * 512 + tid; i < 3 * M_TOK; i += gridDim.x * 512) ssz[i] = 0.f;
        bf16_t* U = (bf16_t*)(a.ws + WS_U);
        for (int m = gw; m < M_TOK; m += NGW) rms_row(a.in[I_X] + (size_t)m * DM, a.in[I_MIXNORM], U + (size_t)m * DM, lane);
    }
}
DI void phase_norm2(const Args& a, int l) {
    const int tid = otid(), wid = tid >> 6, lane = tid & 63;
    const int gw = blockIdx.x * 8 + wid, NGW = gridDim.x * 8;
    bf16_t* HN = (bf16_t*)(a.ws + WS_HN);
    for (int m = gw; m < M_TOK; m += NGW) rms_row(a.out + (size_t)m * DM, a.in[I_FFNNORM] + l * DM, HN + (size_t)m * DM, lane);
}

DI void lerp8(const bf16_t* cur, const bf16_t* prev, bool has_prev, const float* mu, float* o) {
    const u32x4 c = *(const u32x4*)cur; u32x4 p = {0u, 0u, 0u, 0u}; if (has_prev) p = *(const u32x4*)prev;
    float cf[8], pf[8]; unpack8(c, cf); unpack8(p, pf);
    const f32x4 m0 = *(const f32x4*)mu, m1 = *(const f32x4*)(mu + 4);
#pragma unroll
    for (int i = 0; i < 8; ++i) { const float m = i < 4 ? m0[i] : m1[i - 4]; o[i] = cf[i] + (pf[i] - cf[i]) * m; }
}
DI void rwkv_prep_item(const Args& a, int l, int item, LAS unsigned char* lds) {
    const int tid = otid(), wid = tid >> 6, lane = tid & 63;
    const int b = item >> 6, t0 = (item & 63) * 64;
    bf16_t* PROJ = (bf16_t*)(a.ws + WS_PROJ); bf16_t* PREP = (bf16_t*)(a.ws + WS_PREP); const bf16_t* W = (const bf16_t*)(a.ws + WS_W);
    LAS bf16_t* A_w = (LAS bf16_t*)lds; LAS bf16_t* A_a = (LAS bf16_t*)(lds + 9216);
    LAS bf16_t* a_s = (LAS bf16_t*)(lds + 18432); LAS bf16_t* omd_s = (LAS bf16_t*)(lds + 18432 + 65536);
    const float* mu = a.in[I_TOKMIX] + l * 1792;
    {
        const int token = tid >> 3, part = tid & 7; const size_t row = (size_t)b * SEQ + t0 + token; const bool hp = (t0 + token) > 0;
        float v[8];
        lerp8(PROJ + row * PP + C_WL + part * 8, PROJ + (row - 1) * PP + C_WL + part * 8, hp, mu + (C_WL - C_R) + part * 8, v);
#pragma unroll
        for (int i = 0; i < 8; ++i) v[i] = tanh_fast(v[i]);
        *(LAS u32x4*)(A_w + token * 72 + part * 8) = pack8(v);
        lerp8(PROJ + row * PP + C_AL + part * 8, PROJ + (row - 1) * PP + C_AL + part * 8, hp, mu + (C_AL - C_R) + part * 8, v);
        *(LAS u32x4*)(A_a + token * 72 + part * 8) = pack8(v);
    }
    __syncthreads();
#pragma unroll 1
    for (int which = 0; which < 2; ++which) {
        f32x4 acc[4][4];
#pragma unroll
        for (int m = 0; m < 4; ++m)
#pragma unroll
            for (int n = 0; n < 4; ++n) acc[m][n] = (f32x4){0.f, 0.f, 0.f, 0.f};
        const int fr = lane & 15, fq = lane >> 4;
        const LAS bf16_t* As = which ? A_a : A_w; const bf16_t* Bw = W + (which ? W_AL : W_WL);
#pragma unroll
        for (int ks = 0; ks < 2; ++ks) {
            bf16x8 af[4];
#pragma unroll
            for (int m = 0; m < 4; ++m) af[m] = *(const LAS bf16x8*)(As + (m * 16 + fr) * 72 + ks * 32 + fq * 8);
#pragma unroll
            for (int n = 0; n < 4; ++n) {
                const bf16x8 bfr = *(const bf16x8*)(Bw + (size_t)(wid * 64 + n * 16 + fr) * 64 + ks * 32 + fq * 8);
#pragma unroll
                for (int m = 0; m < 4; ++m) acc[m][n] = MFMA16(af[m], bfr, acc[m][n]);
            }
        }
        LAS bf16_t* dst = which ? a_s : omd_s;
#pragma unroll
        for (int n = 0; n < 4; ++n) {
            const int c = wid * 64 + n * 16 + fr; const float c0 = a.in[which ? I_A0 : I_W0][l * 512 + c];
#pragma unroll
            for (int m = 0; m < 4; ++m)
#pragma unroll
                for (int r = 0; r < 4; ++r) {
                    const int token = m * 16 + fq * 4 + r;
                    float res;
                    if (which) res = sigm(c0 + acc[m][n][r]);
                    else {
                        const float x = -(c0 + acc[m][n][r]);
                        const float ew = 0.60653065971f * __builtin_amdgcn_rcpf(1.f + __expf(x));
                        res = ew > 0.03f ? 1.f - __expf(-ew) : ew * (1.f - ew * (0.5f - ew * (1.f / 6.f)));
                    }
                    dst[token * 512 + c] = tobf(res);
                }
        }
    }
    __syncthreads();
    {
        const int cgp = tid & 63, head = cgp >> 3, k0 = (cgp & 7) * 8, c = cgp * 8;
        float mur[8], muk[8], muv[8], kkp[8], kap[8];
        {
            const float* srcs[5] = {mu + c, mu + 512 + c, mu + 1024 + c, a.in[I_KK] + l * 512 + c, a.in[I_KA] + l * 512 + c};
            float* dsts[5] = {mur, muk, muv, kkp, kap};
#pragma unroll
            for (int q = 0; q < 5; ++q) { const f32x4 t0 = *(const f32x4*)srcs[q], t1 = *(const f32x4*)(srcs[q] + 4);
#pragma unroll
                for (int i = 0; i < 4; ++i) { dsts[q][i] = t0[i]; dsts[q][4 + i] = t1[i]; } }
        }
        u32x4 raw[6];
        auto load_unit = [&](int u) {
            const int token = u * 8 + (tid >> 6); const size_t row = (size_t)b * SEQ + t0 + token; const bool hp = (t0 + token) > 0;
            const u32x4 z = {0u, 0u, 0u, 0u};
            raw[0] = *(const u32x4*)(PROJ + row * PP + C_R + c); raw[1] = hp ? *(const u32x4*)(PROJ + (row - 1) * PP + C_R + c) : z;
            raw[2] = *(const u32x4*)(PROJ + row * PP + C_K + c); raw[3] = hp ? *(const u32x4*)(PROJ + (row - 1) * PP + C_K + c) : z;
            raw[4] = *(const u32x4*)(PROJ + row * PP + C_V + c); raw[5] = hp ? *(const u32x4*)(PROJ + (row - 1) * PP + C_V + c) : z;
        };
        load_unit(0);
#pragma unroll 1
        for (int u = 0; u < 8; ++u) {
            const int token = u * 8 + (tid >> 6);
            float r[8], k[8], v[8], av[8], od[8];
            {
                float cf[8], pf[8];
                unpack8(raw[0], cf); unpack8(raw[1], pf);
#pragma unroll
                for (int i = 0; i < 8; ++i) r[i] = cf[i] + (pf[i] - cf[i]) * mur[i];
                unpack8(raw[2], cf); unpack8(raw[3], pf);
#pragma unroll
                for (int i = 0; i < 8; ++i) k[i] = cf[i] + (pf[i] - cf[i]) * muk[i];
                unpack8(raw[4], cf); unpack8(raw[5], pf);
#pragma unroll
                for (int i = 0; i < 8; ++i) v[i] = cf[i] + (pf[i] - cf[i]) * muv[i];
            }
            if (u + 1 < 8) load_unit(u + 1);
            unpack8(*(const LAS u32x4*)(a_s + token * 512 + c), av); unpack8(*(const LAS u32x4*)(omd_s + token * 512 + c), od);
            float kk[8], bb[8], kp[8]; float ss = 0.f;
#pragma unroll
            for (int i = 0; i < 8; ++i) { kk[i] = k[i] * kkp[i]; ss += kk[i] * kk[i]; }
            ss = red8(ss);
            const float rn = rsqrtf(fmaxf(ss, 1e-24f));
#pragma unroll
            for (int i = 0; i < 8; ++i) { kk[i] *= rn; bb[i] = kk[i] * av[i]; kp[i] = k[i] * (1.f + (av[i] - 1.f) * kap[i]); }
            bf16_t* op = PREP + ((size_t)(b * 8 + head) * SEQ + t0 + token) * 384 + k0;
            *(u32x4*)(op) = pack8(r); *(u32x4*)(op + 64) = pack8(od); *(u32x4*)(op + 128) = pack8(kp); *(u32x4*)(op + 192) = pack8(kk); *(u32x4*)(op + 256) = pack8(bb); *(u32x4*)(op + 320) = pack8(v);
        }
    }
    __syncthreads();
}
DI void nsa_norm_item(const Args& a, int l, int item, LAS unsigned char* lds) {
    const int tid = otid();
    const int b = item >> 6, t0 = (item & 63) * 64;
    bf16_t* PROJ = (bf16_t*)(a.ws + WS_PROJ);
    LAS bf16_t* vt = (LAS bf16_t*)lds;
    const int token = tid >> 3, part = tid & 7, g = part >> 2, d0 = (part & 3) * 16;
    const size_t row = (size_t)b * SEQ + t0 + token;
#pragma unroll
    for (int var = 0; var < 2; ++var) {
        bf16_t* kp = PROJ + row * PP + (var ? C_KW : C_KS) + g * 64 + d0;
        float f[16]; unpack8(*(const u32x4*)kp, f); unpack8(*(const u32x4*)(kp + 8), f + 8);
        float ss = 0.f;
#pragma unroll
        for (int i = 0; i < 16; ++i) ss += f[i] * f[i];
        ss = red4(ss);
        const float rstd = rsqrtf(ss * (1.f / 64.f) + 1e-6f);
        const float* gn = a.in[I_KGAIN] + (l * 3 + 1 + var) * 64 + d0;
#pragma unroll
        for (int i = 0; i < 16; ++i) f[i] = f[i] * rstd * gn[i];
        *(u32x4*)kp = pack8(f); *(u32x4*)(kp + 8) = pack8(f + 8);
        const bf16_t* vp = PROJ + row * PP + (var ? C_VW : C_VS) + g * 64 + d0;
        const u32x4 v0 = *(const u32x4*)vp, v1 = *(const u32x4*)(vp + 8);
        const unsigned vw[8] = {v0.x, v0.y, v0.z, v0.w, v1.x, v1.y, v1.z, v1.w};
#pragma unroll
        for (int i = 0; i < 8; ++i) { vt[(var * 128 + g * 64 + d0 + 2 * i) * 72 + token] = (bf16_t)(vw[i] & 0xffffu); vt[(var * 128 + g * 64 + d0 + 2 * i + 1) * 72 + token] = (bf16_t)(vw[i] >> 16); }
    }
    __syncthreads();
#pragma unroll
    for (int u = 0; u < 4; ++u) {
        const int id = u * 512 + tid, var = id >> 10, rr = (id >> 3) & 127, seg = id & 7, gg = rr >> 6, d = rr & 63;
        bf16_t* dst = (bf16_t*)(a.ws + (var ? WS_VWT : WS_VST)) + ((size_t)(b * 2 + gg) * 64 + d) * SEQ + t0 + seg * 8;
        *(u32x4*)dst = *(const LAS u32x4*)(vt + (var * 128 + rr) * 72 + seg * 8);
    }
    __syncthreads();
}
DI float gelu_tanh(float x) { const float u = 0.7978845608f * (x + 0.044715f * x * x * x); return 0.5f * x * (1.f + tanh_fast(u)); }
DI void compress_item(const Args& a, int l, int item, LAS unsigned char* lds) {
    const int tid = otid(), wid = tid >> 6, lane = tid & 63, fr = lane & 15, fq = lane >> 4;
    const int kv = item >> 7, bg = (item >> 3) & 15, nq = item & 7, b = bg >> 1, g = bg & 1;
    const bf16_t* PROJ = (const bf16_t*)(a.ws + WS_PROJ); const bf16_t* W = (const bf16_t*)(a.ws + WS_W);
    LAS bf16_t* hs = (LAS bf16_t*)lds; LAS float* os = (LAS float*)(lds + 8704);
    const int colbase = (kv ? C_VC : C_KC) + g * 64;
    f32x4 acc[2];
#pragma unroll
    for (int m = 0; m < 2; ++m) acc[m] = (f32x4){0.f, 0.f, 0.f, 0.f};
    const bf16_t* w1 = W + W_C1 + (size_t)kv * 262144 + (size_t)(wid * 16 + fr) * 2048 + fq * 8;
    int tk0[2];
#pragma unroll
    for (int m = 0; m < 2; ++m) tk0[m] = 16 * (nq * 32 + m * 16 + fr);
#pragma unroll 1
    for (int k8 = 0; k8 < 64; k8 += 8) {
        bf16x8 bfr[8], af[8][2];
#pragma unroll
        for (int kk = 0; kk < 8; ++kk) {
            const int ks = k8 + kk, tokoff = ks >> 1, dcol = (ks & 1) * 32 + fq * 8;
            bfr[kk] = *(const bf16x8*)(w1 + ks * 32);
#pragma unroll
            for (int m = 0; m < 2; ++m) { int tk = tk0[m] + tokoff; tk = tk > SEQ - 1 ? SEQ - 1 : tk; af[kk][m] = *(const bf16x8*)(PROJ + ((size_t)b * SEQ + tk) * PP + colbase + dcol); }
        }
#pragma unroll
        for (int kk = 0; kk < 8; ++kk)
#pragma unroll
            for (int m = 0; m < 2; ++m) acc[m] = MFMA16(af[kk][m], bfr[kk], acc[m]);
    }
    {
        const int c = wid * 16 + fr; const float* biasp = (const float*)(a.ws + WS_BIASP) + kv * 16 * 128 + c;
        float bias = 0.f;
#pragma unroll
        for (int kp = 0; kp < 16; ++kp) bias += biasp[kp * 128];
#pragma unroll
        for (int m = 0; m < 2; ++m)
#pragma unroll
            for (int r = 0; r < 4; ++r) hs[(m * 16 + fq * 4 + r) * 136 + c] = tobf(gelu_tanh(acc[m][r] + bias));
    }
    __syncthreads();
    {
        const int m = wid >> 2, nt = wid & 3;
        f32x4 acc2 = {0.f, 0.f, 0.f, 0.f};
#pragma unroll
        for (int ks = 0; ks < 4; ++ks) {
            const bf16x8 af = *(const LAS bf16x8*)(hs + (m * 16 + fr) * 136 + ks * 32 + fq * 8);
            const bf16x8 bf = *(const bf16x8*)(W + W_C2 + (size_t)kv * 8192 + (size_t)(nt * 16 + fr) * 128 + ks * 32 + fq * 8);
            acc2 = MFMA16(af, bf, acc2);
        }
#pragma unroll
        for (int r = 0; r < 4; ++r) os[(m * 16 + fq * 4 + r) * 64 + nt * 16 + fr] = acc2[r];
    }
    __syncthreads();
    if (tid < 256) {
        const int rowi = tid >> 3, d0 = (tid & 7) * 8, n = nq * 32 + rowi;
        float v[8];
#pragma unroll
        for (int i = 0; i < 8; ++i) v[i] = os[rowi * 64 + d0 + i];
        if (kv == 0) {
            float ss = 0.f;
#pragma unroll
            for (int i = 0; i < 8; ++i) ss += v[i] * v[i];
            ss = red8(ss);
            const float rstd = rsqrtf(ss * (1.f / 64.f) + 1e-6f);
            const float* gn = a.in[I_KGAIN] + (l * 3 + 0) * 64 + d0;
#pragma unroll
            for (int i = 0; i < 8; ++i) v[i] = (n == 255) ? 0.f : v[i] * rstd * gn[i];
            *(u32x4*)((bf16_t*)(a.ws + WS_KCN) + ((size_t)bg * 256 + n) * 64 + d0) = pack8(v);
        } else {
            bf16_t* vct = (bf16_t*)(a.ws + WS_VCT) + (size_t)bg * 64 * 256;
#pragma unroll
            for (int i = 0; i < 8; ++i) vct[(d0 + i) * 256 + n] = tobf(n == 255 ? 0.f : v[i]);
        }
    }
    __syncthreads();
}
DI void phase_prep(const Args& a, int l, LAS unsigned char* lds) {
#ifdef DUPPREP
    for (int it = blockIdx.x; it < 768; it += gridDim.x) { if (it < 256) compress_item(a, l, it, lds); else rwkv_prep_item(a, l, it - 256, lds); }
#endif
#ifdef OLD_PREP
    for (int it = blockIdx.x; it < 1280; it += gridDim.x) {
        if (it < 256) compress_item(a, l, it, lds);
        else if (it < 768) rwkv_prep_item(a, l, it - 256, lds);
        else nsa_norm_item(a, l, it - 768, lds);
    }
#else
    for (int it = blockIdx.x; it < 768; it += gridDim.x) {
        if (it < 256) compress_item(a, l, it, lds);
        else nsa_norm_item(a, l, it - 256, lds);
    }
#endif
}

DI f32x2 red16p(f32x2 x) { x.x = red16(x.x); x.y = red16(x.y); return x; }
template <int RPL>
DI void scan_bh(const Args& a, int bh, int halfsel, LAS unsigned char* lds) {
    const int tid = otid(), wid = tid >> 6, lane = tid & 63, vq = lane >> 4, kq = lane & 15;
    const bf16_t* src = (const bf16_t*)(a.ws + WS_PREP) + (size_t)bh * SEQ * 384;
    bf16_t* PROJ = (bf16_t*)(a.ws + WS_PROJ);
    const int b = bh >> 3, h = bh & 7;
    constexpr int T = 32, CH = T * 384, NL = CH / 2048;
    LAS float* opbuf = (LAS float*)lds;
    LAS unsigned char* ybuf = lds + 2 * CH * 4;
    const int row0 = RPL == 2 ? halfsel * 32 + (wid & 3) * 8 + vq * 2 : halfsel * 32 + wid * 4 + vq;
    const bool active = RPL == 2 ? wid < 4 : true;
    f32x2 S[4];
#pragma unroll
    for (int j = 0; j < 4; ++j) S[j] = (f32x2){0.f, 0.f};
    u32x2 ld[NL]; bool isd[NL];
#pragma unroll
    for (int j = 0; j < NL; ++j) { isd[j] = (((tid * 4 + j * 2048) % 384) >> 6) == 1; ld[j] = *(const u32x2*)(src + tid * 4 + j * 2048); }
#pragma unroll
    for (int j = 0; j < NL; ++j) { f32x4 f = {bflo(ld[j].x), bfhi(ld[j].x), bflo(ld[j].y), bfhi(ld[j].y)}; if (isd[j]) f = 1.f - f; *(LAS f32x4*)(opbuf + tid * 4 + j * 2048) = f; }
    __syncthreads();
#pragma unroll 1
    for (int c = 0; c < SEQ / T; ++c) {
        if (c + 1 < SEQ / T) {
#pragma unroll
            for (int j = 0; j < NL; ++j) ld[j] = *(const u32x2*)(src + (size_t)(c + 1) * CH + tid * 4 + j * 2048);
        }
        const LAS float* cur = opbuf + (c & 1) * CH;
        LAS unsigned char* yb = ybuf + (c & 1) * (T * 128);
        f32x4 r4 = *(const LAS f32x4*)(cur + kq * 4), d4 = *(const LAS f32x4*)(cur + 64 + kq * 4), k4 = *(const LAS f32x4*)(cur + 128 + kq * 4),
              kk4 = *(const LAS f32x4*)(cur + 192 + kq * 4), b4 = *(const LAS f32x4*)(cur + 256 + kq * 4);
        f32x2 v2; if (RPL == 2) v2 = *(const LAS f32x2*)(cur + 320 + row0); else { v2.x = cur[320 + row0]; v2.y = 0.f; }
        if (active) {
#pragma unroll
        for (int st = 0; st < T; ++st) {
            f32x4 nr4, nd4, nk4, nkk4, nb4; f32x2 nv2;
            if (st < T - 1) {
                const LAS float* o = cur + (st + 1) * 384;
                nr4 = *(const LAS f32x4*)(o + kq * 4); nd4 = *(const LAS f32x4*)(o + 64 + kq * 4); nk4 = *(const LAS f32x4*)(o + 128 + kq * 4);
                nkk4 = *(const LAS f32x4*)(o + 192 + kq * 4); nb4 = *(const LAS f32x4*)(o + 256 + kq * 4);
                if (RPL == 2) nv2 = *(const LAS f32x2*)(o + 320 + row0); else { nv2.x = o[320 + row0]; nv2.y = 0.f; }
            }
            if (RPL == 2) {
                f32x2 sa = S[0] * kk4[0]; sa += S[1] * kk4[1]; f32x2 sb = S[2] * kk4[2]; sb += S[3] * kk4[3]; sa += sb;
                sa = red16p(sa); sa = -sa;
#pragma unroll
                for (int j = 0; j < 4; ++j) S[j] = S[j] * d4[j] + sa * b4[j] + v2 * k4[j];
                f32x2 y = S[0] * r4[0]; y += S[1] * r4[1]; f32x2 yc = S[2] * r4[2]; yc += S[3] * r4[3]; y += yc;
                y = red16p(y);
                *(LAS unsigned*)(yb + st * 128 + row0 * 2) = pk2(y.x, y.y);
            } else {
                const f32x2 kk01 = {kk4[0], kk4[1]}, kk23 = {kk4[2], kk4[3]}, d01 = {d4[0], d4[1]}, d23 = {d4[2], d4[3]}, b01 = {b4[0], b4[1]}, b23 = {b4[2], b4[3]},
                            k01 = {k4[0], k4[1]}, k23 = {k4[2], k4[3]}, r01 = {r4[0], r4[1]}, r23 = {r4[2], r4[3]};
                f32x2 sa2 = S[0] * kk01; sa2 += S[1] * kk23;
                const float sa = -red16(sa2.x + sa2.y);
                S[0] = S[0] * d01 + sa * b01 + v2.x * k01; S[1] = S[1] * d23 + sa * b23 + v2.x * k23;
                f32x2 y2 = S[0] * r01; y2 += S[1] * r23;
                const float y = red16(y2.x + y2.y);
                if (kq == 0) *(LAS bf16_t*)(yb + st * 128 + row0 * 2) = tobf(y);
            }
            if (st < T - 1) { r4 = nr4; d4 = nd4; k4 = nk4; kk4 = nkk4; b4 = nb4; v2 = nv2; }
        }
        }
        if (c + 1 < SEQ / T) {
            LAS float* nb = opbuf + ((c + 1) & 1) * CH;
#pragma unroll
            for (int j = 0; j < NL; ++j) { f32x4 f = {bflo(ld[j].x), bfhi(ld[j].x), bflo(ld[j].y), bfhi(ld[j].y)}; if (isd[j]) f = 1.f - f; *(LAS f32x4*)(nb + tid * 4 + j * 2048) = f; }
        }
        __syncthreads();
        { if (tid < T * 4) { const int rowi = tid >> 2, seg = tid & 3;
            *(u32x4*)(PROJ + ((size_t)b * SEQ + c * T + rowi) * PP + C_R + h * 64 + halfsel * 32 + seg * 8) = *(const LAS u32x4*)(yb + rowi * 128 + halfsel * 64 + seg * 16); } }
    }
    __syncthreads();
}

DI void scan_bh2(const Args& a, int l, int bh, int halfsel, LAS unsigned char* lds) {
    const int tid = otid(), wid = tid >> 6, lane = tid & 63;
    const int b = bh >> 3, h = bh & 7;
    constexpr int T = 32, CH = T * 384;
    LAS float* opbuf = (LAS float*)lds;
    LAS unsigned char* ybuf = lds + 2 * CH * 4;
    bf16_t* PROJ = (bf16_t*)(a.ws + WS_PROJ);
    if (wid < 4) {
        const int vq = lane >> 4, kq = lane & 15;
        const int row0 = halfsel * 32 + wid * 8 + vq * 2;
        bf16_t* Y = (bf16_t*)(a.ws + WS_Y);
        f32x2 S[4];
#pragma unroll
        for (int j = 0; j < 4; ++j) S[j] = (f32x2){0.f, 0.f};
        __syncthreads();
#pragma unroll 1
        for (int c = 0; c < SEQ / T; ++c) {
            const LAS float* cur = opbuf + (c & 1) * CH;
            LAS unsigned char* yb = ybuf + (c & 1) * (T * 128);
            f32x4 r4 = *(const LAS f32x4*)(cur + kq * 4), d4 = *(const LAS f32x4*)(cur + 64 + kq * 4), k4 = *(const LAS f32x4*)(cur + 128 + kq * 4),
                  kk4 = *(const LAS f32x4*)(cur + 192 + kq * 4), b4 = *(const LAS f32x4*)(cur + 256 + kq * 4);
            f32x2 v2 = *(const LAS f32x2*)(cur + 320 + row0);
#pragma unroll
            for (int st = 0; st < T; ++st) {
                f32x4 nr4, nd4, nk4, nkk4, nb4; f32x2 nv2;
                if (st < T - 1) {
                    const LAS float* o = cur + (st + 1) * 384;
                    nr4 = *(const LAS f32x4*)(o + kq * 4); nd4 = *(const LAS f32x4*)(o + 64 + kq * 4); nk4 = *(const LAS f32x4*)(o + 128 + kq * 4);
                    nkk4 = *(const LAS f32x4*)(o + 192 + kq * 4); nb4 = *(const LAS f32x4*)(o + 256 + kq * 4); nv2 = *(const LAS f32x2*)(o + 320 + row0);
                }
                f32x2 sa = S[0] * kk4[0]; sa += S[1] * kk4[1]; f32x2 sb = S[2] * kk4[2]; sb += S[3] * kk4[3]; sa += sb;
                sa = red16p(sa); sa = -sa;
#pragma unroll
                for (int j = 0; j < 4; ++j) S[j] = S[j] * d4[j] + sa * b4[j] + v2 * k4[j];
                f32x2 y = S[0] * r4[0]; y += S[1] * r4[1]; f32x2 yc = S[2] * r4[2]; yc += S[3] * r4[3]; y += yc;
                y = red16p(y);
                *(LAS unsigned*)(yb + st * 128 + row0 * 2) = pk2(y.x, y.y);
                if (st < T - 1) { r4 = nr4; d4 = nd4; k4 = nk4; kk4 = nkk4; b4 = nb4; v2 = nv2; }
            }
            __syncthreads();
            if (tid < T * 4) { const int rowi = tid >> 2, seg = tid & 3;
                *(u32x4*)(Y + ((size_t)b * SEQ + c * T + rowi) * 512 + h * 64 + halfsel * 32 + seg * 8) = *(const LAS u32x4*)(yb + rowi * 128 + halfsel * 64 + seg * 16); }
        }
    } else {
        const int lw = wid - 4, token = lane >> 3, part = lane & 7, fr = lane & 15, fq = lane >> 4;
        const int c8 = part * 8, ch = h * 64 + c8;
        LAS unsigned char* scr = lds + 2 * CH * 4 + 2 * T * 128 + lw * 7168;
        LAS bf16_t* A_w = (LAS bf16_t*)scr; LAS bf16_t* A_a = (LAS bf16_t*)(scr + 2304);
        LAS bf16_t* a_s = (LAS bf16_t*)(scr + 4608); LAS bf16_t* omd_s = (LAS bf16_t*)(scr + 5632);
        const bf16_t* W = (const bf16_t*)(a.ws + WS_W);
        bf16_t* PREP3 = (bf16_t*)(a.ws + WS_PREP);
        const float* mu = a.in[I_TOKMIX] + l * 1792;
        float mur[8], muk[8], muv[8], kkp[8], kap[8], muw[8], mua[8];
        {
            const float* srcs[7] = {mu + ch, mu + 512 + ch, mu + 1024 + ch, a.in[I_KK] + l * 512 + ch, a.in[I_KA] + l * 512 + ch, mu + (C_WL - C_R) + c8, mu + (C_AL - C_R) + c8};
            float* dsts[7] = {mur, muk, muv, kkp, kap, muw, mua};
#pragma unroll
            for (int q = 0; q < 7; ++q) { const f32x4 t0 = *(const f32x4*)srcs[q], t1 = *(const f32x4*)(srcs[q] + 4);
#pragma unroll
                for (int i = 0; i < 4; ++i) { dsts[q][i] = t0[i]; dsts[q][4 + i] = t1[i]; } }
        }
        float w0c[4], a0c[4];
#pragma unroll
        for (int n = 0; n < 4; ++n) { w0c[n] = a.in[I_W0][l * 512 + h * 64 + n * 16 + fr]; a0c[n] = a.in[I_A0][l * 512 + h * 64 + n * 16 + fr]; }
        { const u32x4 z = {0u, 0u, 0u, 0u}; *(LAS u32x4*)(A_w + (8 + token) * 72 + c8) = z; *(LAS u32x4*)(A_a + (8 + token) * 72 + c8) = z; }
        u32x4 nxt[10];
        auto load_rows = [&](int cc2) {
            const int tg2 = cc2 * T + lw * 8 + token; const bool hp2 = tg2 > 0; const u32x4 z = {0u, 0u, 0u, 0u};
            const bf16_t* pr = PROJ + ((size_t)b * SEQ + tg2) * PP;
            nxt[0] = *(const u32x4*)(pr + C_WL + c8); nxt[1] = hp2 ? *(const u32x4*)(pr - PP + C_WL + c8) : z;
            nxt[2] = *(const u32x4*)(pr + C_AL + c8); nxt[3] = hp2 ? *(const u32x4*)(pr - PP + C_AL + c8) : z;
            nxt[4] = *(const u32x4*)(pr + C_R + ch);  nxt[5] = hp2 ? *(const u32x4*)(pr - PP + C_R + ch) : z;
            nxt[6] = *(const u32x4*)(pr + C_K + ch);  nxt[7] = hp2 ? *(const u32x4*)(pr - PP + C_K + ch) : z;
            nxt[8] = *(const u32x4*)(pr + C_V + ch);  nxt[9] = hp2 ? *(const u32x4*)(pr - PP + C_V + ch) : z;
        };
        load_rows(0);
#pragma unroll 1
        for (int cc = 0; cc <= SEQ / T; ++cc) {
            if (cc < SEQ / T) {
                const int tg = cc * T + lw * 8 + token;
                const u32x4 rw0 = nxt[0], rw1 = nxt[1], ra0 = nxt[2], ra1 = nxt[3], rr0 = nxt[4], rr1 = nxt[5], rk0 = nxt[6], rk1 = nxt[7], rv0 = nxt[8], rv1 = nxt[9];
                bf16x8 bwq[2][4];
#pragma unroll
                for (int ks = 0; ks < 2; ++ks)
#pragma unroll
                    for (int n = 0; n < 4; ++n) bwq[ks][n] = *(const bf16x8*)(W + W_WL + (size_t)(h * 64 + n * 16 + fr) * 64 + ks * 32 + fq * 8);
                float cf[8], pf[8], t8[8];
                unpack8(rw0, cf); unpack8(rw1, pf);
#pragma unroll
                for (int i = 0; i < 8; ++i) t8[i] = tanh_fast(cf[i] + (pf[i] - cf[i]) * muw[i]);
                *(LAS u32x4*)(A_w + token * 72 + c8) = pack8(t8);
                unpack8(ra0, cf); unpack8(ra1, pf);
#pragma unroll
                for (int i = 0; i < 8; ++i) t8[i] = cf[i] + (pf[i] - cf[i]) * mua[i];
                *(LAS u32x4*)(A_a + token * 72 + c8) = pack8(t8);
                asm volatile("s_waitcnt lgkmcnt(0)" ::: "memory");
#pragma unroll
                for (int which = 0; which < 2; ++which) {
                    f32x4 acc[4];
#pragma unroll
                    for (int n = 0; n < 4; ++n) acc[n] = (f32x4){0.f, 0.f, 0.f, 0.f};
                    const LAS bf16_t* As = which ? A_a : A_w;
#pragma unroll
                    for (int ks = 0; ks < 2; ++ks) {
                        const bf16x8 af = *(const LAS bf16x8*)(As + fr * 72 + ks * 32 + fq * 8);
#pragma unroll
                        for (int n = 0; n < 4; ++n) acc[n] = MFMA16(af, bwq[ks][n], acc[n]);
                    }
                    if (which == 0) {
#pragma unroll
                        for (int ks = 0; ks < 2; ++ks)
#pragma unroll
                            for (int n = 0; n < 4; ++n) bwq[ks][n] = *(const bf16x8*)(W + W_AL + (size_t)(h * 64 + n * 16 + fr) * 64 + ks * 32 + fq * 8);
                    }
                    if (fq < 2) {
                        LAS bf16_t* dst = which ? a_s : omd_s;
#pragma unroll
                        for (int n = 0; n < 4; ++n)
#pragma unroll
                            for (int r = 0; r < 4; ++r) {
                                float res;
                                if (which) res = sigm(a0c[n] + acc[n][r]);
                                else { const float x = -(w0c[n] + acc[n][r]); const float ew = 0.60653065971f * __builtin_amdgcn_rcpf(1.f + __expf(x));
                                       res = ew > 0.03f ? 1.f - __expf(-ew) : ew * (1.f - ew * (0.5f - ew * (1.f / 6.f))); }
                                dst[(fq * 4 + r) * 64 + n * 16 + fr] = tobf(res);
                            }
                    }
                }
                asm volatile("s_waitcnt lgkmcnt(0)" ::: "memory");
                float r[8], k[8], v[8], av[8], od[8];
                unpack8(rr0, cf); unpack8(rr1, pf);
#pragma unroll
                for (int i = 0; i < 8; ++i) r[i] = cf[i] + (pf[i] - cf[i]) * mur[i];
                unpack8(rk0, cf); unpack8(rk1, pf);
#pragma unroll
                for (int i = 0; i < 8; ++i) k[i] = cf[i] + (pf[i] - cf[i]) * muk[i];
                unpack8(rv0, cf); unpack8(rv1, pf);
#pragma unroll
                for (int i = 0; i < 8; ++i) v[i] = cf[i] + (pf[i] - cf[i]) * muv[i];
                unpack8(*(const LAS u32x4*)(a_s + token * 64 + c8), av); unpack8(*(const LAS u32x4*)(omd_s + token * 64 + c8), od);
                float kk[8], bb[8], kp[8]; float ss = 0.f;
#pragma unroll
                for (int i = 0; i < 8; ++i) { kk[i] = k[i] * kkp[i]; ss += kk[i] * kk[i]; }
                ss = red8(ss);
                const float rn = rsqrtf(fmaxf(ss, 1e-24f));
#pragma unroll
                for (int i = 0; i < 8; ++i) { kk[i] *= rn; bb[i] = kk[i] * av[i]; kp[i] = k[i] * (1.f + (av[i] - 1.f) * kap[i]); }
                const u32x4 r16 = pack8(r), kp16 = pack8(kp), kk16 = pack8(kk), bb16 = pack8(bb), v16 = pack8(v);
                if (halfsel == 0) { bf16_t* op = PREP3 + ((size_t)bh * SEQ + tg) * 192 + c8; *(u32x4*)op = r16; *(u32x4*)(op + 64) = kp16; *(u32x4*)(op + 128) = v16; }
                LAS float* ob = opbuf + (cc & 1) * CH + (lw * 8 + token) * 384 + c8;
                unpack8(r16, t8);  *(LAS f32x4*)(ob) = (f32x4){t8[0], t8[1], t8[2], t8[3]};       *(LAS f32x4*)(ob + 4) = (f32x4){t8[4], t8[5], t8[6], t8[7]};
#pragma unroll
                for (int i = 0; i < 8; ++i) t8[i] = 1.f - od[i];
                *(LAS f32x4*)(ob + 64) = (f32x4){t8[0], t8[1], t8[2], t8[3]};  *(LAS f32x4*)(ob + 68) = (f32x4){t8[4], t8[5], t8[6], t8[7]};
                unpack8(kp16, t8); *(LAS f32x4*)(ob + 128) = (f32x4){t8[0], t8[1], t8[2], t8[3]}; *(LAS f32x4*)(ob + 132) = (f32x4){t8[4], t8[5], t8[6], t8[7]};
                unpack8(kk16, t8); *(LAS f32x4*)(ob + 192) = (f32x4){t8[0], t8[1], t8[2], t8[3]}; *(LAS f32x4*)(ob + 196) = (f32x4){t8[4], t8[5], t8[6], t8[7]};
                unpack8(bb16, t8); *(LAS f32x4*)(ob + 256) = (f32x4){t8[0], t8[1], t8[2], t8[3]}; *(LAS f32x4*)(ob + 260) = (f32x4){t8[4], t8[5], t8[6], t8[7]};
                unpack8(v16, t8);  *(LAS f32x4*)(ob + 320) = (f32x4){t8[0], t8[1], t8[2], t8[3]}; *(LAS f32x4*)(ob + 324) = (f32x4){t8[4], t8[5], t8[6], t8[7]};
                if (cc + 1 < SEQ / T) load_rows(cc + 1);
            }
            __syncthreads();
        }
    }
    __syncthreads();
}

constexpr int AT_IMP = 0, AT_SEL = 65536, AT_LINV = 66048, AT_BUF = 67072, AT_BUFSZ = 18432, AT_VOFF = 9216;
struct AttnCtx {
    bf16x8 q[4]; int t, tw, qi, hi, tid; unsigned long long mymask; int ncv, ncvw, ncvmin; float inv; LAS float* impw; LAS unsigned char* lds; bool nocompute;
};
template <int BR>
DI void attn_branch(const AttnCtx& c, unsigned long long tmask, const bf16_t* kbase, size_t kpitch, const bf16_t* vbase, size_t vpitch, f32x16 (&o)[2], float& lsum) {
    if (tmask == 0ull) return;
    const int rowi = c.tid >> 3, seg = c.tid & 7;
    const bf16_t* kg = kbase + (size_t)rowi * kpitch + seg * 8;
    const bf16_t* vg = vbase + (size_t)rowi * vpitch + seg * 8;
    unsigned long long m = tmask;
    int j = __ffsll((long long)m) - 1; m &= m - 1;
    u32x4 kr = *(const u32x4*)(kg + (size_t)j * 64 * kpitch), vr;
    if (BR != 0) vr = *(const u32x4*)(vg + j * 64);
    int it = 0;
    for (;;) {
        LAS bf16_t* Ks = (LAS bf16_t*)(c.lds + AT_BUF + (it & 1) * AT_BUFSZ); LAS bf16_t* Vs = (LAS bf16_t*)(c.lds + AT_BUF + (it & 1) * AT_BUFSZ + AT_VOFF);
        *(LAS u32x4*)(Ks + rowi * 72 + seg * 8) = kr;
        if (BR != 0) { *(LAS u32x2*)(Vs + rowi * 68 + seg * 8) = (u32x2){vr.x, vr.y}; *(LAS u32x2*)(Vs + rowi * 68 + seg * 8 + 4) = (u32x2){vr.z, vr.w}; }
        __syncthreads();
        const int jc = j; const bool more = m != 0ull;
        if (more) { j = __ffsll((long long)m) - 1; m &= m - 1; kr = *(const u32x4*)(kg + (size_t)j * 64 * kpitch); if (BR != 0) vr = *(const u32x4*)(vg + j * 64); }
        bool mine = true;
        if (BR == 2) mine = (c.mymask >> jc) & 1ull;
        const bool wave_on = (BR == 2 ? (__ballot(mine) != 0ull) : true) && !c.nocompute;
        if (wave_on) {
            const float sbias = (BR == 2 && !mine) ? -1e30f : 0.f;
            bool interior;
            if (BR <= 1) interior = jc * 64 + 64 <= c.ncvmin;
            else if (BR == 2) interior = jc * 64 + 63 <= c.tw;
            else interior = (jc * 64 + 63 <= c.tw) && (jc * 64 > c.tw + 31 - 512);
            if (interior) {
                f32x16 s0, s1;
#pragma unroll
                for (int i = 0; i < 16; ++i) { s0[i] = sbias; s1[i] = sbias; }
#pragma unroll
                for (int st = 0; st < 4; ++st) {
                    const bf16x8 kf0 = *(const LAS bf16x8*)(Ks + c.qi * 72 + 16 * st + 8 * c.hi), kf1 = *(const LAS bf16x8*)(Ks + (32 + c.qi) * 72 + 16 * st + 8 * c.hi);
                    s0 = MFMA32(kf0, c.q[st], s0); s1 = MFMA32(kf1, c.q[st], s1);
                }
                float p0[16], p1[16];
#pragma unroll
                for (int i = 0; i < 16; ++i) { p0[i] = __builtin_amdgcn_exp2f(s0[i]); p1[i] = __builtin_amdgcn_exp2f(s1[i]); }
                {
                    float l0 = 0.f, l1 = 0.f;
#pragma unroll
                    for (int i = 0; i < 16; ++i) { l0 += p0[i]; l1 += p1[i]; }
                    lsum += l0 + l1;
                }
                if (BR == 1) {
#pragma unroll
                    for (int gq = 0; gq < 4; ++gq) {
                        const int jj = jc * 16 + gq * 2 + c.hi;
                        __hip_atomic_fetch_add(c.impw + jj, (p0[4 * gq] + p0[4 * gq + 1]) + (p0[4 * gq + 2] + p0[4 * gq + 3]), __ATOMIC_RELAXED, __HIP_MEMORY_SCOPE_WORKGROUP);
                        __hip_atomic_fetch_add(c.impw + jj + 1, p0[4 * gq + 3], __ATOMIC_RELAXED, __HIP_MEMORY_SCOPE_WORKGROUP);
                    }
#pragma unroll
                    for (int gq = 0; gq < 4; ++gq) {
                        const int jj = jc * 16 + 8 + gq * 2 + c.hi;
                        __hip_atomic_fetch_add(c.impw + jj, (p1[4 * gq] + p1[4 * gq + 1]) + (p1[4 * gq + 2] + p1[4 * gq + 3]), __ATOMIC_RELAXED, __HIP_MEMORY_SCOPE_WORKGROUP);
                        if (jj + 1 < 64) __hip_atomic_fetch_add(c.impw + jj + 1, p1[4 * gq + 3], __ATOMIC_RELAXED, __HIP_MEMORY_SCOPE_WORKGROUP);
                    }
                }
                if (BR != 0) {
                    unsigned pa[8], pb[8];
#pragma unroll
                    for (int i = 0; i < 8; ++i) { pa[i] = pk2(p0[2 * i], p0[2 * i + 1]); pb[i] = pk2(p1[2 * i], p1[2 * i + 1]); }
#pragma unroll
                    for (int f = 0; f < 2; ++f) {
                        const u32x4 bw0 = {pa[4 * f], pa[4 * f + 1], pa[4 * f + 2], pa[4 * f + 3]}, bw1 = {pb[4 * f], pb[4 * f + 1], pb[4 * f + 2], pb[4 * f + 3]};
#pragma unroll
                        for (int mt = 0; mt < 2; ++mt) {
                            const LAS bf16_t* vp = Vs + (mt * 32 + c.qi) * 68 + f * 16 + 4 * c.hi;
                            const u32x2 a0 = *(const LAS u32x2*)vp, a1 = *(const LAS u32x2*)(vp + 8), a2 = *(const LAS u32x2*)(vp + 32), a3 = *(const LAS u32x2*)(vp + 40);
                            const u32x4 aw0 = {a0.x, a0.y, a1.x, a1.y}, aw1 = {a2.x, a2.y, a3.x, a3.y};
                            o[mt] = MFMA32(__builtin_bit_cast(bf16x8, aw0), __builtin_bit_cast(bf16x8, bw0), o[mt]);
                            o[mt] = MFMA32(__builtin_bit_cast(bf16x8, aw1), __builtin_bit_cast(bf16x8, bw1), o[mt]);
                        }
                    }
                }
            } else {
#pragma unroll
            for (int sub = 0; sub < 2; ++sub) {
                const int key0 = jc * 64 + sub * 32;
                bool skip;
                if (BR <= 1) skip = key0 >= c.ncvw;
                else if (BR == 2) skip = key0 > c.tw + 31;
                else skip = (key0 + 31 < c.tw - 511) || (key0 > c.tw + 31);
                if (skip) continue;
                f32x16 s;
#pragma unroll
                for (int i = 0; i < 16; ++i) s[i] = sbias;
#pragma unroll
                for (int st = 0; st < 4; ++st) { const bf16x8 kf = *(const LAS bf16x8*)(Ks + (sub * 32 + c.qi) * 72 + 16 * st + 8 * c.hi); s = MFMA32(kf, c.q[st], s); }
                float p[16];
#pragma unroll
                for (int i = 0; i < 16; ++i) p[i] = __builtin_amdgcn_exp2f(s[i]);
                int lim;
                if (BR <= 1) lim = c.ncv - 1 - key0 - 4 * c.hi; else lim = c.t - key0 - 4 * c.hi;
#pragma unroll
                for (int i = 0; i < 16; ++i) { const int cst = (i & 3) + 8 * (i >> 2); bool valid = cst <= lim; if (BR == 3) valid = valid && (cst > lim - 512); p[i] = valid ? p[i] : 0.f; }
#pragma unroll
                for (int i = 0; i < 16; ++i) lsum += p[i];
                if (BR == 0) continue;
                if (BR == 1) {
#pragma unroll
                    for (int gq = 0; gq < 4; ++gq) {
                        const int jj = jc * 16 + sub * 8 + gq * 2 + c.hi;
                        __hip_atomic_fetch_add(c.impw + jj, (p[4 * gq] + p[4 * gq + 1]) + (p[4 * gq + 2] + p[4 * gq + 3]), __ATOMIC_RELAXED, __HIP_MEMORY_SCOPE_WORKGROUP);
                        if (jj + 1 < 64) __hip_atomic_fetch_add(c.impw + jj + 1, p[4 * gq + 3], __ATOMIC_RELAXED, __HIP_MEMORY_SCOPE_WORKGROUP);
                    }
                }
                unsigned pp[8];
#pragma unroll
                for (int i = 0; i < 8; ++i) pp[i] = pk2(p[2 * i], p[2 * i + 1]);
#pragma unroll
                for (int f = 0; f < 2; ++f) {
                    const u32x4 bw = {pp[4 * f], pp[4 * f + 1], pp[4 * f + 2], pp[4 * f + 3]};
                    const bf16x8 bfr = __builtin_bit_cast(bf16x8, bw);
#pragma unroll
                    for (int mt = 0; mt < 2; ++mt) {
                        const LAS bf16_t* vp = Vs + (mt * 32 + c.qi) * 68 + sub * 32 + f * 16 + 4 * c.hi;
                        const u32x2 a0 = *(const LAS u32x2*)vp, a1 = *(const LAS u32x2*)(vp + 8);
                        const u32x4 aw = {a0.x, a0.y, a1.x, a1.y};
                        o[mt] = MFMA32(__builtin_bit_cast(bf16x8, aw), bfr, o[mt]);
                    }
                }
            }
            }
        }
        if (!more) break;
        ++it;
    }
    __syncthreads();
}
DI void attn_item(const Args& a, int l, int item, LAS unsigned char* lds, bool dry = false) {
    const int tid = otid(), wid = tid >> 6, lane = tid & 63, qi = lane & 31, hi = lane >> 5;
    const int qb = item >> 4, bg = item & 15, b = bg >> 1, g = bg & 1;
    const int hh = wid >> 1, half = wid & 1, head = g * 4 + hh;
    const int t0 = qb * 64, tw = t0 + half * 32, t = tw + qi, tq = half * 32 + qi;
    bf16_t* PROJ = (bf16_t*)(a.ws + WS_PROJ);
    LAS float* imp = (LAS float*)(lds + AT_IMP);
    LAS unsigned long long* selm = (LAS unsigned long long*)(lds + AT_SEL);
    LAS float* linv = (LAS float*)(lds + AT_LINV);
    for (int i = tid; i < 16384; i += 512) imp[i] = 0.f;
    const size_t qrow = (size_t)b * SEQ + t;
    AttnCtx c; c.nocompute = false;
#ifdef DRY_NOCOMPUTE
    c.nocompute = dry;
#endif
    c.t = t; c.tw = tw; c.qi = qi; c.hi = hi; c.tid = tid; c.lds = lds; c.mymask = 0ull; c.inv = 0.f;
    c.ncv = t >= 31 ? (t - 15) >> 4 : 0; c.ncvw = (tw + 16) >> 4; c.ncvmin = tw >= 31 ? (tw - 15) >> 4 : 0; c.impw = imp + (hh * 64 + tq) * 64;
    {
        const bf16_t* qp = PROJ + qrow * PP + C_Q + head * 64 + 8 * hi;
        float qf[4][8]; float ss = 0.f;
#pragma unroll
        for (int st = 0; st < 4; ++st) { unpack8(*(const u32x4*)(qp + 16 * st), qf[st]);
#pragma unroll
            for (int j = 0; j < 8; ++j) ss += qf[st][j] * qf[st][j]; }
        ss += __shfl_xor(ss, 32);
        const float sc = rsqrtf(ss * (1.f / 64.f) + 1e-6f) * 0.125f * 1.4426950408889634f;
        const float* qg = a.in[I_QGAIN] + l * 64 + 8 * hi;
#pragma unroll
        for (int st = 0; st < 4; ++st) {
#pragma unroll
            for (int j = 0; j < 8; ++j) qf[st][j] *= sc * qg[16 * st + j];
            c.q[st] = __builtin_bit_cast(bf16x8, pack8(qf[st]));
        }
    }
    const float g_c = bf1(PROJ[qrow * PP + C_NG + head * 3 + 0]), g_s = bf1(PROJ[qrow * PP + C_NG + head * 3 + 1]), g_w = bf1(PROJ[qrow * PP + C_NG + head * 3 + 2]);
    f32x16 ot[2], ob[2];
#pragma unroll
    for (int i = 0; i < 16; ++i) { ot[0][i] = 0.f; ot[1][i] = 0.f; ob[0][i] = 0.f; ob[1][i] = 0.f; }
    __syncthreads();
    {
        const int ntc = (((t0 + 48) >> 4) + 63) >> 6;
        const unsigned long long cm = (1ull << ntc) - 1ull;
        const bf16_t* kc = (const bf16_t*)(a.ws + WS_KCN) + (size_t)bg * 256 * 64;
        const bf16_t* vct = (const bf16_t*)(a.ws + WS_VCT) + (size_t)bg * 64 * 256;
        float lsum = 0.f;
        attn_branch<1>(c, cm, kc, 64, vct, 256, ob, lsum);
        lsum += __shfl_xor(lsum, 32);
        const float inv = lsum > 0.f ? 1.f / lsum : 0.f;
        if (hi == 0) linv[hh * 64 + tq] = inv;
        const float sc = g_c * inv;
#pragma unroll
        for (int i = 0; i < 16; ++i) { ot[0][i] += ob[0][i] * sc; ot[1][i] += ob[1][i] * sc; ob[0][i] = 0.f; ob[1][i] = 0.f; }
    }
    __syncthreads();
    if (qb < 16) { if (lane < 8) selm[wid * 8 + lane] = (2ull << qb) - 1ull; }
    else
    for (int k = 0; k < 8; ++k) {
        const int tk = wid * 8 + k;
        float val = (imp[(0 * 64 + tk) * 64 + lane] * linv[tk] + imp[(1 * 64 + tk) * 64 + lane] * linv[64 + tk]) + (imp[(2 * 64 + tk) * 64 + lane] * linv[128 + tk] + imp[(3 * 64 + tk) * 64 + lane] * linv[192 + tk]);
        const bool causal = lane <= qb, forced = (lane == 0) || (lane == qb) || (lane == qb - 1);
        val = causal ? val + (forced ? 1000.f : 0.f) : -1.f;
        int rank = 0;
#pragma unroll
        for (int j = 0; j < 64; ++j) { const float vj = __builtin_bit_cast(float, __builtin_amdgcn_readlane(__builtin_bit_cast(int, val), j)); rank += (vj > val || (vj == val && j < lane)) ? 1 : 0; }
        const unsigned long long mk = __ballot(rank < 16 && causal);
        if (lane == 0) selm[tk] = mk;
    }
    __syncthreads();
    {
        c.mymask = selm[tq];
        const unsigned long long all = selm[lane];
        unsigned long long um = 0ull;
        for (int j = 0; j <= qb; ++j) if (__ballot((all >> j) & 1ull) != 0ull) um |= 1ull << j;
        float lsum = 0.f;
        attn_branch<2>(c, um, PROJ + (size_t)b * SEQ * PP + C_KS + g * 64, PP, (const bf16_t*)(a.ws + WS_VST) + (size_t)bg * 64 * SEQ, SEQ, ob, lsum);
        lsum += __shfl_xor(lsum, 32);
        const float sc = lsum > 0.f ? g_s / lsum : 0.f;
#pragma unroll
        for (int i = 0; i < 16; ++i) { ot[0][i] += ob[0][i] * sc; ot[1][i] += ob[1][i] * sc; ob[0][i] = 0.f; ob[1][i] = 0.f; }
    }
    {
        const int jlo = qb >= 8 ? qb - 8 : 0;
        const unsigned long long wm = ((qb == 63 ? ~0ull : ((1ull << (qb + 1)) - 1ull)) >> jlo) << jlo;
        float lsum = 0.f;
        attn_branch<3>(c, wm, PROJ + (size_t)b * SEQ * PP + C_KW + g * 64, PP, (const bf16_t*)(a.ws + WS_VWT) + (size_t)bg * 64 * SEQ, SEQ, ob, lsum);
        lsum += __shfl_xor(lsum, 32);
        const float sc = lsum > 0.f ? g_w / lsum : 0.f;
#pragma unroll
        for (int i = 0; i < 16; ++i) { ot[0][i] += ob[0][i] * sc; ot[1][i] += ob[1][i] * sc; }
    }
    if (!dry || a.ph_hi == 12345) {
        bf16_t* op = PROJ + qrow * PP + C_Q + head * 64 + 4 * hi;
#pragma unroll
        for (int mt = 0; mt < 2; ++mt)
#pragma unroll
            for (int gq = 0; gq < 4; ++gq) { u32x2 w; w.x = pk2(ot[mt][4 * gq], ot[mt][4 * gq + 1]); w.y = pk2(ot[mt][4 * gq + 2], ot[mt][4 * gq + 3]); *(u32x2*)(op + mt * 32 + gq * 8) = w; }
    }
    __syncthreads();
}
#ifndef SCAN_RPL
#define SCAN_RPL 2
#endif
DI void phase_mix(const Args& a, int l, LAS unsigned char* lds) {
    const int nscan = 128;
    if ((int)blockIdx.x < nscan) {
#ifdef DUPSCAN
        for (int rep = 0; rep < 2; ++rep)
#endif
        { scan_bh2(a, l, blockIdx.x >> 1, blockIdx.x & 1, lds); }
        if (gridDim.x - nscan == 128) { const int sb = blockIdx.x, xcd = sb & 7, slot = sb >> 3; attn_item(a, l, slot * 16 + 2 * xcd, lds); }
    } else { const int na = gridDim.x - nscan;
#ifdef DUPATTN
        for (int it = blockIdx.x - nscan; it < 1024; it += na) attn_item(a, l, it, lds, true);
#endif
        if (na == 128) {
            const int ab = blockIdx.x - nscan, xcd = ab & 7, slot = ab >> 3;
            for (int r = 0; r < 8; ++r) {
                const int bg = 2 * xcd + (r >> 2), rr = r & 3;
                const int qb = rr == 0 ? 63 - slot : rr == 1 ? slot : rr == 2 ? 47 - slot : 16 + slot;
                if (r == 1) continue;
                attn_item(a, l, qb * 16 + bg, lds);
            }
        } else { for (int it = blockIdx.x - nscan; it < 1024; it += na) attn_item(a, l, it, lds); } }
}

DI void post_item(const Args& a, int l, int item, LAS unsigned char* lds) {
    const int tid = otid(), wid = tid >> 6, lane = tid & 63, fr = lane & 15, fq = lane >> 4;
    const int b = item >> 6, t0 = (item & 63) * 64;
    bf16_t* PROJ = (bf16_t*)(a.ws + WS_PROJ); const bf16_t* PREP = (const bf16_t*)(a.ws + WS_PREP); const bf16_t* W = (const bf16_t*)(a.ws + WS_W);
    LAS bf16_t* A_g = (LAS bf16_t*)lds; LAS bf16_t* z_s = (LAS bf16_t*)(lds + 17408);
    const float* mu = a.in[I_TOKMIX] + l * 1792;
    {
        const int token = tid >> 3, part = tid & 7; const size_t row = (size_t)b * SEQ + t0 + token; const bool hp = (t0 + token) > 0;
#pragma unroll
        for (int hf = 0; hf < 2; ++hf) {
            float v[8]; const int cc = part * 16 + hf * 8;
            lerp8(PROJ + row * PP + C_GL + cc, PROJ + (row - 1) * PP + C_GL + cc, hp, mu + (C_GL - C_R) + cc, v);
#pragma unroll
            for (int i = 0; i < 8; ++i) v[i] = sigm(v[i]);
            *(LAS u32x4*)(A_g + token * 136 + cc) = pack8(v);
        }
    }
    {
        const int cgp = tid & 63, head = cgp >> 3, k0 = (cgp & 7) * 8, c = cgp * 8;
        float rk[8], lw[8], lb[8];
        {
            const float* srcs[3] = {a.in[I_RK] + l * 512 + c, a.in[I_LNW] + l * 512 + c, a.in[I_LNB] + l * 512 + c};
            float* dsts[3] = {rk, lw, lb};
#pragma unroll
            for (int q = 0; q < 3; ++q) { const f32x4 t0v = *(const f32x4*)srcs[q], t1v = *(const f32x4*)(srcs[q] + 4);
#pragma unroll
                for (int i = 0; i < 4; ++i) { dsts[q][i] = t0v[i]; dsts[q][4 + i] = t1v[i]; } }
        }
        u32x4 raw[4];
        auto load_unit = [&](int u) {
            const int token = u * 8 + (tid >> 6); const size_t row = (size_t)b * SEQ + t0 + token;
            raw[0] = *(const u32x4*)((const bf16_t*)(a.ws + WS_Y) + row * 512 + c);
            const bf16_t* ip = PREP + ((size_t)(b * 8 + head) * SEQ + t0 + token) * 192 + k0;
            raw[1] = *(const u32x4*)ip; raw[2] = *(const u32x4*)(ip + 64); raw[3] = *(const u32x4*)(ip + 128);
        };
        load_unit(0);
#pragma unroll 1
        for (int u = 0; u < 8; ++u) {
            const int token = u * 8 + (tid >> 6);
            float y[8], r[8], k[8], v[8];
            unpack8(raw[0], y); unpack8(raw[1], r); unpack8(raw[2], k); unpack8(raw[3], v);
            if (u + 1 < 8) load_unit(u + 1);
            float sm = 0.f;
#pragma unroll
            for (int i = 0; i < 8; ++i) sm += y[i];
            const float mean = red8(sm) * (1.f / 64.f);
            float sv = 0.f;
#pragma unroll
            for (int i = 0; i < 8; ++i) { y[i] -= mean; sv += y[i] * y[i]; }
            const float rstd = rsqrtf(red8(sv) * (1.f / 64.f) + 64e-5f);
            float dot = 0.f;
#pragma unroll
            for (int i = 0; i < 8; ++i) dot += r[i] * k[i] * rk[i];
            dot = red8(dot);
            float z[8];
#pragma unroll
            for (int i = 0; i < 8; ++i) z[i] = y[i] * rstd * lw[i] + lb[i] + dot * v[i];
            *(LAS u32x4*)(z_s + token * 512 + c) = pack8(z);
        }
    }
    __syncthreads();
    {
        f32x4 acc[4][4];
#pragma unroll
        for (int m = 0; m < 4; ++m)
#pragma unroll
            for (int n = 0; n < 4; ++n) acc[m][n] = (f32x4){0.f, 0.f, 0.f, 0.f};
#pragma unroll
        for (int ks = 0; ks < 4; ++ks) {
            bf16x8 ag[4];
#pragma unroll
            for (int m = 0; m < 4; ++m) ag[m] = *(const LAS bf16x8*)(A_g + (m * 16 + fr) * 136 + ks * 32 + fq * 8);
#pragma unroll
            for (int n = 0; n < 4; ++n) {
                const bf16x8 bgf = *(const bf16x8*)(W + W_GL + (size_t)(wid * 64 + n * 16 + fr) * 128 + ks * 32 + fq * 8);
#pragma unroll
                for (int m = 0; m < 4; ++m) acc[m][n] = MFMA16(ag[m], bgf, acc[m][n]);
            }
        }
#pragma unroll
        for (int m = 0; m < 4; ++m)
#pragma unroll
            for (int n = 0; n < 4; ++n)
#pragma unroll
                for (int r = 0; r < 4; ++r) { const int idx = (m * 16 + fq * 4 + r) * 512 + wid * 64 + n * 16 + fr; z_s[idx] = tobf(bf1(z_s[idx]) * acc[m][n][r]); }
    }
    __syncthreads();
#pragma unroll
    for (int u = 0; u < 8; ++u) {
        const int id = u * 512 + tid, token = id >> 6, cgp = id & 63;
        *(u32x4*)(PROJ + ((size_t)b * SEQ + t0 + token) * PP + C_R + cgp * 8) = *(const LAS u32x4*)(z_s + token * 512 + cgp * 8);
    }
    __syncthreads();
}

#ifndef PHMASK
#define PHMASK 0x3ff
#endif
#define PHEN(k) ((PHMASK >> (k)) & 1)
__global__ void __launch_bounds__(512, 2) fwd_kernel(Args a) {
    extern __shared__ __attribute__((aligned(16))) unsigned char lds_raw[];
    LAS unsigned char* lds = (LAS unsigned char*)lds_raw;
    cg::grid_group grid = cg::this_grid();
    volatile LAS unsigned* xst = (volatile LAS unsigned*)(lds + LDS_BYTES - 16);
    if (threadIdx.x == 0) { xst[0] = 0u; xst[1] = 0u; }
    __syncthreads();
    const XcdBarrier xb = xcd_barrier_post((unsigned*)(a.ws + WS_BAR), xst);
#pragma unroll 1
    for (int ph = a.ph_lo; ph < a.ph_hi; ++ph) {
        const int l = ph / 10, p = ph % 10;
        if (p == 7) continue;
        if (ph > a.ph_lo) { if (a.ph_hi == 12345) grid.sync(); else xcd_barrier(xb); }
        { size_t z_ = 0; asm volatile("" : "+s"(z_)); a.ws = a.ws + z_; a.out = a.out + z_; }
        bf16_t* W = (bf16_t*)(a.ws + WS_W);
        bf16_t* PROJ = (bf16_t*)(a.ws + WS_PROJ);
#ifdef DUPMASK
        const int nrep = ((DUPMASK >> p) & 1) ? 2 : 1;
#else
        const int nrep = 1;
#endif
#pragma unroll 1
        for (int rep = 0; rep < nrep; ++rep) {
        if (rep) grid.sync();
        if (PHEN(0) && p == 0) { phase_conv(a, l, lds); __syncthreads(); }
        else if (PHEN(1) && p == 1) {
            pg8::Gemm g{(const bf16_t*)(a.ws + WS_U), W + W_IN, M_TOK, NPROJ_P, DM, DM}; pg8::StaticOrder S; S.init(M_TOK, NPROJ_P, gridDim.x, (int)blockIdx.x);
            pg8::EpiProj E{PROJ, (uint8_t*)(a.ws + WS_GATE), l == 0 ? nullptr : (const float*)(a.ws + WS_SS) + M_TOK};
            pg8::gemm_phase<pg8::EpiProj, pg8::StaticOrder, true, true>(lds, g, S, E);
        }
        else if (PHEN(2) && p == 2) phase_prep(a, l, lds);
        else if (PHEN(3) && p == 3) phase_mix(a, l, lds);
        else if (PHEN(4) && p == 4) { for (int it = blockIdx.x; it < 512; it += gridDim.x) post_item(a, l, it, lds); }
        else if (PHEN(5) && p == 5) {
            { pg8::Gemm g{PROJ + C_Q, W + W_A, M_TOK, DM, 512, PP}; pg8::StaticOrder S; S.init(M_TOK, DM, gridDim.x, (int)blockIdx.x);
              pg8::EpiMerge<false> E{(bf16_t*)(a.ws + WS_MERGED), (const uint8_t*)(a.ws + WS_GATE)};
              pg8::gemm_phase<pg8::EpiMerge<false>, pg8::StaticOrder, true, true>(lds, g, S, E); }
            { pg8::Gemm g{PROJ + C_R, W + W_B, M_TOK, DM, 512, PP}; pg8::StaticOrder S; S.init(M_TOK, DM, gridDim.x, (int)blockIdx.x);
              pg8::EpiMerge<true> E{(bf16_t*)(a.ws + WS_MERGED), (const uint8_t*)(a.ws + WS_GATE)};
              pg8::gemm_phase<pg8::EpiMerge<true>, pg8::StaticOrder, true, true>(lds, g, S, E); }
        }
        else if (PHEN(6) && p == 6) {
            pg8::Gemm g{(const bf16_t*)(a.ws + WS_MERGED), W + W_OUT, M_TOK, DM, DM, DM}; pg8::StaticOrder S; S.init(M_TOK, DM, gridDim.x, (int)blockIdx.x);
            pg8::EpiResF32 E{l == 0 ? a.in[I_X] : a.out, a.out, (bf16_t*)(a.ws + WS_HN), a.in[I_FFNNORM] + l * DM, (float*)(a.ws + WS_SS) + (l == 0 ? 0 : 2 * M_TOK)};
            pg8::gemm_phase<pg8::EpiResF32, pg8::StaticOrder, true, true>(lds, g, S, E);
        }
        else if (PHEN(7) && p == 7) phase_norm2(a, l);
        else if (PHEN(8) && p == 8) {
            pg8::Gemm g{(const bf16_t*)(a.ws + WS_HN), W + W_UP, M_TOK, 4096, DM, DM}; pg8::StaticOrder S; S.init(M_TOK, 4096, gridDim.x, (int)blockIdx.x);
            pg8::EpiRelu2 E{(bf16_t*)(a.ws + WS_H), (const float*)(a.ws + WS_SS) + (l == 0 ? 0 : 2 * M_TOK)};
            pg8::gemm_phase<pg8::EpiRelu2, pg8::StaticOrder, true, true>(lds, g, S, E);
        }
        else if (PHEN(9)) {
            pg8::Gemm g{(const bf16_t*)(a.ws + WS_H), W + W_DOWN, M_TOK, DM, 4096, 4096}; pg8::StaticOrder S; S.init(M_TOK, DM, gridDim.x, (int)blockIdx.x);
            pg8::EpiResF32 E{a.out, a.out, l == 0 ? (bf16_t*)(a.ws + WS_U) : nullptr, a.in[I_MIXNORM] + DM, (float*)(a.ws + WS_SS) + M_TOK};
            pg8::gemm_phase<pg8::EpiResF32, pg8::StaticOrder, true, true>(lds, g, S, E);
        }
        }
    }
}

#ifndef N_PHASE_LAUNCH
#define N_PHASE_LAUNCH 20
#endif
extern "C" void kernel_launch(void* const* d_in, const int* in_sizes, int n_in, void* d_out, int out_size, void* d_ws, size_t ws_size, hipStream_t stream) {
    static int grid = 0;
    if (grid == 0) {
        int dev = 0, cus = 0, per_cu = 0;
        (void)hipGetDevice(&dev);
        (void)hipDeviceGetAttribute(&cus, hipDeviceAttributeMultiprocessorCount, dev);
        if (hipFuncSetAttribute((const void*)fwd_kernel, hipFuncAttributeMaxDynamicSharedMemorySize, LDS_BYTES) != hipSuccess) { fprintf(stderr, "hipFuncSetAttribute failed\n"); grid = -1; return; }
        (void)hipOccupancyMaxActiveBlocksPerMultiprocessor(&per_cu, (const void*)fwd_kernel, 512, LDS_BYTES);
        if (per_cu < 1) { fprintf(stderr, "occupancy query says %d blocks per CU\n", per_cu); per_cu = 1; }
        (void)hipGetLastError();
        grid = cus;
        if (ws_size < 502 * MiB) { fprintf(stderr, "workspace too small: %zu\n", ws_size); grid = -1; return; }
    }
    if (grid < 0) return;
    if (hipMemsetAsync((char*)d_ws + WS_BAR, 0, XCD_BAR_WORDS * 4, stream) != hipSuccess) { fprintf(stderr, "memset of the barrier words failed\n"); return; }
    Args a{};
    for (int i = 0; i < 25; ++i) a.in[i] = (const float*)d_in[i];
    a.out = (float*)d_out; a.ws = (unsigned char*)d_ws;
    for (int lo = 0; lo < 20; lo += N_PHASE_LAUNCH) {
        a.ph_lo = lo; a.ph_hi = lo + N_PHASE_LAUNCH > 20 ? 20 : lo + N_PHASE_LAUNCH;
        void* args[] = {&a};
        hipError_t e;
        if (N_PHASE_LAUNCH > 1) e = hipLaunchCooperativeKernel((const void*)fwd_kernel, dim3(grid), dim3(512), args, LDS_BYTES, stream);
        else e = hipLaunchKernel((const void*)fwd_kernel, dim3(grid), dim3(512), args, LDS_BYTES, stream);
        if (e != hipSuccess) { fprintf(stderr, "launch failed: %s\n", hipGetErrorString(e)); break; }
    }
}
```

```cpp
#include <hip/hip_runtime.h>
#include <hip/hip_cooperative_groups.h>
#include <cstdio>
#include <cstdint>
namespace cg = cooperative_groups;
namespace pg8 {
#define PG8_LAS __attribute__((address_space(3)))
typedef unsigned short bf16_t;
typedef short bf16x8 __attribute__((ext_vector_type(8)));
typedef float f32x4 __attribute__((ext_vector_type(4)));
typedef unsigned u32x4 __attribute__((ext_vector_type(4)));
constexpr int BM = 256, BK = 64, HALF = 128, HTB = HALF * BK * 2  , STAGE_BYTES = 8 * HTB, NXCD = 8, WGM = 8;

__host__ __device__ __forceinline__ int lds_byte(int r, int c) { const int st = (r >> 4) * 2 + (c >> 5), rr = r & 15, cc = c & 31, ob = rr * 64 + cc * 2; return st * 1024 + (ob ^ (((ob >> 9) & 1) << 5)); }
__host__ __device__ __forceinline__ void stage_rc(int b, int& R, int& C) { const int st = b / 1024, sb = b % 1024, swz = sb ^ (((sb >> 9) & 1) << 5); R = (st >> 1) * 16 + swz / 64; C = (st & 1) * 32 + (swz % 64) / 2; }
__host__ __device__ __forceinline__ int perm32(int rho) { const int n = rho >> 4, i = rho & 15; return 8 * (i >> 2) + 4 * n + (i & 3); }

struct Unit { int pm, pn; };
struct Gemm { const bf16_t* A; const bf16_t* Bt; int M, N, K, lda; };

struct StaticOrder {
    int nM, nN, nwg, G, c;
    __host__ __device__ void init(int M, int N, int G_, int c_) { nM = M / BM; nN = N / BM; nwg = nM * nN; G = G_; c = c_; }
    __host__ __device__ bool next(int i, Unit& u) const {
        const long L = (long)i * G + c; if (L >= nwg) return false;
        int wgid = (int)L; { const int q = nwg / NXCD, r = nwg % NXCD, xcd = wgid % NXCD, off = wgid / NXCD; wgid = (xcd < r ? xcd * (q + 1) : r * (q + 1) + (xcd - r) * q) + off; }
        const int nig = WGM * nN, gid = wgid / nig, fm = gid * WGM, gsz = (nM - fm) < WGM ? (nM - fm) : WGM;
        u.pm = fm + ((wgid % nig) % gsz); u.pn = (wgid % nig) / gsz; return true;
    }
    __device__ __forceinline__ void a_ready(const Unit&) const {}
    __device__ __forceinline__ void done(const Unit&) const {}
};
__device__ __forceinline__ unsigned cvt_pk_bf16(float lo, float hi) { unsigned r; asm volatile("v_cvt_pk_bf16_f32 %0, %1, %2" : "=v"(r) : "v"(lo), "v"(hi)); return r; }
template <class Epi, class Sched, bool ALIGN_EPI = false, bool SP2 = false>
__device__ __forceinline__ void gemm_phase(PG8_LAS unsigned char* lds, const Gemm g, const Sched& S, const Epi& E) {
    int tid_ = threadIdx.x; asm volatile("" : "+v"(tid_));
    const int tid = tid_, wid = __builtin_amdgcn_readfirstlane(tid >> 6), lane = tid & 63, wr = wid >> 2, wc = wid & 3, fr = lane & 15, fq = lane >> 4;
    const int K = g.K, nt = K / BK;
    unsigned voffA[2], voffB[2];
#pragma unroll
    for (int i = 0; i < 2; ++i) { int R, C; stage_rc(tid * 16 + i * 8192, R, C); const int Rb = Epi::PERM ? ((R & ~31) + perm32(R & 31)) : R;
        voffA[i] = (unsigned)(R * g.lda + C) * 2u; voffB[i] = (unsigned)(Rb * K + C) * 2u; }
    const size_t kstep = (size_t)(BK * 2);
    const size_t hstepB = (size_t)HALF * K * 2, hstepA = (size_t)HALF * g.lda * 2;
    const size_t tstepA = 2 * hstepA, tstepB = 2 * hstepB;
    const unsigned ldsw = (unsigned)wid * 1024u;
    const int aoff = lds_byte(wr * 64 + fr, fq * 8), boff = lds_byte(wc * 32 + fr, fq * 8);
#define PG8_SA(b, h) (((b) * 2 + (h)) * HTB)
#define PG8_SB(b, h) ((4 + (b) * 2 + (h)) * HTB)
#define PG8_STAGE(bufoff, gbase, voff) do { _Pragma("unroll") for (int _i = 0; _i < 2; ++_i) \
        __builtin_amdgcn_global_load_lds((const unsigned*)((const char*)(gbase) + (voff)[_i]), (PG8_LAS unsigned*)(lds + (bufoff) + ldsw + _i * 8192), 16, 0, 0); } while (0)
#define PG8_LDA(dst, b, h) do { _Pragma("unroll") for (int m = 0; m < 4; ++m) _Pragma("unroll") for (int k = 0; k < 2; ++k) dst[m][k] = *(const PG8_LAS bf16x8*)(lds + PG8_SA(b, h) + aoff + m * 2048 + k * 1024); } while (0)
#define PG8_LDB(dst, b, h) do { _Pragma("unroll") for (int n = 0; n < 2; ++n) _Pragma("unroll") for (int k = 0; k < 2; ++k) dst[n][k] = *(const PG8_LAS bf16x8*)(lds + PG8_SB(b, h) + boff + n * 2048 + k * 1024); } while (0)
#define PG8_MMA(ai, bj, At, Bt) do { __builtin_amdgcn_s_setprio(1); _Pragma("unroll") for (int m = 0; m < 4; ++m) _Pragma("unroll") for (int n = 0; n < 2; ++n) _Pragma("unroll") for (int k = 0; k < 2; ++k) \
        acc[ai][bj][m][n] = __builtin_amdgcn_mfma_f32_16x16x32_bf16(Bt[n][k], At[m][k], acc[ai][bj][m][n], 0, 0, 0); __builtin_amdgcn_s_setprio(0); } while (0)
#define PG8_WAIT_V(n) asm volatile("s_waitcnt vmcnt(" #n ")" ::: "memory")
#define PG8_WAIT_L(n) asm volatile("s_waitcnt lgkmcnt(" #n ")" ::: "memory")
#define PG8_BAR __builtin_amdgcn_s_barrier()
#define PG8_SCHED __builtin_amdgcn_sched_barrier(0)
    Unit cur, nxt; int ui = 0;
    if (!S.next(0, cur)) return;
    f32x4 acc[2][2][4][2];
#pragma unroll
    for (int a = 0; a < 2; ++a)
#pragma unroll
        for (int b = 0; b < 2; ++b)
#pragma unroll
            for (int m = 0; m < 4; ++m)
#pragma unroll
                for (int n = 0; n < 2; ++n) acc[a][b][m][n] = (f32x4){0.f, 0.f, 0.f, 0.f};
    bf16x8 At[4][2], B0[2][2], B1[2][2];
    const char* cA = (const char*)g.A + (size_t)cur.pm * tstepA; const char* cB = (const char*)g.Bt + (size_t)cur.pn * tstepB;
    S.a_ready(cur);
    if constexpr (SP2) {
        PG8_STAGE(PG8_SB(0, 0), cB, voffB); PG8_STAGE(PG8_SB(0, 1), cB + hstepB, voffB); PG8_STAGE(PG8_SA(0, 0), cA, voffA); PG8_STAGE(PG8_SA(0, 1), cA + hstepA, voffA);
        if (wr == 1) PG8_BAR;
        PG8_WAIT_V(2); PG8_BAR;
        PG8_STAGE(PG8_SB(1, 0), cB + kstep, voffB); PG8_STAGE(PG8_SA(1, 0), cA + kstep, voffA); PG8_STAGE(PG8_SB(1, 1), cB + hstepB + kstep, voffB);
        PG8_WAIT_V(6); PG8_BAR;
    } else {
        PG8_STAGE(PG8_SB(0, 0), cB, voffB); PG8_STAGE(PG8_SA(0, 0), cA, voffA); PG8_STAGE(PG8_SB(0, 1), cB + hstepB, voffB); PG8_STAGE(PG8_SA(0, 1), cA + hstepA, voffA);
        if (wr == 1) PG8_BAR;
        PG8_WAIT_V(4); PG8_BAR;
        PG8_STAGE(PG8_SB(1, 0), cB + kstep, voffB); PG8_STAGE(PG8_SA(1, 0), cA + kstep, voffA); PG8_STAGE(PG8_SB(1, 1), cB + hstepB + kstep, voffB);
        PG8_WAIT_V(6); PG8_BAR;
    }
    for (;;) {
        const bool has_next = S.next(ui + 1, nxt);
        const char* nA = has_next ? (const char*)g.A + (size_t)nxt.pm * tstepA : cA; const char* nB = has_next ? (const char*)g.Bt + (size_t)nxt.pn * tstepB : cB;
        for (int t = 0; t < nt; t += 2) {
            const bool last = (t == nt - 2);
            const char* a1 = cA + (size_t)(t + 1) * kstep;
            const char* a2 = last ? nA : cA + (size_t)(t + 2) * kstep; const char* b2 = last ? nB : cB + (size_t)(t + 2) * kstep;
            const char* a3 = a2 + kstep; const char* b3 = b2 + kstep;
            if (last && has_next) S.a_ready(nxt);
            if constexpr (SP2) {
            PG8_LDB(B0, 0, 0); PG8_LDB(B1, 0, 1); PG8_SCHED; PG8_LDA(At, 0, 0); PG8_STAGE(PG8_SA(1, 1), a1 + hstepA, voffA);
            PG8_WAIT_V(8); PG8_WAIT_L(0); PG8_BAR; PG8_MMA(0, 0, At, B0); PG8_MMA(0, 1, At, B1); PG8_BAR; PG8_SCHED;
            PG8_LDA(At, 0, 1); PG8_STAGE(PG8_SB(0, 0), b2, voffB); PG8_STAGE(PG8_SB(0, 1), b2 + hstepB, voffB); PG8_STAGE(PG8_SA(0, 0), a2, voffA);
            PG8_WAIT_V(8); PG8_WAIT_L(0); PG8_BAR; PG8_MMA(1, 0, At, B0); PG8_MMA(1, 1, At, B1); PG8_BAR; PG8_SCHED;
            PG8_LDB(B0, 1, 0); PG8_LDB(B1, 1, 1); PG8_SCHED; PG8_LDA(At, 1, 0); PG8_STAGE(PG8_SA(0, 1), a2 + hstepA, voffA);
            PG8_WAIT_V(8); PG8_WAIT_L(0); PG8_BAR; PG8_MMA(0, 0, At, B0); PG8_MMA(0, 1, At, B1); PG8_BAR; PG8_SCHED;
            PG8_LDA(At, 1, 1); PG8_STAGE(PG8_SB(1, 0), b3, voffB); PG8_STAGE(PG8_SB(1, 1), b3 + hstepB, voffB); PG8_STAGE(PG8_SA(1, 0), a3, voffA);
            PG8_WAIT_V(8); PG8_WAIT_L(0); PG8_BAR; PG8_MMA(1, 0, At, B0); PG8_MMA(1, 1, At, B1); PG8_BAR; PG8_SCHED;
            } else {
            PG8_LDB(B0, 0, 0); PG8_SCHED; PG8_LDA(At, 0, 0); PG8_STAGE(PG8_SA(1, 1), a1 + hstepA, voffA);
            PG8_WAIT_L(8); PG8_BAR; PG8_WAIT_L(0); PG8_MMA(0, 0, At, B0); PG8_BAR; PG8_SCHED;
            PG8_LDB(B1, 0, 1); PG8_STAGE(PG8_SB(0, 0), b2, voffB);
            PG8_BAR; PG8_WAIT_L(0); PG8_MMA(0, 1, At, B1); PG8_BAR;
            PG8_LDA(At, 0, 1); PG8_STAGE(PG8_SA(0, 0), a2, voffA);
            PG8_BAR; PG8_WAIT_L(0); PG8_MMA(1, 0, At, B0); PG8_BAR; PG8_SCHED;
            PG8_STAGE(PG8_SB(0, 1), b2 + hstepB, voffB);
            PG8_WAIT_V(6); PG8_BAR; PG8_MMA(1, 1, At, B1); PG8_BAR;
            PG8_LDB(B0, 1, 0); PG8_SCHED; PG8_LDA(At, 1, 0); PG8_STAGE(PG8_SA(0, 1), a2 + hstepA, voffA);
            PG8_WAIT_L(8); PG8_BAR; PG8_WAIT_L(0); PG8_MMA(0, 0, At, B0); PG8_BAR; PG8_SCHED;
            PG8_LDB(B1, 1, 1); PG8_STAGE(PG8_SB(1, 0), b3, voffB);
            PG8_BAR; PG8_WAIT_L(0); PG8_MMA(0, 1, At, B1); PG8_BAR;
            PG8_LDA(At, 1, 1); PG8_STAGE(PG8_SA(1, 0), a3, voffA);
            PG8_BAR; PG8_WAIT_L(0); PG8_MMA(1, 0, At, B0); PG8_BAR; PG8_SCHED;
            PG8_STAGE(PG8_SB(1, 1), b3 + hstepB, voffB);
            PG8_WAIT_V(6); PG8_BAR; PG8_MMA(1, 1, At, B1); PG8_BAR;
            }
        }
        if constexpr (ALIGN_EPI) { if (wr == 0) PG8_BAR; }
        if constexpr (!Epi::AFTER_DRAIN) { E(acc, cur, wr, wc, fr, fq); S.done(cur); }
        if (!has_next) break;
#pragma unroll
        for (int a = 0; a < 2; ++a)
#pragma unroll
            for (int b = 0; b < 2; ++b)
#pragma unroll
                for (int m = 0; m < 4; ++m)
#pragma unroll
                    for (int n = 0; n < 2; ++n) acc[a][b][m][n] = (f32x4){0.f, 0.f, 0.f, 0.f};
        cur = nxt; cA = nA; cB = nB; ++ui;
        if constexpr (ALIGN_EPI) { if (wr == 1) PG8_BAR; }
    }
    PG8_WAIT_V(0);
    if constexpr (!ALIGN_EPI) { if (wr == 0) PG8_BAR; }
    PG8_BAR;
    if constexpr (Epi::AFTER_DRAIN) { E.fused(acc, cur, wr, wc, fr, fq, lds, wid, lane); S.done(cur); }
#undef PG8_SA
#undef PG8_SB
#undef PG8_STAGE
#undef PG8_LDA
#undef PG8_LDB
#undef PG8_MMA
#undef PG8_WAIT_V
#undef PG8_WAIT_L
#undef PG8_BAR
#undef PG8_SCHED
}
}

#define LAS __attribute__((address_space(3)))
#define DI __device__ __forceinline__
typedef unsigned short bf16_t;
typedef short bf16x8 __attribute__((ext_vector_type(8)));
typedef float f32x4 __attribute__((ext_vector_type(4)));
typedef float f32x2 __attribute__((ext_vector_type(2)));
typedef float f32x16 __attribute__((ext_vector_type(16)));
typedef unsigned u32x4 __attribute__((ext_vector_type(4)));
typedef unsigned u32x2 __attribute__((ext_vector_type(2)));
typedef __bf16 bf2_t __attribute__((ext_vector_type(2)));

DI int otid() { int t = threadIdx.x; asm volatile("" : "+v"(t)); return t; }
DI unsigned pk2(float a, float b) { f32x2 v = {a, b}; bf2_t r = __builtin_convertvector(v, bf2_t); return __builtin_bit_cast(unsigned, r); }
DI float bflo(unsigned w) { return __uint_as_float(w << 16); }
DI float bfhi(unsigned w) { return __uint_as_float(w & 0xffff0000u); }
DI float bf1(bf16_t h) { return __uint_as_float(((unsigned)h) << 16); }
DI bf16_t tobf(float x) { return (bf16_t)(pk2(x, 0.f) & 0xffffu); }
DI float sigm(float x) { return __builtin_amdgcn_rcpf(1.f + __expf(-x)); }
DI float tanh_fast(float x) { return 1.f - 2.f * __builtin_amdgcn_rcpf(1.f + __expf(2.f * x)); }
DI void unpack8(const u32x4 w, float* f) { f[0] = bflo(w.x); f[1] = bfhi(w.x); f[2] = bflo(w.y); f[3] = bfhi(w.y); f[4] = bflo(w.z); f[5] = bfhi(w.z); f[6] = bflo(w.w); f[7] = bfhi(w.w); }
DI u32x4 pack8(const float* f) { u32x4 w; w.x = pk2(f[0], f[1]); w.y = pk2(f[2], f[3]); w.z = pk2(f[4], f[5]); w.w = pk2(f[6], f[7]); return w; }
template <int CTRL> DI float dpp_add(float x) { return x + __builtin_bit_cast(float, __builtin_amdgcn_update_dpp(0, __builtin_bit_cast(int, x), CTRL, 0xf, 0xf, true)); }
DI float red4(float x) { x = dpp_add<0xB1>(x); x = dpp_add<0x4E>(x); return x; }
DI float red8(float x) { x = red4(x); x = dpp_add<0x141>(x); return x; }
DI float red16(float x) { x = red8(x); x = dpp_add<0x140>(x); return x; }
#define DPP_ADD2(a, b, ctrl) asm("s_nop 1\n\tv_add_f32_dpp %0, %0, %0 " ctrl " row_mask:0xf bank_mask:0xf bound_ctrl:1\n\tv_add_f32_dpp %1, %1, %1 " ctrl " row_mask:0xf bank_mask:0xf bound_ctrl:1" : "+v"(a), "+v"(b))
DI void red16x2(float& a, float& b) { DPP_ADD2(a, b, "quad_perm:[1,0,3,2]"); DPP_ADD2(a, b, "quad_perm:[2,3,0,1]"); DPP_ADD2(a, b, "row_half_mirror"); DPP_ADD2(a, b, "row_mirror"); }
DI float wave_sum(float v) {
#pragma unroll
    for (int o = 1; o < 64; o <<= 1) v += __shfl_xor(v, o);
    return v;
}
#define MFMA16(a, b, c) __builtin_amdgcn_mfma_f32_16x16x32_bf16((a), (b), (c), 0, 0, 0)
#define MFMA32(a, b, c) __builtin_amdgcn_mfma_f32_32x32x16_bf16((a), (b), (c), 0, 0, 0)

constexpr int M_TOK = 32768, DM = 1024, SEQ = 4096;
constexpr int PP = 3096;
constexpr int NPROJ = 5144, NPROJ_P = 5376;
constexpr int C_Q = 0, C_KC = 512, C_VC = 640, C_KS = 768, C_VS = 896, C_KW = 1024, C_VW = 1152, C_NG = 1280, C_R = 1304, C_K = 1816, C_V = 2328,
              C_WL = 2840, C_AL = 2904, C_GL = 2968, C_GA = 3096;
constexpr size_t MiB = 1u << 20;
constexpr size_t WS_BIASP = 0, WS_KCN = 64 * 1024, WS_VCT = WS_KCN + 512 * 1024, WS_SS = 2 * MiB, WS_BAR = 3 * MiB;
constexpr size_t WS_W = 4 * MiB, WS_PROJ = 36 * MiB, WS_GATE = 230 * MiB, WS_PREP = 294 * MiB, WS_VST = 486 * MiB, WS_VWT = 494 * MiB, WS_H = 36 * MiB;
constexpr size_t WS_U = WS_PREP, WS_MERGED = WS_PREP, WS_HN = WS_PREP + 64 * MiB;
constexpr size_t WS_Y = WS_PREP + 96 * MiB;
constexpr size_t W_IN = 0, W_A = 5505024, W_B = 6029312, W_OUT = 6553600, W_UP = 7602176, W_DOWN = 11796480, W_WL = 15990784, W_AL = 16023552, W_GL = 16056320,
                 W_C1 = 16121856, W_C2 = 16646144;
constexpr int LDS_BYTES = 155648;

struct Args { const float* in[25]; float* out; unsigned char* ws; int ph_lo, ph_hi; };
enum { I_X = 0, I_MIXNORM, I_WIN, I_QGAIN, I_KGAIN, I_CMPPOS, I_CMPW1, I_CMPW2, I_WATTN, I_TOKMIX, I_W0, I_WLORA, I_A0, I_ALORA, I_GLORA, I_KK, I_KA, I_RK, I_LNW, I_LNB,
       I_WRWKV, I_WOUT, I_FFNNORM, I_WUP, I_WDOWN };

#define XB_TMO      128
#define XB_XCNT(j)  (256  + 64 * (j))
#define XB_XSUB(j)  (1280 + 64 * (j))
#define XB_XGEN(j)  (2304 + 64 * (j))
#define XB_TOP      3328
#define XB_TOPGEN   3392
#define XCD_BAR_WORDS 3456
#define XB_SPIN_CAP (1u << 18)

__device__ __forceinline__ unsigned xb_ld(unsigned* p)              { return __hip_atomic_load(p, __ATOMIC_RELAXED, __HIP_MEMORY_SCOPE_AGENT); }
__device__ __forceinline__ unsigned xb_add(unsigned* p, unsigned v) { return __hip_atomic_fetch_add(p, v, __ATOMIC_RELAXED, __HIP_MEMORY_SCOPE_AGENT); }
__device__ __forceinline__ unsigned xb_xcc_id() { return (unsigned)__builtin_amdgcn_s_getreg((3 << 11) | 20) & 0xFu; }
#define XB_SPIN(cond, bar) do { unsigned _sp = 0; while (cond) { __builtin_amdgcn_s_sleep(1); \
    if ((++_sp & 255u) == 0u) { if (xb_ld(&(bar)[XB_TMO])) break; if (_sp > XB_SPIN_CAP) { atomicAdd(&(bar)[XB_TMO], 1u); break; } } } } while (0)

struct XcdBarrier {
    unsigned* bar; unsigned x;
    volatile LAS unsigned* st;
};

__device__ __forceinline__ XcdBarrier xcd_barrier_post(unsigned* bar, volatile LAS unsigned* st) {
    XcdBarrier b; b.bar = bar; b.x = xb_xcc_id(); b.st = st;
    if (threadIdx.x == 0) (void)xb_add(&bar[XB_XCNT(b.x)], 1u);
    return b;
}
__device__ __forceinline__ void xcd_barrier_complete(unsigned* bar, unsigned x, unsigned& nloc, unsigned& nx) {
    const unsigned G = gridDim.x * gridDim.y * gridDim.z;
    unsigned sum, cnt, mine, sp = 0u;
    for (;;) {
        sum = 0u; cnt = 0u; mine = 0u;
#pragma unroll
        for (unsigned j = 0; j < 16; ++j) { const unsigned c = xb_ld(&bar[XB_XCNT(j)]); sum += c; cnt += (c > 0u) ? 1u : 0u; mine = (j == x) ? c : mine; }
        if (sum == G) break;
        __builtin_amdgcn_s_sleep(1);
        if ((++sp & 255u) == 0u) { if (xb_ld(&bar[XB_TMO])) break; if (sp > XB_SPIN_CAP) { atomicAdd(&bar[XB_TMO], 1u); break; } }
    }
    nloc = mine > 0u ? mine : 1u; nx = cnt > 0u ? cnt : 1u;
}

__device__ __forceinline__ void xcd_barrier(const XcdBarrier& b) {
    asm volatile("s_waitcnt vmcnt(0)" ::: "memory");
    __syncthreads();
    if (threadIdx.x == 0) {
        unsigned* bar = b.bar;
        __builtin_amdgcn_s_waitcnt(0);
        unsigned nloc = b.st[0], nx = b.st[1];
        if (nloc == 0u) { xcd_barrier_complete(bar, b.x, nloc, nx); b.st[0] = nloc; b.st[1] = nx; }
        const unsigned old = xb_add(&bar[XB_XSUB(b.x)], 1u);
        const unsigned gen = old / nloc;
        if (old + 1u == (gen + 1u) * nloc) {
            __builtin_amdgcn_fence(__ATOMIC_RELEASE, "agent");
            asm volatile("s_waitcnt vmcnt(0)" ::: "memory");
            const unsigned og = xb_add(&bar[XB_TOP], 1u);
            const unsigned tg = og / nx;
            if (og + 1u == (tg + 1u) * nx) xb_add(&bar[XB_TOPGEN], 1u);
            else XB_SPIN(xb_ld(&bar[XB_TOPGEN]) == tg, bar);
            __builtin_amdgcn_fence(__ATOMIC_ACQUIRE, "agent");
            xb_add(&bar[XB_XGEN(b.x)], 1u);
            asm volatile("s_waitcnt vmcnt(0)" ::: "memory");
        } else {
            XB_SPIN(xb_ld(&bar[XB_XGEN(b.x)]) == gen, bar);
            __builtin_amdgcn_fence(__ATOMIC_ACQUIRE, "agent");
            asm volatile("s_waitcnt vmcnt(0)" ::: "memory");
        }
    }
    __syncthreads();
}

namespace pg8 {
struct EpiProj {
    static constexpr bool PERM = true, AFTER_DRAIN = false;
    bf16_t* P; uint8_t* G; const float* ss;
    __device__ __forceinline__ void operator()(const f32x4 (&acc)[2][2][4][2], const Unit& u, int wr, int wc, int fr, int fq) const {
        const int row0 = u.pm * BM + wr * 64 + fr, col0 = u.pn * BM + wc * 32 + 8 * fq;
#pragma unroll
        for (int ai = 0; ai < 2; ++ai)
#pragma unroll
            for (int m = 0; m < 4; ++m) {
                const size_t row = (size_t)(row0 + ai * HALF + m * 16);
                const float rs = ss ? rsqrtf(ss[row] * (1.f / 1024.f) + 1e-6f) : 1.f;
#pragma unroll
                for (int bj = 0; bj < 2; ++bj) {
                    const int col = col0 + bj * HALF;
                    f32x4 v0 = acc[ai][bj][m][0] * rs, v1 = acc[ai][bj][m][1] * rs;
                    if (col < C_GA) {
                        if (col >= C_NG && col < C_R) {
#pragma unroll
                            for (int e = 0; e < 4; ++e) { v0[e] = sigm(v0[e]); v1[e] = sigm(v1[e]); }
                        }
                        ::u32x4 w; w.x = cvt_pk_bf16(v0[0], v0[1]); w.y = cvt_pk_bf16(v0[2], v0[3]); w.z = cvt_pk_bf16(v1[0], v1[1]); w.w = cvt_pk_bf16(v1[2], v1[3]);
                        *(::u32x4*)(P + row * PP + col) = w;
                    } else if (col < NPROJ) {
                        unsigned q[8];
#pragma unroll
                        for (int e = 0; e < 4; ++e) { q[e] = (unsigned)__builtin_rintf(sigm(v0[e]) * 255.f); q[4 + e] = (unsigned)__builtin_rintf(sigm(v1[e]) * 255.f); }
                        ::u32x2 w; w.x = q[0] | (q[1] << 8) | (q[2] << 16) | (q[3] << 24); w.y = q[4] | (q[5] << 8) | (q[6] << 16) | (q[7] << 24);
                        *(::u32x2*)(G + row * 2048 + (col - C_GA)) = w;
                    }
                }
            }
    }
};
template <bool SECOND> struct EpiMerge {
    static constexpr bool PERM = true, AFTER_DRAIN = false;
    bf16_t* O; const uint8_t* G;
    __device__ __forceinline__ void operator()(const f32x4 (&acc)[2][2][4][2], const Unit& u, int wr, int wc, int fr, int fq) const {
        const int row0 = u.pm * BM + wr * 64 + fr, col0 = u.pn * BM + wc * 32 + 8 * fq;
#pragma unroll
        for (int ai = 0; ai < 2; ++ai)
#pragma unroll
            for (int m = 0; m < 4; ++m) {
                const size_t row = (size_t)(row0 + ai * HALF + m * 16);
#pragma unroll
                for (int bj = 0; bj < 2; ++bj) {
                    const int col = col0 + bj * HALF;
                    const ::u32x2 gq = *(const ::u32x2*)(G + row * 2048 + (SECOND ? 1024 : 0) + col);
                    float v[8];
#pragma unroll
                    for (int e = 0; e < 4; ++e) { v[e] = acc[ai][bj][m][0][e] * ((float)((gq.x >> (8 * e)) & 255u) * (1.f / 255.f)); v[4 + e] = acc[ai][bj][m][1][e] * ((float)((gq.y >> (8 * e)) & 255u) * (1.f / 255.f)); }
                    ::u32x4* op = (::u32x4*)(O + row * 1024 + col);
                    if (SECOND) { const ::u32x4 t = *op; float tf[8]; unpack8(t, tf);
#pragma unroll
                        for (int e = 0; e < 8; ++e) v[e] += tf[e]; }
                    *op = pack8(v);
                }
                asm volatile("" ::: "memory");
            }
    }
};
struct EpiResF32 {
    static constexpr bool PERM = false, AFTER_DRAIN = false;
    const float* base; float* out; bf16_t* xn; const float* gain; float* ss;
    __device__ __forceinline__ void operator()(const f32x4 (&acc)[2][2][4][2], const Unit& u, int wr, int wc, int fr, int fq) const {
        const int row0 = u.pm * BM + wr * 64 + fr, col0 = u.pn * BM + wc * 32 + 4 * fq;
        f32x4 gv[2][2];
        if (xn) {
#pragma unroll
            for (int bj = 0; bj < 2; ++bj)
#pragma unroll
                for (int n = 0; n < 2; ++n) gv[bj][n] = *(const f32x4*)(gain + col0 + bj * HALF + n * 16);
        }
#pragma unroll
        for (int ai = 0; ai < 2; ++ai)
#pragma unroll
            for (int m = 0; m < 4; ++m) {
                const int row = row0 + ai * HALF + m * 16;
                const size_t off = (size_t)row * 1024 + col0;
                float sq = 0.f;
#pragma unroll
                for (int bj = 0; bj < 2; ++bj)
#pragma unroll
                    for (int n = 0; n < 2; ++n) {
                        const f32x4 b = *(const f32x4*)(base + off + bj * HALF + n * 16); const f32x4 o = b + acc[ai][bj][m][n];
                        *(f32x4*)(out + off + bj * HALF + n * 16) = o;
                        if (xn) { sq += (o[0] * o[0] + o[1] * o[1]) + (o[2] * o[2] + o[3] * o[3]); const f32x4 og = o * gv[bj][n];
                            ::u32x2 w; w.x = cvt_pk_bf16(og[0], og[1]); w.y = cvt_pk_bf16(og[2], og[3]); *(::u32x2*)(xn + off + bj * HALF + n * 16) = w; }
                    }
                if (xn) { sq += __shfl_xor(sq, 16); sq += __shfl_xor(sq, 32); if (fq == 0) atomicAdd(ss + row, sq); }
                asm volatile("" ::: "memory");
            }
    }
};
struct EpiRelu2 {
    static constexpr bool PERM = true, AFTER_DRAIN = false;
    bf16_t* O; const float* ss;
    __device__ __forceinline__ void operator()(const f32x4 (&acc)[2][2][4][2], const Unit& u, int wr, int wc, int fr, int fq) const {
        const int row0 = u.pm * BM + wr * 64 + fr, col0 = u.pn * BM + wc * 32 + 8 * fq;
#pragma unroll
        for (int ai = 0; ai < 2; ++ai)
#pragma unroll
            for (int m = 0; m < 4; ++m) {
                const size_t row = (size_t)(row0 + ai * HALF + m * 16);
                const float r2 = 1.f / (ss[row] * (1.f / 1024.f) + 1e-6f);
#pragma unroll
                for (int bj = 0; bj < 2; ++bj) {
                    f32x4 v0 = acc[ai][bj][m][0], v1 = acc[ai][bj][m][1];
#pragma unroll
                    for (int e = 0; e < 4; ++e) { const float a = fmaxf(v0[e], 0.f), b = fmaxf(v1[e], 0.f); v0[e] = a * a * r2; v1[e] = b * b * r2; }
                    ::u32x4 w; w.x = cvt_pk_bf16(v0[0], v0[1]); w.y = cvt_pk_bf16(v0[2], v0[3]); w.z = cvt_pk_bf16(v1[0], v1[1]); w.w = cvt_pk_bf16(v1[2], v1[3]);
                    *(::u32x4*)(O + row * 4096 + col0 + bj * HALF) = w;
                }
            }
    }
};
}

DI void tr_item(const float* __restrict__ W, int K, int N, bf16_t* WT, LAS float* scr, int item, int lane, int nblk) {
    const int kb = item / nblk, nb = item % nblk, k0 = 64 * kb, n0 = 32 * nb;
    const int nn = n0 + (lane & 31);
    float v[32];
#pragma unroll
    for (int i = 0; i < 32; ++i) { const int kk = 2 * i + (lane >> 5); v[i] = (nn < N) ? W[(size_t)(k0 + kk) * N + nn] : 0.f; }
#pragma unroll
    for (int i = 0; i < 32; ++i) { const int kk = 2 * i + (lane >> 5); scr[kk * 33 + (lane & 31)] = v[i]; }
    asm volatile("s_waitcnt lgkmcnt(0)" ::: "memory");
    const int c = lane & 7;
#pragma unroll
    for (int j = 0; j < 4; ++j) { const int n = (lane >> 3) + 8 * j; const LAS float* s = scr + (8 * c) * 33 + n;
        u32x4 o; o.x = pk2(s[0 * 33], s[1 * 33]); o.y = pk2(s[2 * 33], s[3 * 33]); o.z = pk2(s[4 * 33], s[5 * 33]); o.w = pk2(s[6 * 33], s[7 * 33]);
        *(u32x4*)(WT + (size_t)(n0 + n) * K + k0 + 8 * c) = o; }
    asm volatile("s_waitcnt lgkmcnt(0)" ::: "memory");
}
DI void conv_mat(const float* W, int K, int N, int NP, bf16_t* WT, LAS float* scr, int gw, int NGW, int lane) {
    const int nblk = NP / 32, nit = (K / 64) * nblk;
    for (int it = gw; it < nit; it += NGW) tr_item(W, K, N, WT, scr, it, lane, nblk);
}
DI void rms_row(const float* x, const float* gain, bf16_t* o, int lane) {
    const f32x4* xr = (const f32x4*)x + lane; const f32x4* gr = (const f32x4*)gain + lane;
    f32x4 v[4]; float s = 0.f;
#pragma unroll
    for (int j = 0; j < 4; ++j) { v[j] = xr[64 * j]; s += (v[j].x * v[j].x + v[j].y * v[j].y) + (v[j].z * v[j].z + v[j].w * v[j].w); }
    const float rstd = rsqrtf(wave_sum(s) * (1.f / 1024.f) + 1e-6f);
    u32x2* op = (u32x2*)o + lane;
#pragma unroll
    for (int j = 0; j < 4; ++j) { const f32x4 g = gr[64 * j]; u32x2 w; w.x = pk2(v[j].x * rstd * g.x, v[j].y * rstd * g.y); w.y = pk2(v[j].z * rstd * g.z, v[j].w * rstd * g.w); op[64 * j] = w; }
}
DI void phase_conv(const Args& a, int l, LAS unsigned char* lds) {
    const int tid = otid(), wid = tid >> 6, lane = tid & 63;
    LAS float* scr = (LAS float*)(lds + wid * 16384);
    const int gw = blockIdx.x * 8 + wid, NGW = gridDim.x * 8;
    bf16_t* W = (bf16_t*)(a.ws + WS_W);
    conv_mat(a.in[I_WIN] + (size_t)l * 1024 * NPROJ, 1024, NPROJ, NPROJ_P, W + W_IN, scr, gw, NGW, lane);
    conv_mat(a.in[I_WUP] + (size_t)l * 1024 * 4096, 1024, 4096, 4096, W + W_UP, scr, gw, NGW, lane);
    conv_mat(a.in[I_WDOWN] + (size_t)l * 1024 * 4096, 4096, 1024, 1024, W + W_DOWN, scr, gw, NGW, lane);
    conv_mat(a.in[I_WOUT] + (size_t)l * 1024 * 1024, 1024, 1024, 1024, W + W_OUT, scr, gw, NGW, lane);
    conv_mat(a.in[I_WATTN] + (size_t)l * 512 * 1024, 512, 1024, 1024, W + W_A, scr, gw, NGW, lane);
    conv_mat(a.in[I_WRWKV] + (size_t)l * 512 * 1024, 512, 1024, 1024, W + W_B, scr, gw, NGW, lane);
    conv_mat(a.in[I_WLORA] + (size_t)l * 64 * 512, 64, 512, 512, W + W_WL, scr, gw, NGW, lane);
    conv_mat(a.in[I_ALORA] + (size_t)l * 64 * 512, 64, 512, 512, W + W_AL, scr, gw, NGW, lane);
    conv_mat(a.in[I_GLORA] + (size_t)l * 128 * 512, 128, 512, 512, W + W_GL, scr, gw, NGW, lane);
    for (int kv = 0; kv < 2; ++kv) {
        conv_mat(a.in[I_CMPW1] + (size_t)(l * 2 + kv) * 2048 * 128, 2048, 128, 128, W + W_C1 + kv * 262144, scr, gw, NGW, lane);
        conv_mat(a.in[I_CMPW2] + (size_t)(l * 2 + kv) * 128 * 64, 128, 64, 64, W + W_C2 + kv * 8192, scr, gw, NGW, lane);
    }
    float* biasp = (float*)(a.ws + WS_BIASP);
    for (int u = gw; u < 64; u += NGW) {
        const int kv = u >> 5, ng = (u >> 4) & 1, kp = u & 15, n = ng * 64 + lane;
        const float* pos = a.in[I_CMPPOS] + (size_t)(l * 2 + kv) * 2048; const float* w1 = a.in[I_CMPW1] + (size_t)(l * 2 + kv) * 2048 * 128;
        float acc8[8] = {0.f, 0.f, 0.f, 0.f, 0.f, 0.f, 0.f, 0.f};
#pragma unroll 2
        for (int k = kp * 128; k < kp * 128 + 128; k += 8) {
#pragma unroll
            for (int e = 0; e < 8; ++e) acc8[e] += pos[k + e] * w1[(size_t)(k + e) * 128 + n];
        }
        biasp[(kv * 16 + kp) * 128 + n] = ((acc8[0] + acc8[1]) + (acc8[2] + acc8[3])) + ((acc8[4] + acc8[5]) + (acc8[6] + acc8[7]));
    }
    if (l == 0) {
        float* ssz = (float*)(a.ws + WS_SS);
        for (int i = blockIdx.x * 512 + tid; i < 3 * M_TOK; i += gridDim.x * 512) ssz[i] = 0.f;
        bf16_t* U = (bf16_t*)(a.ws + WS_U);
        for (int m = gw; m < M_TOK; m += NGW) rms_row(a.in[I_X] + (size_t)m * DM, a.in[I_MIXNORM], U + (size_t)m * DM, lane);
    }
}
DI void phase_norm2(const Args& a, int l) {
    const int tid = otid(), wid = tid >> 6, lane = tid & 63;
    const int gw = blockIdx.x * 8 + wid, NGW = gridDim.x * 8;
    bf16_t* HN = (bf16_t*)(a.ws + WS_HN);
    for (int m = gw; m < M_TOK; m += NGW) rms_row(a.out + (size_t)m * DM, a.in[I_FFNNORM] + l * DM, HN + (size_t)m * DM, lane);
}

DI void lerp8(const bf16_t* cur, const bf16_t* prev, bool has_prev, const float* mu, float* o) {
    const u32x4 c = *(const u32x4*)cur; u32x4 p = {0u, 0u, 0u, 0u}; if (has_prev) p = *(const u32x4*)prev;
    float cf[8], pf[8]; unpack8(c, cf); unpack8(p, pf);
    const f32x4 m0 = *(const f32x4*)mu, m1 = *(const f32x4*)(mu + 4);
#pragma unroll
    for (int i = 0; i < 8; ++i) { const float m = i < 4 ? m0[i] : m1[i - 4]; o[i] = cf[i] + (pf[i] - cf[i]) * m; }
}
DI void rwkv_prep_item(const Args& a, int l, int item, LAS unsigned char* lds) {
    const int tid = otid(), wid = tid >> 6, lane = tid & 63;
    const int b = item >> 6, t0 = (item & 63) * 64;
    bf16_t* PROJ = (bf16_t*)(a.ws + WS_PROJ); bf16_t* PREP = (bf16_t*)(a.ws + WS_PREP); const bf16_t* W = (const bf16_t*)(a.ws + WS_W);
    LAS bf16_t* A_w = (LAS bf16_t*)lds; LAS bf16_t* A_a = (LAS bf16_t*)(lds + 9216);
    LAS bf16_t* a_s = (LAS bf16_t*)(lds + 18432); LAS bf16_t* omd_s = (LAS bf16_t*)(lds + 18432 + 65536);
    const float* mu = a.in[I_TOKMIX] + l * 1792;
    {
        const int token = tid >> 3, part = tid & 7; const size_t row = (size_t)b * SEQ + t0 + token; const bool hp = (t0 + token) > 0;
        float v[8];
        lerp8(PROJ + row * PP + C_WL + part * 8, PROJ + (row - 1) * PP + C_WL + part * 8, hp, mu + (C_WL - C_R) + part * 8, v);
#pragma unroll
        for (int i = 0; i < 8; ++i) v[i] = tanh_fast(v[i]);
        *(LAS u32x4*)(A_w + token * 72 + part * 8) = pack8(v);
        lerp8(PROJ + row * PP + C_AL + part * 8, PROJ + (row - 1) * PP + C_AL + part * 8, hp, mu + (C_AL - C_R) + part * 8, v);
        *(LAS u32x4*)(A_a + token * 72 + part * 8) = pack8(v);
    }
    __syncthreads();
#pragma unroll 1
    for (int which = 0; which < 2; ++which) {
        f32x4 acc[4][4];
#pragma unroll
        for (int m = 0; m < 4; ++m)
#pragma unroll
            for (int n = 0; n < 4; ++n) acc[m][n] = (f32x4){0.f, 0.f, 0.f, 0.f};
        const int fr = lane & 15, fq = lane >> 4;
        const LAS bf16_t* As = which ? A_a : A_w; const bf16_t* Bw = W + (which ? W_AL : W_WL);
#pragma unroll
        for (int ks = 0; ks < 2; ++ks) {
            bf16x8 af[4];
#pragma unroll
            for (int m = 0; m < 4; ++m) af[m] = *(const LAS bf16x8*)(As + (m * 16 + fr) * 72 + ks * 32 + fq * 8);
#pragma unroll
            for (int n = 0; n < 4; ++n) {
                const bf16x8 bfr = *(const bf16x8*)(Bw + (size_t)(wid * 64 + n * 16 + fr) * 64 + ks * 32 + fq * 8);
#pragma unroll
                for (int m = 0; m < 4; ++m) acc[m][n] = MFMA16(af[m], bfr, acc[m][n]);
            }
        }
        LAS bf16_t* dst = which ? a_s : omd_s;
#pragma unroll
        for (int n = 0; n < 4; ++n) {
            const int c = wid * 64 + n * 16 + fr; const float c0 = a.in[which ? I_A0 : I_W0][l * 512 + c];
#pragma unroll
            for (int m = 0; m < 4; ++m)
#pragma unroll
                for (int r = 0; r < 4; ++r) {
                    const int token = m * 16 + fq * 4 + r;
                    float res;
                    if (which) res = sigm(c0 + acc[m][n][r]);
                    else {
                        const float x = -(c0 + acc[m][n][r]);
                        const float ew = 0.60653065971f * __builtin_amdgcn_rcpf(1.f + __expf(x));
                        res = ew > 0.03f ? 1.f - __expf(-ew) : ew * (1.f - ew * (0.5f - ew * (1.f / 6.f)));
                    }
                    dst[token * 512 + c] = tobf(res);
                }
        }
    }
    __syncthreads();
    {
        const int cgp = tid & 63, head = cgp >> 3, k0 = (cgp & 7) * 8, c = cgp * 8;
        float mur[8], muk[8], muv[8], kkp[8], kap[8];
        {
            const float* srcs[5] = {mu + c, mu + 512 + c, mu + 1024 + c, a.in[I_KK] + l * 512 + c, a.in[I_KA] + l * 512 + c};
            float* dsts[5] = {mur, muk, muv, kkp, kap};
#pragma unroll
            for (int q = 0; q < 5; ++q) { const f32x4 t0 = *(const f32x4*)srcs[q], t1 = *(const f32x4*)(srcs[q] + 4);
#pragma unroll
                for (int i = 0; i < 4; ++i) { dsts[q][i] = t0[i]; dsts[q][4 + i] = t1[i]; } }
        }
        u32x4 raw[6];
        auto load_unit = [&](int u) {
            const int token = u * 8 + (tid >> 6); const size_t row = (size_t)b * SEQ + t0 + token; const bool hp = (t0 + token) > 0;
            const u32x4 z = {0u, 0u, 0u, 0u};
            raw[0] = *(const u32x4*)(PROJ + row * PP + C_R + c); raw[1] = hp ? *(const u32x4*)(PROJ + (row - 1) * PP + C_R + c) : z;
            raw[2] = *(const u32x4*)(PROJ + row * PP + C_K + c); raw[3] = hp ? *(const u32x4*)(PROJ + (row - 1) * PP + C_K + c) : z;
            raw[4] = *(const u32x4*)(PROJ + row * PP + C_V + c); raw[5] = hp ? *(const u32x4*)(PROJ + (row - 1) * PP + C_V + c) : z;
        };
        load_unit(0);
#pragma unroll 1
        for (int u = 0; u < 8; ++u) {
            const int token = u * 8 + (tid >> 6);
            float r[8], k[8], v[8], av[8], od[8];
            {
                float cf[8], pf[8];
                unpack8(raw[0], cf); unpack8(raw[1], pf);
#pragma unroll
                for (int i = 0; i < 8; ++i) r[i] = cf[i] + (pf[i] - cf[i]) * mur[i];
                unpack8(raw[2], cf); unpack8(raw[3], pf);
#pragma unroll
                for (int i = 0; i < 8; ++i) k[i] = cf[i] + (pf[i] - cf[i]) * muk[i];
                unpack8(raw[4], cf); unpack8(raw[5], pf);
#pragma unroll
                for (int i = 0; i < 8; ++i) v[i] = cf[i] + (pf[i] - cf[i]) * muv[i];
            }
            if (u + 1 < 8) load_unit(u + 1);
            unpack8(*(const LAS u32x4*)(a_s + token * 512 + c), av); unpack8(*(const LAS u32x4*)(omd_s + token * 512 + c), od);
            float kk[8], bb[8], kp[8]; float ss = 0.f;
#pragma unroll
            for (int i = 0; i < 8; ++i) { kk[i] = k[i] * kkp[i]; ss += kk[i] * kk[i]; }
            ss = red8(ss);
            const float rn = rsqrtf(fmaxf(ss, 1e-24f));
#pragma unroll
            for (int i = 0; i < 8; ++i) { kk[i] *= rn; bb[i] = kk[i] * av[i]; kp[i] = k[i] * (1.f + (av[i] - 1.f) * kap[i]); }
            bf16_t* op = PREP + ((size_t)(b * 8 + head) * SEQ + t0 + token) * 384 + k0;
            *(u32x4*)(op) = pack8(r); *(u32x4*)(op + 64) = pack8(od); *(u32x4*)(op + 128) = pack8(kp); *(u32x4*)(op + 192) = pack8(kk); *(u32x4*)(op + 256) = pack8(bb); *(u32x4*)(op + 320) = pack8(v);
        }
    }
    __syncthreads();
}
DI void nsa_norm_item(const Args& a, int l, int item, LAS unsigned char* lds) {
    const int tid = otid();
    const int b = item >> 6, t0 = (item & 63) * 64;
    bf16_t* PROJ = (bf16_t*)(a.ws + WS_PROJ);
    LAS bf16_t* vt = (LAS bf16_t*)lds;
    const int token = tid >> 3, part = tid & 7, g = part >> 2, d0 = (part & 3) * 16;
    const size_t row = (size_t)b * SEQ + t0 + token;
#pragma unroll
    for (int var = 0; var < 2; ++var) {
        bf16_t* kp = PROJ + row * PP + (var ? C_KW : C_KS) + g * 64 + d0;
        float f[16]; unpack8(*(const u32x4*)kp, f); unpack8(*(const u32x4*)(kp + 8), f + 8);
        float ss = 0.f;
#pragma unroll
        for (int i = 0; i < 16; ++i) ss += f[i] * f[i];
        ss = red4(ss);
        const float rstd = rsqrtf(ss * (1.f / 64.f) + 1e-6f);
        const float* gn = a.in[I_KGAIN] + (l * 3 + 1 + var) * 64 + d0;
#pragma unroll
        for (int i = 0; i < 16; ++i) f[i] = f[i] * rstd * gn[i];
        *(u32x4*)kp = pack8(f); *(u32x4*)(kp + 8) = pack8(f + 8);
        const bf16_t* vp = PROJ + row * PP + (var ? C_VW : C_VS) + g * 64 + d0;
        const u32x4 v0 = *(const u32x4*)vp, v1 = *(const u32x4*)(vp + 8);
        const unsigned vw[8] = {v0.x, v0.y, v0.z, v0.w, v1.x, v1.y, v1.z, v1.w};
#pragma unroll
        for (int i = 0; i < 8; ++i) { vt[(var * 128 + g * 64 + d0 + 2 * i) * 72 + token] = (bf16_t)(vw[i] & 0xffffu); vt[(var * 128 + g * 64 + d0 + 2 * i + 1) * 72 + token] = (bf16_t)(vw[i] >> 16); }
    }
    __syncthreads();
#pragma unroll
    for (int u = 0; u < 4; ++u) {
        const int id = u * 512 + tid, var = id >> 10, rr = (id >> 3) & 127, seg = id & 7, gg = rr >> 6, d = rr & 63;
        bf16_t* dst = (bf16_t*)(a.ws + (var ? WS_VWT : WS_VST)) + ((size_t)(b * 2 + gg) * 64 + d) * SEQ + t0 + seg * 8;
        *(u32x4*)dst = *(const LAS u32x4*)(vt + (var * 128 + rr) * 72 + seg * 8);
    }
    __syncthreads();
}
DI float gelu_tanh(float x) { const float u = 0.7978845608f * (x + 0.044715f * x * x * x); return 0.5f * x * (1.f + tanh_fast(u)); }
DI void compress_item(const Args& a, int l, int item, LAS unsigned char* lds) {
    const int tid = otid(), wid = tid >> 6, lane = tid & 63, fr = lane & 15, fq = lane >> 4;
    const int kv = item >> 7, bg = (item >> 3) & 15, nq = item & 7, b = bg >> 1, g = bg & 1;
    const bf16_t* PROJ = (const bf16_t*)(a.ws + WS_PROJ); const bf16_t* W = (const bf16_t*)(a.ws + WS_W);
    LAS bf16_t* hs = (LAS bf16_t*)lds; LAS float* os = (LAS float*)(lds + 8704);
    const int colbase = (kv ? C_VC : C_KC) + g * 64;
    f32x4 acc[2];
#pragma unroll
    for (int m = 0; m < 2; ++m) acc[m] = (f32x4){0.f, 0.f, 0.f, 0.f};
    const bf16_t* w1 = W + W_C1 + (size_t)kv * 262144 + (size_t)(wid * 16 + fr) * 2048 + fq * 8;
    int tk0[2];
#pragma unroll
    for (int m = 0; m < 2; ++m) tk0[m] = 16 * (nq * 32 + m * 16 + fr);
#pragma unroll 1
    for (int k8 = 0; k8 < 64; k8 += 8) {
        bf16x8 bfr[8], af[8][2];
#pragma unroll
        for (int kk = 0; kk < 8; ++kk) {
            const int ks = k8 + kk, tokoff = ks >> 1, dcol = (ks & 1) * 32 + fq * 8;
            bfr[kk] = *(const bf16x8*)(w1 + ks * 32);
#pragma unroll
            for (int m = 0; m < 2; ++m) { int tk = tk0[m] + tokoff; tk = tk > SEQ - 1 ? SEQ - 1 : tk; af[kk][m] = *(const bf16x8*)(PROJ + ((size_t)b * SEQ + tk) * PP + colbase + dcol); }
        }
#pragma unroll
        for (int kk = 0; kk < 8; ++kk)
#pragma unroll
            for (int m = 0; m < 2; ++m) acc[m] = MFMA16(af[kk][m], bfr[kk], acc[m]);
    }
    {
        const int c = wid * 16 + fr; const float* biasp = (const float*)(a.ws + WS_BIASP) + kv * 16 * 128 + c;
        float bias = 0.f;
#pragma unroll
        for (int kp = 0; kp < 16; ++kp) bias += biasp[kp * 128];
#pragma unroll
        for (int m = 0; m < 2; ++m)
#pragma unroll
            for (int r = 0; r < 4; ++r) hs[(m * 16 + fq * 4 + r) * 136 + c] = tobf(gelu_tanh(acc[m][r] + bias));
    }
    __syncthreads();
    {
        const int m = wid >> 2, nt = wid & 3;
        f32x4 acc2 = {0.f, 0.f, 0.f, 0.f};
#pragma unroll
        for (int ks = 0; ks < 4; ++ks) {
            const bf16x8 af = *(const LAS bf16x8*)(hs + (m * 16 + fr) * 136 + ks * 32 + fq * 8);
            const bf16x8 bf = *(const bf16x8*)(W + W_C2 + (size_t)kv * 8192 + (size_t)(nt * 16 + fr) * 128 + ks * 32 + fq * 8);
            acc2 = MFMA16(af, bf, acc2);
        }
#pragma unroll
        for (int r = 0; r < 4; ++r) os[(m * 16 + fq * 4 + r) * 64 + nt * 16 + fr] = acc2[r];
    }
    __syncthreads();
    if (tid < 256) {
        const int rowi = tid >> 3, d0 = (tid & 7) * 8, n = nq * 32 + rowi;
        float v[8];
#pragma unroll
        for (int i = 0; i < 8; ++i) v[i] = os[rowi * 64 + d0 + i];
        if (kv == 0) {
            float ss = 0.f;
#pragma unroll
            for (int i = 0; i < 8; ++i) ss += v[i] * v[i];
            ss = red8(ss);
            const float rstd = rsqrtf(ss * (1.f / 64.f) + 1e-6f);
            const float* gn = a.in[I_KGAIN] + (l * 3 + 0) * 64 + d0;
#pragma unroll
            for (int i = 0; i < 8; ++i) v[i] = (n == 255) ? 0.f : v[i] * rstd * gn[i];
            *(u32x4*)((bf16_t*)(a.ws + WS_KCN) + ((size_t)bg * 256 + n) * 64 + d0) = pack8(v);
        } else {
            bf16_t* vct = (bf16_t*)(a.ws + WS_VCT) + (size_t)bg * 64 * 256;
#pragma unroll
            for (int i = 0; i < 8; ++i) vct[(d0 + i) * 256 + n] = tobf(n == 255 ? 0.f : v[i]);
        }
    }
    __syncthreads();
}
DI void phase_prep(const Args& a, int l, LAS unsigned char* lds) {
#ifdef DUPPREP
    for (int it = blockIdx.x; it < 768; it += gridDim.x) { if (it < 256) compress_item(a, l, it, lds); else rwkv_prep_item(a, l, it - 256, lds); }
#endif
#ifdef OLD_PREP
    for (int it = blockIdx.x; it < 1280; it += gridDim.x) {
        if (it < 256) compress_item(a, l, it, lds);
        else if (it < 768) rwkv_prep_item(a, l, it - 256, lds);
        else nsa_norm_item(a, l, it - 768, lds);
    }
#else
    for (int it = blockIdx.x; it < 768; it += gridDim.x) {
        if (it < 256) compress_item(a, l, it, lds);
        else nsa_norm_item(a, l, it - 256, lds);
    }
#endif
}

DI f32x2 red16p(f32x2 x) { float a = x.x, b = x.y; red16x2(a, b); return (f32x2){a, b}; }
template <int RPL>
DI void scan_bh(const Args& a, int bh, int halfsel, LAS unsigned char* lds) {
    const int tid = otid(), wid = tid >> 6, lane = tid & 63, vq = lane >> 4, kq = lane & 15;
    const bf16_t* src = (const bf16_t*)(a.ws + WS_PREP) + (size_t)bh * SEQ * 384;
    bf16_t* PROJ = (bf16_t*)(a.ws + WS_PROJ);
    const int b = bh >> 3, h = bh & 7;
    constexpr int T = 32, CH = T * 384, NL = CH / 2048;
    LAS float* opbuf = (LAS float*)lds;
    LAS unsigned char* ybuf = lds + 2 * CH * 4;
    const int row0 = RPL == 2 ? halfsel * 32 + (wid & 3) * 8 + vq * 2 : halfsel * 32 + wid * 4 + vq;
    const bool active = RPL == 2 ? wid < 4 : true;
    f32x2 S[4];
#pragma unroll
    for (int j = 0; j < 4; ++j) S[j] = (f32x2){0.f, 0.f};
    u32x2 ld[NL]; bool isd[NL];
#pragma unroll
    for (int j = 0; j < NL; ++j) { isd[j] = (((tid * 4 + j * 2048) % 384) >> 6) == 1; ld[j] = *(const u32x2*)(src + tid * 4 + j * 2048); }
#pragma unroll
    for (int j = 0; j < NL; ++j) { f32x4 f = {bflo(ld[j].x), bfhi(ld[j].x), bflo(ld[j].y), bfhi(ld[j].y)}; if (isd[j]) f = 1.f - f; *(LAS f32x4*)(opbuf + tid * 4 + j * 2048) = f; }
    __syncthreads();
#pragma unroll 1
    for (int c = 0; c < SEQ / T; ++c) {
        if (c + 1 < SEQ / T) {
#pragma unroll
            for (int j = 0; j < NL; ++j) ld[j] = *(const u32x2*)(src + (size_t)(c + 1) * CH + tid * 4 + j * 2048);
        }
        const LAS float* cur = opbuf + (c & 1) * CH;
        LAS unsigned char* yb = ybuf + (c & 1) * (T * 128);
        f32x4 r4 = *(const LAS f32x4*)(cur + kq * 4), d4 = *(const LAS f32x4*)(cur + 64 + kq * 4), k4 = *(const LAS f32x4*)(cur + 128 + kq * 4),
              kk4 = *(const LAS f32x4*)(cur + 192 + kq * 4), b4 = *(const LAS f32x4*)(cur + 256 + kq * 4);
        f32x2 v2; if (RPL == 2) v2 = *(const LAS f32x2*)(cur + 320 + row0); else { v2.x = cur[320 + row0]; v2.y = 0.f; }
        if (active) {
#pragma unroll
        for (int st = 0; st < T; ++st) {
            f32x4 nr4, nd4, nk4, nkk4, nb4; f32x2 nv2;
            if (st < T - 1) {
                const LAS float* o = cur + (st + 1) * 384;
                nr4 = *(const LAS f32x4*)(o + kq * 4); nd4 = *(const LAS f32x4*)(o + 64 + kq * 4); nk4 = *(const LAS f32x4*)(o + 128 + kq * 4);
                nkk4 = *(const LAS f32x4*)(o + 192 + kq * 4); nb4 = *(const LAS f32x4*)(o + 256 + kq * 4);
                if (RPL == 2) nv2 = *(const LAS f32x2*)(o + 320 + row0); else { nv2.x = o[320 + row0]; nv2.y = 0.f; }
            }
            if (RPL == 2) {
                f32x2 sa = S[0] * kk4[0]; sa += S[1] * kk4[1]; f32x2 sb = S[2] * kk4[2]; sb += S[3] * kk4[3]; sa += sb;
                sa = red16p(sa); sa = -sa;
#pragma unroll
                for (int j = 0; j < 4; ++j) S[j] = S[j] * d4[j] + sa * b4[j] + v2 * k4[j];
                f32x2 y = S[0] * r4[0]; y += S[1] * r4[1]; f32x2 yc = S[2] * r4[2]; yc += S[3] * r4[3]; y += yc;
                y = red16p(y);
                *(LAS unsigned*)(yb + st * 128 + row0 * 2) = pk2(y.x, y.y);
            } else {
                const f32x2 kk01 = {kk4[0], kk4[1]}, kk23 = {kk4[2], kk4[3]}, d01 = {d4[0], d4[1]}, d23 = {d4[2], d4[3]}, b01 = {b4[0], b4[1]}, b23 = {b4[2], b4[3]},
                            k01 = {k4[0], k4[1]}, k23 = {k4[2], k4[3]}, r01 = {r4[0], r4[1]}, r23 = {r4[2], r4[3]};
                f32x2 sa2 = S[0] * kk01; sa2 += S[1] * kk23;
                const float sa = -red16(sa2.x + sa2.y);
                S[0] = S[0] * d01 + sa * b01 + v2.x * k01; S[1] = S[1] * d23 + sa * b23 + v2.x * k23;
                f32x2 y2 = S[0] * r01; y2 += S[1] * r23;
                const float y = red16(y2.x + y2.y);
                if (kq == 0) *(LAS bf16_t*)(yb + st * 128 + row0 * 2) = tobf(y);
            }
            if (st < T - 1) { r4 = nr4; d4 = nd4; k4 = nk4; kk4 = nkk4; b4 = nb4; v2 = nv2; }
        }
        }
        if (c + 1 < SEQ / T) {
            LAS float* nb = opbuf + ((c + 1) & 1) * CH;
#pragma unroll
            for (int j = 0; j < NL; ++j) { f32x4 f = {bflo(ld[j].x), bfhi(ld[j].x), bflo(ld[j].y), bfhi(ld[j].y)}; if (isd[j]) f = 1.f - f; *(LAS f32x4*)(nb + tid * 4 + j * 2048) = f; }
        }
        __syncthreads();
        { if (tid < T * 4) { const int rowi = tid >> 2, seg = tid & 3;
            *(u32x4*)(PROJ + ((size_t)b * SEQ + c * T + rowi) * PP + C_R + h * 64 + halfsel * 32 + seg * 8) = *(const LAS u32x4*)(yb + rowi * 128 + halfsel * 64 + seg * 16); } }
    }
    __syncthreads();
}

DI void scan_bh2(const Args& a, int l, int bh, int halfsel, LAS unsigned char* lds) {
    const int tid = otid(), wid = tid >> 6, lane = tid & 63;
    const int b = bh >> 3, h = bh & 7;
    constexpr int T = 32, CH = T * 384;
    LAS float* opbuf = (LAS float*)lds;
    LAS unsigned char* ybuf = lds + 2 * CH * 4;
    bf16_t* PROJ = (bf16_t*)(a.ws + WS_PROJ);
    if (wid < 4) {
        const int vq = lane >> 4, kq = lane & 15;
        const int row0 = halfsel * 32 + wid * 8 + vq * 2;
        bf16_t* Y = (bf16_t*)(a.ws + WS_Y);
        f32x2 S[4];
#pragma unroll
        for (int j = 0; j < 4; ++j) S[j] = (f32x2){0.f, 0.f};
        __syncthreads();
#pragma unroll 1
        for (int c = 0; c < SEQ / T; ++c) {
            const LAS float* cur = opbuf + (c & 1) * CH;
            LAS unsigned char* yb = ybuf + (c & 1) * (T * 128);
            f32x4 r4 = *(const LAS f32x4*)(cur + kq * 4), d4 = *(const LAS f32x4*)(cur + 64 + kq * 4), k4 = *(const LAS f32x4*)(cur + 128 + kq * 4),
                  kk4 = *(const LAS f32x4*)(cur + 192 + kq * 4), b4 = *(const LAS f32x4*)(cur + 256 + kq * 4);
            f32x2 v2 = *(const LAS f32x2*)(cur + 320 + row0);
#pragma unroll
            for (int st = 0; st < T; ++st) {
                f32x4 nr4, nd4, nk4, nkk4, nb4; f32x2 nv2;
                if (st < T - 1) {
                    const LAS float* o = cur + (st + 1) * 384;
                    nr4 = *(const LAS f32x4*)(o + kq * 4); nd4 = *(const LAS f32x4*)(o + 64 + kq * 4); nk4 = *(const LAS f32x4*)(o + 128 + kq * 4);
                    nkk4 = *(const LAS f32x4*)(o + 192 + kq * 4); nb4 = *(const LAS f32x4*)(o + 256 + kq * 4); nv2 = *(const LAS f32x2*)(o + 320 + row0);
                }
                f32x2 sa = S[0] * kk4[0]; sa += S[1] * kk4[1]; f32x2 sb = S[2] * kk4[2]; sb += S[3] * kk4[3]; sa += sb;
                sa = red16p(sa); sa = -sa;
#pragma unroll
                for (int j = 0; j < 4; ++j) S[j] = S[j] * d4[j] + sa * b4[j] + v2 * k4[j];
                f32x2 y = S[0] * r4[0]; y += S[1] * r4[1]; f32x2 yc = S[2] * r4[2]; yc += S[3] * r4[3]; y += yc;
                y = red16p(y);
                *(LAS unsigned*)(yb + st * 128 + row0 * 2) = pk2(y.x, y.y);
                if (st < T - 1) { r4 = nr4; d4 = nd4; k4 = nk4; kk4 = nkk4; b4 = nb4; v2 = nv2; }
            }
            __syncthreads();
            if (tid < T * 4) { const int rowi = tid >> 2, seg = tid & 3;
                *(u32x4*)(Y + ((size_t)b * SEQ + c * T + rowi) * 512 + h * 64 + halfsel * 32 + seg * 8) = *(const LAS u32x4*)(yb + rowi * 128 + halfsel * 64 + seg * 16); }
        }
    } else {
        const int lw = wid - 4, token = lane >> 3, part = lane & 7, fr = lane & 15, fq = lane >> 4;
        const int c8 = part * 8, ch = h * 64 + c8;
        LAS unsigned char* scr = lds + 2 * CH * 4 + 2 * T * 128 + lw * 7168;
        LAS bf16_t* A_w = (LAS bf16_t*)scr; LAS bf16_t* A_a = (LAS bf16_t*)(scr + 2304);
        LAS bf16_t* a_s = (LAS bf16_t*)(scr + 4608); LAS bf16_t* omd_s = (LAS bf16_t*)(scr + 5632);
        const bf16_t* W = (const bf16_t*)(a.ws + WS_W);
        bf16_t* PREP3 = (bf16_t*)(a.ws + WS_PREP);
        const float* mu = a.in[I_TOKMIX] + l * 1792;
        float mur[8], muk[8], muv[8], kkp[8], kap[8], muw[8], mua[8];
        {
            const float* srcs[7] = {mu + ch, mu + 512 + ch, mu + 1024 + ch, a.in[I_KK] + l * 512 + ch, a.in[I_KA] + l * 512 + ch, mu + (C_WL - C_R) + c8, mu + (C_AL - C_R) + c8};
            float* dsts[7] = {mur, muk, muv, kkp, kap, muw, mua};
#pragma unroll
            for (int q = 0; q < 7; ++q) { const f32x4 t0 = *(const f32x4*)srcs[q], t1 = *(const f32x4*)(srcs[q] + 4);
#pragma unroll
                for (int i = 0; i < 4; ++i) { dsts[q][i] = t0[i]; dsts[q][4 + i] = t1[i]; } }
        }
        float w0c[4], a0c[4];
#pragma unroll
        for (int n = 0; n < 4; ++n) { w0c[n] = a.in[I_W0][l * 512 + h * 64 + n * 16 + fr]; a0c[n] = a.in[I_A0][l * 512 + h * 64 + n * 16 + fr]; }
        { const u32x4 z = {0u, 0u, 0u, 0u}; *(LAS u32x4*)(A_w + (8 + token) * 72 + c8) = z; *(LAS u32x4*)(A_a + (8 + token) * 72 + c8) = z; }
        u32x4 nxt[10];
        auto load_rows = [&](int cc2) {
            const int tg2 = cc2 * T + lw * 8 + token; const bool hp2 = tg2 > 0; const u32x4 z = {0u, 0u, 0u, 0u};
            const bf16_t* pr = PROJ + ((size_t)b * SEQ + tg2) * PP;
            nxt[0] = *(const u32x4*)(pr + C_WL + c8); nxt[1] = hp2 ? *(const u32x4*)(pr - PP + C_WL + c8) : z;
            nxt[2] = *(const u32x4*)(pr + C_AL + c8); nxt[3] = hp2 ? *(const u32x4*)(pr - PP + C_AL + c8) : z;
            nxt[4] = *(const u32x4*)(pr + C_R + ch);  nxt[5] = hp2 ? *(const u32x4*)(pr - PP + C_R + ch) : z;
            nxt[6] = *(const u32x4*)(pr + C_K + ch);  nxt[7] = hp2 ? *(const u32x4*)(pr - PP + C_K + ch) : z;
            nxt[8] = *(const u32x4*)(pr + C_V + ch);  nxt[9] = hp2 ? *(const u32x4*)(pr - PP + C_V + ch) : z;
        };
        load_rows(0);
#pragma unroll 1
        for (int cc = 0; cc <= SEQ / T; ++cc) {
            if (cc < SEQ / T) {
                const int tg = cc * T + lw * 8 + token;
                const u32x4 rw0 = nxt[0], rw1 = nxt[1], ra0 = nxt[2], ra1 = nxt[3], rr0 = nxt[4], rr1 = nxt[5], rk0 = nxt[6], rk1 = nxt[7], rv0 = nxt[8], rv1 = nxt[9];
                bf16x8 bwq[2][4];
#pragma unroll
                for (int ks = 0; ks < 2; ++ks)
#pragma unroll
                    for (int n = 0; n < 4; ++n) bwq[ks][n] = *(const bf16x8*)(W + W_WL + (size_t)(h * 64 + n * 16 + fr) * 64 + ks * 32 + fq * 8);
                float cf[8], pf[8], t8[8];
                unpack8(rw0, cf); unpack8(rw1, pf);
#pragma unroll
                for (int i = 0; i < 8; ++i) t8[i] = tanh_fast(cf[i] + (pf[i] - cf[i]) * muw[i]);
                *(LAS u32x4*)(A_w + token * 72 + c8) = pack8(t8);
                unpack8(ra0, cf); unpack8(ra1, pf);
#pragma unroll
                for (int i = 0; i < 8; ++i) t8[i] = cf[i] + (pf[i] - cf[i]) * mua[i];
                *(LAS u32x4*)(A_a + token * 72 + c8) = pack8(t8);
                asm volatile("s_waitcnt lgkmcnt(0)" ::: "memory");
#pragma unroll
                for (int which = 0; which < 2; ++which) {
                    f32x4 acc[4];
#pragma unroll
                    for (int n = 0; n < 4; ++n) acc[n] = (f32x4){0.f, 0.f, 0.f, 0.f};
                    const LAS bf16_t* As = which ? A_a : A_w;
#pragma unroll
                    for (int ks = 0; ks < 2; ++ks) {
                        const bf16x8 af = *(const LAS bf16x8*)(As + fr * 72 + ks * 32 + fq * 8);
#pragma unroll
                        for (int n = 0; n < 4; ++n) acc[n] = MFMA16(af, bwq[ks][n], acc[n]);
                    }
                    if (which == 0) {
#pragma unroll
                        for (int ks = 0; ks < 2; ++ks)
#pragma unroll
                            for (int n = 0; n < 4; ++n) bwq[ks][n] = *(const bf16x8*)(W + W_AL + (size_t)(h * 64 + n * 16 + fr) * 64 + ks * 32 + fq * 8);
                    }
                    if (fq < 2) {
                        LAS bf16_t* dst = which ? a_s : omd_s;
#pragma unroll
                        for (int n = 0; n < 4; ++n)
#pragma unroll
                            for (int r = 0; r < 4; ++r) {
                                float res;
                                if (which) res = sigm(a0c[n] + acc[n][r]);
                                else { const float x = -(w0c[n] + acc[n][r]); const float ew = 0.60653065971f * __builtin_amdgcn_rcpf(1.f + __expf(x));
                                       res = ew > 0.03f ? 1.f - __expf(-ew) : ew * (1.f - ew * (0.5f - ew * (1.f / 6.f))); }
                                dst[(fq * 4 + r) * 64 + n * 16 + fr] = tobf(res);
                            }
                    }
                }
                asm volatile("s_waitcnt lgkmcnt(0)" ::: "memory");
                float r[8], k[8], v[8], av[8], od[8];
                unpack8(rr0, cf); unpack8(rr1, pf);
#pragma unroll
                for (int i = 0; i < 8; ++i) r[i] = cf[i] + (pf[i] - cf[i]) * mur[i];
                unpack8(rk0, cf); unpack8(rk1, pf);
#pragma unroll
                for (int i = 0; i < 8; ++i) k[i] = cf[i] + (pf[i] - cf[i]) * muk[i];
                unpack8(rv0, cf); unpack8(rv1, pf);
#pragma unroll
                for (int i = 0; i < 8; ++i) v[i] = cf[i] + (pf[i] - cf[i]) * muv[i];
                unpack8(*(const LAS u32x4*)(a_s + token * 64 + c8), av); unpack8(*(const LAS u32x4*)(omd_s + token * 64 + c8), od);
                float kk[8], bb[8], kp[8]; float ss = 0.f;
#pragma unroll
                for (int i = 0; i < 8; ++i) { kk[i] = k[i] * kkp[i]; ss += kk[i] * kk[i]; }
                ss = red8(ss);
                const float rn = rsqrtf(fmaxf(ss, 1e-24f));
#pragma unroll
                for (int i = 0; i < 8; ++i) { kk[i] *= rn; bb[i] = kk[i] * av[i]; kp[i] = k[i] * (1.f + (av[i] - 1.f) * kap[i]); }
                const u32x4 r16 = pack8(r), kp16 = pack8(kp), kk16 = pack8(kk), bb16 = pack8(bb), v16 = pack8(v);
                if (halfsel == 0) { bf16_t* op = PREP3 + ((size_t)bh * SEQ + tg) * 192 + c8; *(u32x4*)op = r16; *(u32x4*)(op + 64) = kp16; *(u32x4*)(op + 128) = v16; }
                LAS float* ob = opbuf + (cc & 1) * CH + (lw * 8 + token) * 384 + c8;
                unpack8(r16, t8);  *(LAS f32x4*)(ob) = (f32x4){t8[0], t8[1], t8[2], t8[3]};       *(LAS f32x4*)(ob + 4) = (f32x4){t8[4], t8[5], t8[6], t8[7]};
#pragma unroll
                for (int i = 0; i < 8; ++i) t8[i] = 1.f - od[i];
                *(LAS f32x4*)(ob + 64) = (f32x4){t8[0], t8[1], t8[2], t8[3]};  *(LAS f32x4*)(ob + 68) = (f32x4){t8[4], t8[5], t8[6], t8[7]};
                unpack8(kp16, t8); *(LAS f32x4*)(ob + 128) = (f32x4){t8[0], t8[1], t8[2], t8[3]}; *(LAS f32x4*)(ob + 132) = (f32x4){t8[4], t8[5], t8[6], t8[7]};
                unpack8(kk16, t8); *(LAS f32x4*)(ob + 192) = (f32x4){t8[0], t8[1], t8[2], t8[3]}; *(LAS f32x4*)(ob + 196) = (f32x4){t8[4], t8[5], t8[6], t8[7]};
                unpack8(bb16, t8); *(LAS f32x4*)(ob + 256) = (f32x4){t8[0], t8[1], t8[2], t8[3]}; *(LAS f32x4*)(ob + 260) = (f32x4){t8[4], t8[5], t8[6], t8[7]};
                unpack8(v16, t8);  *(LAS f32x4*)(ob + 320) = (f32x4){t8[0], t8[1], t8[2], t8[3]}; *(LAS f32x4*)(ob + 324) = (f32x4){t8[4], t8[5], t8[6], t8[7]};
                if (cc + 1 < SEQ / T) load_rows(cc + 1);
            }
            __syncthreads();
        }
    }
    __syncthreads();
}

constexpr int IMPP = 65;
constexpr int AT_IMP = 0, AT_SEL = 4 * 64 * IMPP * 4, AT_LINV = AT_SEL + 512, AT_BUF = AT_LINV + 1024, AT_BUFSZ = 18432, AT_VOFF = 9216;
struct AttnCtx {
    bf16x8 q[4]; int t, tw, qi, hi, tid; unsigned long long mymask; int ncv, ncvw, ncvmin; float inv; LAS float* impw; LAS unsigned char* lds; bool nocompute;
};
template <int BR>
DI void attn_branch(const AttnCtx& c, unsigned long long tmask, const bf16_t* kbase, size_t kpitch, const bf16_t* vbase, size_t vpitch, f32x16 (&o)[2], float& lsum) {
    if (tmask == 0ull) return;
    const int rowi = c.tid >> 3, seg = c.tid & 7;
    const bf16_t* kg = kbase + (size_t)rowi * kpitch + seg * 8;
    const bf16_t* vg = vbase + (size_t)rowi * vpitch + seg * 8;
    unsigned long long m = tmask;
    int j = __ffsll((long long)m) - 1; m &= m - 1;
    u32x4 kr = *(const u32x4*)(kg + (size_t)j * 64 * kpitch), vr;
    if (BR != 0) vr = *(const u32x4*)(vg + j * 64);
    int it = 0;
    for (;;) {
        LAS bf16_t* Ks = (LAS bf16_t*)(c.lds + AT_BUF + (it & 1) * AT_BUFSZ); LAS bf16_t* Vs = (LAS bf16_t*)(c.lds + AT_BUF + (it & 1) * AT_BUFSZ + AT_VOFF);
        *(LAS u32x4*)(Ks + rowi * 72 + seg * 8) = kr;
        if (BR != 0) { *(LAS u32x2*)(Vs + rowi * 68 + seg * 8) = (u32x2){vr.x, vr.y}; *(LAS u32x2*)(Vs + rowi * 68 + seg * 8 + 4) = (u32x2){vr.z, vr.w}; }
        __syncthreads();
        const int jc = j; const bool more = m != 0ull;
        if (more) { j = __ffsll((long long)m) - 1; m &= m - 1; kr = *(const u32x4*)(kg + (size_t)j * 64 * kpitch); if (BR != 0) vr = *(const u32x4*)(vg + j * 64); }
        bool mine = true;
        if (BR == 2) mine = (c.mymask >> jc) & 1ull;
        const bool wave_on = (BR == 2 ? (__ballot(mine) != 0ull) : true) && !c.nocompute;
        if (wave_on) {
            const float sbias = (BR == 2 && !mine) ? -1e30f : 0.f;
            bool interior;
            if (BR <= 1) interior = jc * 64 + 64 <= c.ncvmin;
            else if (BR == 2) interior = jc * 64 + 63 <= c.tw;
            else interior = (jc * 64 + 63 <= c.tw) && (jc * 64 > c.tw + 31 - 512);
            if (interior) {
                f32x16 s0, s1;
#pragma unroll
                for (int i = 0; i < 16; ++i) { s0[i] = sbias; s1[i] = sbias; }
#pragma unroll
                for (int st = 0; st < 4; ++st) {
                    const bf16x8 kf0 = *(const LAS bf16x8*)(Ks + c.qi * 72 + 16 * st + 8 * c.hi), kf1 = *(const LAS bf16x8*)(Ks + (32 + c.qi) * 72 + 16 * st + 8 * c.hi);
                    s0 = MFMA32(kf0, c.q[st], s0); s1 = MFMA32(kf1, c.q[st], s1);
                }
                float p0[16], p1[16];
#pragma unroll
                for (int i = 0; i < 16; ++i) { p0[i] = __builtin_amdgcn_exp2f(s0[i]); p1[i] = __builtin_amdgcn_exp2f(s1[i]); }
                {
                    float l0 = 0.f, l1 = 0.f;
#pragma unroll
                    for (int i = 0; i < 16; ++i) { l0 += p0[i]; l1 += p1[i]; }
                    lsum += l0 + l1;
                }
                if (BR == 1) {
#pragma unroll
                    for (int gq = 0; gq < 4; ++gq) {
                        const int jj = jc * 16 + gq * 2 + c.hi;
                        __hip_atomic_fetch_add(c.impw + jj, (p0[4 * gq] + p0[4 * gq + 1]) + (p0[4 * gq + 2] + p0[4 * gq + 3]), __ATOMIC_RELAXED, __HIP_MEMORY_SCOPE_WORKGROUP);
                        __hip_atomic_fetch_add(c.impw + jj + 1, p0[4 * gq + 3], __ATOMIC_RELAXED, __HIP_MEMORY_SCOPE_WORKGROUP);
                    }
#pragma unroll
                    for (int gq = 0; gq < 4; ++gq) {
                        const int jj = jc * 16 + 8 + gq * 2 + c.hi;
                        __hip_atomic_fetch_add(c.impw + jj, (p1[4 * gq] + p1[4 * gq + 1]) + (p1[4 * gq + 2] + p1[4 * gq + 3]), __ATOMIC_RELAXED, __HIP_MEMORY_SCOPE_WORKGROUP);
                        if (jj + 1 < 64) __hip_atomic_fetch_add(c.impw + jj + 1, p1[4 * gq + 3], __ATOMIC_RELAXED, __HIP_MEMORY_SCOPE_WORKGROUP);
                    }
                }
                if (BR != 0) {
                    unsigned pa[8], pb[8];
#pragma unroll
                    for (int i = 0; i < 8; ++i) { pa[i] = pk2(p0[2 * i], p0[2 * i + 1]); pb[i] = pk2(p1[2 * i], p1[2 * i + 1]); }
#pragma unroll
                    for (int f = 0; f < 2; ++f) {
                        const u32x4 bw0 = {pa[4 * f], pa[4 * f + 1], pa[4 * f + 2], pa[4 * f + 3]}, bw1 = {pb[4 * f], pb[4 * f + 1], pb[4 * f + 2], pb[4 * f + 3]};
#pragma unroll
                        for (int mt = 0; mt < 2; ++mt) {
                            const LAS bf16_t* vp = Vs + (mt * 32 + c.qi) * 68 + f * 16 + 4 * c.hi;
                            const u32x2 a0 = *(const LAS u32x2*)vp, a1 = *(const LAS u32x2*)(vp + 8), a2 = *(const LAS u32x2*)(vp + 32), a3 = *(const LAS u32x2*)(vp + 40);
                            const u32x4 aw0 = {a0.x, a0.y, a1.x, a1.y}, aw1 = {a2.x, a2.y, a3.x, a3.y};
                            o[mt] = MFMA32(__builtin_bit_cast(bf16x8, aw0), __builtin_bit_cast(bf16x8, bw0), o[mt]);
                            o[mt] = MFMA32(__builtin_bit_cast(bf16x8, aw1), __builtin_bit_cast(bf16x8, bw1), o[mt]);
                        }
                    }
                }
            } else {
#pragma unroll
            for (int sub = 0; sub < 2; ++sub) {
                const int key0 = jc * 64 + sub * 32;
                bool skip;
                if (BR <= 1) skip = key0 >= c.ncvw;
                else if (BR == 2) skip = key0 > c.tw + 31;
                else skip = (key0 + 31 < c.tw - 511) || (key0 > c.tw + 31);
                if (skip) continue;
                f32x16 s;
#pragma unroll
                for (int i = 0; i < 16; ++i) s[i] = sbias;
#pragma unroll
                for (int st = 0; st < 4; ++st) { const bf16x8 kf = *(const LAS bf16x8*)(Ks + (sub * 32 + c.qi) * 72 + 16 * st + 8 * c.hi); s = MFMA32(kf, c.q[st], s); }
                float p[16];
#pragma unroll
                for (int i = 0; i < 16; ++i) p[i] = __builtin_amdgcn_exp2f(s[i]);
                int lim;
                if (BR <= 1) lim = c.ncv - 1 - key0 - 4 * c.hi; else lim = c.t - key0 - 4 * c.hi;
#pragma unroll
                for (int i = 0; i < 16; ++i) { const int cst = (i & 3) + 8 * (i >> 2); bool valid = cst <= lim; if (BR == 3) valid = valid && (cst > lim - 512); p[i] = valid ? p[i] : 0.f; }
#pragma unroll
                for (int i = 0; i < 16; ++i) lsum += p[i];
                if (BR == 0) continue;
                if (BR == 1) {
#pragma unroll
                    for (int gq = 0; gq < 4; ++gq) {
                        const int jj = jc * 16 + sub * 8 + gq * 2 + c.hi;
                        __hip_atomic_fetch_add(c.impw + jj, (p[4 * gq] + p[4 * gq + 1]) + (p[4 * gq + 2] + p[4 * gq + 3]), __ATOMIC_RELAXED, __HIP_MEMORY_SCOPE_WORKGROUP);
                        if (jj + 1 < 64) __hip_atomic_fetch_add(c.impw + jj + 1, p[4 * gq + 3], __ATOMIC_RELAXED, __HIP_MEMORY_SCOPE_WORKGROUP);
                    }
                }
                unsigned pp[8];
#pragma unroll
                for (int i = 0; i < 8; ++i) pp[i] = pk2(p[2 * i], p[2 * i + 1]);
#pragma unroll
                for (int f = 0; f < 2; ++f) {
                    const u32x4 bw = {pp[4 * f], pp[4 * f + 1], pp[4 * f + 2], pp[4 * f + 3]};
                    const bf16x8 bfr = __builtin_bit_cast(bf16x8, bw);
#pragma unroll
                    for (int mt = 0; mt < 2; ++mt) {
                        const LAS bf16_t* vp = Vs + (mt * 32 + c.qi) * 68 + sub * 32 + f * 16 + 4 * c.hi;
                        const u32x2 a0 = *(const LAS u32x2*)vp, a1 = *(const LAS u32x2*)(vp + 8);
                        const u32x4 aw = {a0.x, a0.y, a1.x, a1.y};
                        o[mt] = MFMA32(__builtin_bit_cast(bf16x8, aw), bfr, o[mt]);
                    }
                }
            }
            }
        }
        if (!more) break;
        ++it;
    }
    __syncthreads();
}
DI void attn_item(const Args& a, int l, int item, LAS unsigned char* lds, bool dry = false) {
    const int tid = otid(), wid = tid >> 6, lane = tid & 63, qi = lane & 31, hi = lane >> 5;
    const int qb = item >> 4, bg = item & 15, b = bg >> 1, g = bg & 1;
    const int hh = wid >> 1, half = wid & 1, head = g * 4 + hh;
    const int t0 = qb * 64, tw = t0 + half * 32, t = tw + qi, tq = half * 32 + qi;
    bf16_t* PROJ = (bf16_t*)(a.ws + WS_PROJ);
    LAS float* imp = (LAS float*)(lds + AT_IMP);
    LAS unsigned long long* selm = (LAS unsigned long long*)(lds + AT_SEL);
    LAS float* linv = (LAS float*)(lds + AT_LINV);
    for (int i = tid; i < 4 * 64 * IMPP; i += 512) imp[i] = 0.f;
    const size_t qrow = (size_t)b * SEQ + t;
    AttnCtx c; c.nocompute = false;
#ifdef DRY_NOCOMPUTE
    c.nocompute = dry;
#endif
    c.t = t; c.tw = tw; c.qi = qi; c.hi = hi; c.tid = tid; c.lds = lds; c.mymask = 0ull; c.inv = 0.f;
    c.ncv = t >= 31 ? (t - 15) >> 4 : 0; c.ncvw = (tw + 16) >> 4; c.ncvmin = tw >= 31 ? (tw - 15) >> 4 : 0; c.impw = imp + (hh * 64 + tq) * IMPP;
    {
        const bf16_t* qp = PROJ + qrow * PP + C_Q + head * 64 + 8 * hi;
        float qf[4][8]; float ss = 0.f;
#pragma unroll
        for (int st = 0; st < 4; ++st) { unpack8(*(const u32x4*)(qp + 16 * st), qf[st]);
#pragma unroll
            for (int j = 0; j < 8; ++j) ss += qf[st][j] * qf[st][j]; }
        ss += __shfl_xor(ss, 32);
        const float sc = rsqrtf(ss * (1.f / 64.f) + 1e-6f) * 0.125f * 1.4426950408889634f;
        const float* qg = a.in[I_QGAIN] + l * 64 + 8 * hi;
#pragma unroll
        for (int st = 0; st < 4; ++st) {
#pragma unroll
            for (int j = 0; j < 8; ++j) qf[st][j] *= sc * qg[16 * st + j];
            c.q[st] = __builtin_bit_cast(bf16x8, pack8(qf[st]));
        }
    }
    const float g_c = bf1(PROJ[qrow * PP + C_NG + head * 3 + 0]), g_s = bf1(PROJ[qrow * PP + C_NG + head * 3 + 1]), g_w = bf1(PROJ[qrow * PP + C_NG + head * 3 + 2]);
    f32x16 ot[2], ob[2];
#pragma unroll
    for (int i = 0; i < 16; ++i) { ot[0][i] = 0.f; ot[1][i] = 0.f; ob[0][i] = 0.f; ob[1][i] = 0.f; }
    __syncthreads();
    {
        const int ntc = (((t0 + 48) >> 4) + 63) >> 6;
        const unsigned long long cm = (1ull << ntc) - 1ull;
        const bf16_t* kc = (const bf16_t*)(a.ws + WS_KCN) + (size_t)bg * 256 * 64;
        const bf16_t* vct = (const bf16_t*)(a.ws + WS_VCT) + (size_t)bg * 64 * 256;
        float lsum = 0.f;
        attn_branch<1>(c, cm, kc, 64, vct, 256, ob, lsum);
        lsum += __shfl_xor(lsum, 32);
        const float inv = lsum > 0.f ? 1.f / lsum : 0.f;
        if (hi == 0) linv[hh * 64 + tq] = inv;
        const float sc = g_c * inv;
#pragma unroll
        for (int i = 0; i < 16; ++i) { ot[0][i] += ob[0][i] * sc; ot[1][i] += ob[1][i] * sc; ob[0][i] = 0.f; ob[1][i] = 0.f; }
    }
    __syncthreads();
    if (qb < 16) { if (lane < 8) selm[wid * 8 + lane] = (2ull << qb) - 1ull; }
    else
    for (int k = 0; k < 8; ++k) {
        const int tk = wid * 8 + k;
        float val = (imp[(0 * 64 + tk) * IMPP + lane] * linv[tk] + imp[(1 * 64 + tk) * IMPP + lane] * linv[64 + tk]) + (imp[(2 * 64 + tk) * IMPP + lane] * linv[128 + tk] + imp[(3 * 64 + tk) * IMPP + lane] * linv[192 + tk]);
        const bool causal = lane <= qb, forced = (lane == 0) || (lane == qb) || (lane == qb - 1);
        val = causal ? val + (forced ? 1000.f : 0.f) : -1.f;
        int rank = 0;
#pragma unroll
        for (int j = 0; j < 64; ++j) { const float vj = __builtin_bit_cast(float, __builtin_amdgcn_readlane(__builtin_bit_cast(int, val), j)); rank += (vj > val || (vj == val && j < lane)) ? 1 : 0; }
        const unsigned long long mk = __ballot(rank < 16 && causal);
        if (lane == 0) selm[tk] = mk;
    }
    __syncthreads();
    {
        c.mymask = selm[tq];
        const unsigned long long all = selm[lane];
        unsigned long long um = 0ull;
        for (int j = 0; j <= qb; ++j) if (__ballot((all >> j) & 1ull) != 0ull) um |= 1ull << j;
        float lsum = 0.f;
        attn_branch<2>(c, um, PROJ + (size_t)b * SEQ * PP + C_KS + g * 64, PP, (const bf16_t*)(a.ws + WS_VST) + (size_t)bg * 64 * SEQ, SEQ, ob, lsum);
        lsum += __shfl_xor(lsum, 32);
        const float sc = lsum > 0.f ? g_s / lsum : 0.f;
#pragma unroll
        for (int i = 0; i < 16; ++i) { ot[0][i] += ob[0][i] * sc; ot[1][i] += ob[1][i] * sc; ob[0][i] = 0.f; ob[1][i] = 0.f; }
    }
    {
        const int jlo = qb >= 8 ? qb - 8 : 0;
        const unsigned long long wm = ((qb == 63 ? ~0ull : ((1ull << (qb + 1)) - 1ull)) >> jlo) << jlo;
        float lsum = 0.f;
        attn_branch<3>(c, wm, PROJ + (size_t)b * SEQ * PP + C_KW + g * 64, PP, (const bf16_t*)(a.ws + WS_VWT) + (size_t)bg * 64 * SEQ, SEQ, ob, lsum);
        lsum += __shfl_xor(lsum, 32);
        const float sc = lsum > 0.f ? g_w / lsum : 0.f;
#pragma unroll
        for (int i = 0; i < 16; ++i) { ot[0][i] += ob[0][i] * sc; ot[1][i] += ob[1][i] * sc; }
    }
    if (!dry || a.ph_hi == 12345) {
        bf16_t* op = PROJ + qrow * PP + C_Q + head * 64 + 4 * hi;
#pragma unroll
        for (int mt = 0; mt < 2; ++mt)
#pragma unroll
            for (int gq = 0; gq < 4; ++gq) { u32x2 w; w.x = pk2(ot[mt][4 * gq], ot[mt][4 * gq + 1]); w.y = pk2(ot[mt][4 * gq + 2], ot[mt][4 * gq + 3]); *(u32x2*)(op + mt * 32 + gq * 8) = w; }
    }
    __syncthreads();
}
#ifndef SCAN_RPL
#define SCAN_RPL 2
#endif
DI void phase_mix(const Args& a, int l, LAS unsigned char* lds) {
    const int nscan = 128;
    if ((int)blockIdx.x < nscan) {
#ifdef DUPSCAN
        for (int rep = 0; rep < 2; ++rep)
#endif
        { scan_bh2(a, l, blockIdx.x >> 1, blockIdx.x & 1, lds); }
        if (gridDim.x - nscan == 128) { const int sb = blockIdx.x, xcd = sb & 7, slot = sb >> 3; attn_item(a, l, slot * 16 + 2 * xcd, lds); }
    } else { const int na = gridDim.x - nscan;
#ifdef DUPATTN
        for (int it = blockIdx.x - nscan; it < 1024; it += na) attn_item(a, l, it, lds, true);
#endif
        if (na == 128) {
            const int ab = blockIdx.x - nscan, xcd = ab & 7, slot = ab >> 3;
            for (int r = 0; r < 8; ++r) {
                const int bg = 2 * xcd + (r >> 2), rr = r & 3;
                const int qb = rr == 0 ? 63 - slot : rr == 1 ? slot : rr == 2 ? 47 - slot : 16 + slot;
                if (r == 1) continue;
                attn_item(a, l, qb * 16 + bg, lds);
            }
        } else { for (int it = blockIdx.x - nscan; it < 1024; it += na) attn_item(a, l, it, lds); } }
}

DI void post_item(const Args& a, int l, int item, LAS unsigned char* lds) {
    const int tid = otid(), wid = tid >> 6, lane = tid & 63, fr = lane & 15, fq = lane >> 4;
    const int b = item >> 6, t0 = (item & 63) * 64;
    bf16_t* PROJ = (bf16_t*)(a.ws + WS_PROJ); const bf16_t* PREP = (const bf16_t*)(a.ws + WS_PREP); const bf16_t* W = (const bf16_t*)(a.ws + WS_W);
    LAS bf16_t* A_g = (LAS bf16_t*)lds; LAS bf16_t* z_s = (LAS bf16_t*)(lds + 17408);
    constexpr int PZ = 520;
    const float* mu = a.in[I_TOKMIX] + l * 1792;
    {
        const int token = tid >> 3, part = tid & 7; const size_t row = (size_t)b * SEQ + t0 + token; const bool hp = (t0 + token) > 0;
#pragma unroll
        for (int hf = 0; hf < 2; ++hf) {
            float v[8]; const int cc = part * 16 + hf * 8;
            lerp8(PROJ + row * PP + C_GL + cc, PROJ + (row - 1) * PP + C_GL + cc, hp, mu + (C_GL - C_R) + cc, v);
#pragma unroll
            for (int i = 0; i < 8; ++i) v[i] = sigm(v[i]);
            *(LAS u32x4*)(A_g + token * 136 + cc) = pack8(v);
        }
    }
    {
        const int cgp = tid & 63, head = cgp >> 3, k0 = (cgp & 7) * 8, c = cgp * 8;
        float rk[8], lw[8], lb[8];
        {
            const float* srcs[3] = {a.in[I_RK] + l * 512 + c, a.in[I_LNW] + l * 512 + c, a.in[I_LNB] + l * 512 + c};
            float* dsts[3] = {rk, lw, lb};
#pragma unroll
            for (int q = 0; q < 3; ++q) { const f32x4 t0v = *(const f32x4*)srcs[q], t1v = *(const f32x4*)(srcs[q] + 4);
#pragma unroll
                for (int i = 0; i < 4; ++i) { dsts[q][i] = t0v[i]; dsts[q][4 + i] = t1v[i]; } }
        }
        u32x4 raw[4];
        auto load_unit = [&](int u) {
            const int token = u * 8 + (tid >> 6); const size_t row = (size_t)b * SEQ + t0 + token;
            raw[0] = *(const u32x4*)((const bf16_t*)(a.ws + WS_Y) + row * 512 + c);
            const bf16_t* ip = PREP + ((size_t)(b * 8 + head) * SEQ + t0 + token) * 192 + k0;
            raw[1] = *(const u32x4*)ip; raw[2] = *(const u32x4*)(ip + 64); raw[3] = *(const u32x4*)(ip + 128);
        };
        load_unit(0);
#pragma unroll 1
        for (int u = 0; u < 8; ++u) {
            const int token = u * 8 + (tid >> 6);
            float y[8], r[8], k[8], v[8];
            unpack8(raw[0], y); unpack8(raw[1], r); unpack8(raw[2], k); unpack8(raw[3], v);
            if (u + 1 < 8) load_unit(u + 1);
            float sm = 0.f;
#pragma unroll
            for (int i = 0; i < 8; ++i) sm += y[i];
            const float mean = red8(sm) * (1.f / 64.f);
            float sv = 0.f;
#pragma unroll
            for (int i = 0; i < 8; ++i) { y[i] -= mean; sv += y[i] * y[i]; }
            const float rstd = rsqrtf(red8(sv) * (1.f / 64.f) + 64e-5f);
            float dot = 0.f;
#pragma unroll
            for (int i = 0; i < 8; ++i) dot += r[i] * k[i] * rk[i];
            dot = red8(dot);
            float z[8];
#pragma unroll
            for (int i = 0; i < 8; ++i) z[i] = y[i] * rstd * lw[i] + lb[i] + dot * v[i];
            *(LAS u32x4*)(z_s + token * PZ + c) = pack8(z);
        }
    }
    __syncthreads();
    {
        f32x4 acc[4][4];
#pragma unroll
        for (int m = 0; m < 4; ++m)
#pragma unroll
            for (int n = 0; n < 4; ++n) acc[m][n] = (f32x4){0.f, 0.f, 0.f, 0.f};
#pragma unroll
        for (int ks = 0; ks < 4; ++ks) {
            bf16x8 ag[4];
#pragma unroll
            for (int m = 0; m < 4; ++m) ag[m] = *(const LAS bf16x8*)(A_g + (m * 16 + fr) * 136 + ks * 32 + fq * 8);
#pragma unroll
            for (int n = 0; n < 4; ++n) {
                const bf16x8 bgf = *(const bf16x8*)(W + W_GL + (size_t)(wid * 64 + n * 16 + fr) * 128 + ks * 32 + fq * 8);
#pragma unroll
                for (int m = 0; m < 4; ++m) acc[m][n] = MFMA16(ag[m], bgf, acc[m][n]);
            }
        }
#pragma unroll
        for (int m = 0; m < 4; ++m)
#pragma unroll
            for (int n = 0; n < 4; ++n)
#pragma unroll
                for (int r = 0; r < 4; ++r) { const int idx = (m * 16 + fq * 4 + r) * PZ + wid * 64 + n * 16 + fr; z_s[idx] = tobf(bf1(z_s[idx]) * acc[m][n][r]); }
    }
    __syncthreads();
#pragma unroll
    for (int u = 0; u < 8; ++u) {
        const int id = u * 512 + tid, token = id >> 6, cgp = id & 63;
        *(u32x4*)(PROJ + ((size_t)b * SEQ + t0 + token) * PP + C_R + cgp * 8) = *(const LAS u32x4*)(z_s + token * PZ + cgp * 8);
    }
    __syncthreads();
}

#ifndef PHMASK
#define PHMASK 0x3ff
#endif
#define PHEN(k) ((PHMASK >> (k)) & 1)
__global__ void __launch_bounds__(512, 2) fwd_kernel(Args a) {
    extern __shared__ __attribute__((aligned(16))) unsigned char lds_raw[];
    LAS unsigned char* lds = (LAS unsigned char*)lds_raw;
    cg::grid_group grid = cg::this_grid();
    volatile LAS unsigned* xst = (volatile LAS unsigned*)(lds + LDS_BYTES - 16);
    if (threadIdx.x == 0) { xst[0] = 0u; xst[1] = 0u; }
    __syncthreads();
    const XcdBarrier xb = xcd_barrier_post((unsigned*)(a.ws + WS_BAR), xst);
#pragma unroll 1
    for (int ph = a.ph_lo; ph < a.ph_hi; ++ph) {
        const int l = ph / 10, p = ph % 10;
        if (p == 7) continue;
        if (ph > a.ph_lo) { if (a.ph_hi == 12345) grid.sync(); else xcd_barrier(xb); }
        { size_t z_ = 0; asm volatile("" : "+s"(z_)); a.ws = a.ws + z_; a.out = a.out + z_; }
        bf16_t* W = (bf16_t*)(a.ws + WS_W);
        bf16_t* PROJ = (bf16_t*)(a.ws + WS_PROJ);
#ifdef DUPMASK
        const int nrep = ((DUPMASK >> p) & 1) ? 2 : 1;
#else
        const int nrep = 1;
#endif
#pragma unroll 1
        for (int rep = 0; rep < nrep; ++rep) {
        if (rep) grid.sync();
        if (PHEN(0) && p == 0) { phase_conv(a, l, lds); __syncthreads(); }
        else if (PHEN(1) && p == 1) {
            pg8::Gemm g{(const bf16_t*)(a.ws + WS_U), W + W_IN, M_TOK, NPROJ_P, DM, DM}; pg8::StaticOrder S; S.init(M_TOK, NPROJ_P, gridDim.x, (int)blockIdx.x);
            pg8::EpiProj E{PROJ, (uint8_t*)(a.ws + WS_GATE), l == 0 ? nullptr : (const float*)(a.ws + WS_SS) + M_TOK};
            pg8::gemm_phase<pg8::EpiProj, pg8::StaticOrder, true, true>(lds, g, S, E);
        }
        else if (PHEN(2) && p == 2) phase_prep(a, l, lds);
        else if (PHEN(3) && p == 3) phase_mix(a, l, lds);
        else if (PHEN(4) && p == 4) { for (int it = blockIdx.x; it < 512; it += gridDim.x) post_item(a, l, it, lds); }
        else if (PHEN(5) && p == 5) {
            { pg8::Gemm g{PROJ + C_Q, W + W_A, M_TOK, DM, 512, PP}; pg8::StaticOrder S; S.init(M_TOK, DM, gridDim.x, (int)blockIdx.x);
              pg8::EpiMerge<false> E{(bf16_t*)(a.ws + WS_MERGED), (const uint8_t*)(a.ws + WS_GATE)};
              pg8::gemm_phase<pg8::EpiMerge<false>, pg8::StaticOrder, true, true>(lds, g, S, E); }
            { pg8::Gemm g{PROJ + C_R, W + W_B, M_TOK, DM, 512, PP}; pg8::StaticOrder S; S.init(M_TOK, DM, gridDim.x, (int)blockIdx.x);
              pg8::EpiMerge<true> E{(bf16_t*)(a.ws + WS_MERGED), (const uint8_t*)(a.ws + WS_GATE)};
              pg8::gemm_phase<pg8::EpiMerge<true>, pg8::StaticOrder, true, true>(lds, g, S, E); }
        }
        else if (PHEN(6) && p == 6) {
            pg8::Gemm g{(const bf16_t*)(a.ws + WS_MERGED), W + W_OUT, M_TOK, DM, DM, DM}; pg8::StaticOrder S; S.init(M_TOK, DM, gridDim.x, (int)blockIdx.x);
            pg8::EpiResF32 E{l == 0 ? a.in[I_X] : a.out, a.out, (bf16_t*)(a.ws + WS_HN), a.in[I_FFNNORM] + l * DM, (float*)(a.ws + WS_SS) + (l == 0 ? 0 : 2 * M_TOK)};
            pg8::gemm_phase<pg8::EpiResF32, pg8::StaticOrder, true, true>(lds, g, S, E);
        }
        else if (PHEN(7) && p == 7) phase_norm2(a, l);
        else if (PHEN(8) && p == 8) {
            pg8::Gemm g{(const bf16_t*)(a.ws + WS_HN), W + W_UP, M_TOK, 4096, DM, DM}; pg8::StaticOrder S; S.init(M_TOK, 4096, gridDim.x, (int)blockIdx.x);
            pg8::EpiRelu2 E{(bf16_t*)(a.ws + WS_H), (const float*)(a.ws + WS_SS) + (l == 0 ? 0 : 2 * M_TOK)};
            pg8::gemm_phase<pg8::EpiRelu2, pg8::StaticOrder, true, true>(lds, g, S, E);
        }
        else if (PHEN(9)) {
            pg8::Gemm g{(const bf16_t*)(a.ws + WS_H), W + W_DOWN, M_TOK, DM, 4096, 4096}; pg8::StaticOrder S; S.init(M_TOK, DM, gridDim.x, (int)blockIdx.x);
            pg8::EpiResF32 E{a.out, a.out, l == 0 ? (bf16_t*)(a.ws + WS_U) : nullptr, a.in[I_MIXNORM] + DM, (float*)(a.ws + WS_SS) + M_TOK};
            pg8::gemm_phase<pg8::EpiResF32, pg8::StaticOrder, true, true>(lds, g, S, E);
        }
        }
    }
}

#ifndef N_PHASE_LAUNCH
#define N_PHASE_LAUNCH 20
#endif
extern "C" void kernel_launch(void* const* d_in, const int* in_sizes, int n_in, void* d_out, int out_size, void* d_ws, size_t ws_size, hipStream_t stream) {
    static int grid = 0;
    if (grid == 0) {
        int dev = 0, cus = 0, per_cu = 0;
        (void)hipGetDevice(&dev);
        (void)hipDeviceGetAttribute(&cus, hipDeviceAttributeMultiprocessorCount, dev);
        if (hipFuncSetAttribute((const void*)fwd_kernel, hipFuncAttributeMaxDynamicSharedMemorySize, LDS_BYTES) != hipSuccess) { fprintf(stderr, "hipFuncSetAttribute failed\n"); grid = -1; return; }
        (void)hipOccupancyMaxActiveBlocksPerMultiprocessor(&per_cu, (const void*)fwd_kernel, 512, LDS_BYTES);
        if (per_cu < 1) { fprintf(stderr, "occupancy query says %d blocks per CU\n", per_cu); per_cu = 1; }
        (void)hipGetLastError();
        grid = cus;
        if (ws_size < 502 * MiB) { fprintf(stderr, "workspace too small: %zu\n", ws_size); grid = -1; return; }
    }
    if (grid < 0) return;
    if (hipMemsetAsync((char*)d_ws + WS_BAR, 0, XCD_BAR_WORDS * 4, stream) != hipSuccess) { fprintf(stderr, "memset of the barrier words failed\n"); return; }
    Args a{};
    for (int i = 0; i < 25; ++i) a.in[i] = (const float*)d_in[i];
    a.out = (float*)d_out; a.ws = (unsigned char*)d_ws;
    for (int lo = 0; lo < 20; lo += N_PHASE_LAUNCH) {
        a.ph_lo = lo; a.ph_hi = lo + N_PHASE_LAUNCH > 20 ? 20 : lo + N_PHASE_LAUNCH;
        void* args[] = {&a};
        hipError_t e;
        if (N_PHASE_LAUNCH > 1) e = hipLaunchCooperativeKernel((const void*)fwd_kernel, dim3(grid), dim3(512), args, LDS_BYTES, stream);
        else e = hipLaunchKernel((const void*)fwd_kernel, dim3(grid), dim3(512), args, LDS_BYTES, stream);
        if (e != hipSuccess) { fprintf(stderr, "launch failed: %s\n", hipGetErrorString(e)); break; }
    }
}
```

```cpp
#include <hip/hip_runtime.h>
#include <hip/hip_cooperative_groups.h>
#include <cstdio>
#include <cstdint>
namespace cg = cooperative_groups;
namespace pg8 {
#define PG8_LAS __attribute__((address_space(3)))
typedef unsigned short bf16_t;
typedef short bf16x8 __attribute__((ext_vector_type(8)));
typedef float f32x4 __attribute__((ext_vector_type(4)));
typedef unsigned u32x4 __attribute__((ext_vector_type(4)));
constexpr int BM = 256, BK = 64, HALF = 128, HTB = HALF * BK * 2  , STAGE_BYTES = 8 * HTB, NXCD = 8, WGM = 8;

__host__ __device__ __forceinline__ int lds_byte(int r, int c) { const int st = (r >> 4) * 2 + (c >> 5), rr = r & 15, cc = c & 31, ob = rr * 64 + cc * 2; return st * 1024 + (ob ^ (((ob >> 9) & 1) << 5)); }
__host__ __device__ __forceinline__ void stage_rc(int b, int& R, int& C) { const int st = b / 1024, sb = b % 1024, swz = sb ^ (((sb >> 9) & 1) << 5); R = (st >> 1) * 16 + swz / 64; C = (st & 1) * 32 + (swz % 64) / 2; }
__host__ __device__ __forceinline__ int perm32(int rho) { const int n = rho >> 4, i = rho & 15; return 8 * (i >> 2) + 4 * n + (i & 3); }

struct Unit { int pm, pn; };
struct Gemm { const bf16_t* A; const bf16_t* Bt; int M, N, K, lda; };

struct StaticOrder {
    int nM, nN, nwg, G, c;
    __host__ __device__ void init(int M, int N, int G_, int c_) { nM = M / BM; nN = N / BM; nwg = nM * nN; G = G_; c = c_; }
    __host__ __device__ bool next(int i, Unit& u) const {
        const long L = (long)i * G + c; if (L >= nwg) return false;
        int wgid = (int)L; { const int q = nwg / NXCD, r = nwg % NXCD, xcd = wgid % NXCD, off = wgid / NXCD; wgid = (xcd < r ? xcd * (q + 1) : r * (q + 1) + (xcd - r) * q) + off; }
        const int nig = WGM * nN, gid = wgid / nig, fm = gid * WGM, gsz = (nM - fm) < WGM ? (nM - fm) : WGM;
        u.pm = fm + ((wgid % nig) % gsz); u.pn = (wgid % nig) / gsz; return true;
    }
    __device__ __forceinline__ void a_ready(const Unit&) const {}
    __device__ __forceinline__ void done(const Unit&) const {}
};
__device__ __forceinline__ unsigned cvt_pk_bf16(float lo, float hi) { unsigned r; asm volatile("v_cvt_pk_bf16_f32 %0, %1, %2" : "=v"(r) : "v"(lo), "v"(hi)); return r; }
template <class Epi, class Sched, bool ALIGN_EPI = false, bool SP2 = false>
__device__ __forceinline__ void gemm_phase(PG8_LAS unsigned char* lds, const Gemm g, const Sched& S, const Epi& E) {
    int tid_ = threadIdx.x; asm volatile("" : "+v"(tid_));
    const int tid = tid_, wid = __builtin_amdgcn_readfirstlane(tid >> 6), lane = tid & 63, wr = wid >> 2, wc = wid & 3, fr = lane & 15, fq = lane >> 4;
    const int K = g.K, nt = K / BK;
    unsigned voffA[2], voffB[2];
#pragma unroll
    for (int i = 0; i < 2; ++i) { int R, C; stage_rc(tid * 16 + i * 8192, R, C); const int Rb = Epi::PERM ? ((R & ~31) + perm32(R & 31)) : R;
        voffA[i] = (unsigned)(R * g.lda + C) * 2u; voffB[i] = (unsigned)(Rb * K + C) * 2u; }
    const size_t kstep = (size_t)(BK * 2);
    const size_t hstepB = (size_t)HALF * K * 2, hstepA = (size_t)HALF * g.lda * 2;
    const size_t tstepA = 2 * hstepA, tstepB = 2 * hstepB;
    const unsigned ldsw = (unsigned)wid * 1024u;
    const int aoff = lds_byte(wr * 64 + fr, fq * 8), boff = lds_byte(wc * 32 + fr, fq * 8);
#define PG8_SA(b, h) (((b) * 2 + (h)) * HTB)
#define PG8_SB(b, h) ((4 + (b) * 2 + (h)) * HTB)
#define PG8_STAGE(bufoff, gbase, voff) do { _Pragma("unroll") for (int _i = 0; _i < 2; ++_i) \
        __builtin_amdgcn_global_load_lds((const unsigned*)((const char*)(gbase) + (voff)[_i]), (PG8_LAS unsigned*)(lds + (bufoff) + ldsw + _i * 8192), 16, 0, 0); } while (0)
#define PG8_LDA(dst, b, h) do { _Pragma("unroll") for (int m = 0; m < 4; ++m) _Pragma("unroll") for (int k = 0; k < 2; ++k) dst[m][k] = *(const PG8_LAS bf16x8*)(lds + PG8_SA(b, h) + aoff + m * 2048 + k * 1024); } while (0)
#define PG8_LDB(dst, b, h) do { _Pragma("unroll") for (int n = 0; n < 2; ++n) _Pragma("unroll") for (int k = 0; k < 2; ++k) dst[n][k] = *(const PG8_LAS bf16x8*)(lds + PG8_SB(b, h) + boff + n * 2048 + k * 1024); } while (0)
#define PG8_MMA(ai, bj, At, Bt) do { __builtin_amdgcn_s_setprio(1); _Pragma("unroll") for (int m = 0; m < 4; ++m) _Pragma("unroll") for (int n = 0; n < 2; ++n) _Pragma("unroll") for (int k = 0; k < 2; ++k) \
        acc[ai][bj][m][n] = __builtin_amdgcn_mfma_f32_16x16x32_bf16(Bt[n][k], At[m][k], acc[ai][bj][m][n], 0, 0, 0); __builtin_amdgcn_s_setprio(0); } while (0)
#define PG8_WAIT_V(n) asm volatile("s_waitcnt vmcnt(" #n ")" ::: "memory")
#define PG8_WAIT_L(n) asm volatile("s_waitcnt lgkmcnt(" #n ")" ::: "memory")
#define PG8_BAR __builtin_amdgcn_s_barrier()
#define PG8_SCHED __builtin_amdgcn_sched_barrier(0)
    Unit cur, nxt; int ui = 0;
    if (!S.next(0, cur)) return;
    f32x4 acc[2][2][4][2];
#pragma unroll
    for (int a = 0; a < 2; ++a)
#pragma unroll
        for (int b = 0; b < 2; ++b)
#pragma unroll
            for (int m = 0; m < 4; ++m)
#pragma unroll
                for (int n = 0; n < 2; ++n) acc[a][b][m][n] = (f32x4){0.f, 0.f, 0.f, 0.f};
    bf16x8 At[4][2], B0[2][2], B1[2][2];
    const char* cA = (const char*)g.A + (size_t)cur.pm * tstepA; const char* cB = (const char*)g.Bt + (size_t)cur.pn * tstepB;
    S.a_ready(cur);
    if constexpr (SP2) {
        PG8_STAGE(PG8_SB(0, 0), cB, voffB); PG8_STAGE(PG8_SB(0, 1), cB + hstepB, voffB); PG8_STAGE(PG8_SA(0, 0), cA, voffA); PG8_STAGE(PG8_SA(0, 1), cA + hstepA, voffA);
        if (wr == 1) PG8_BAR;
        PG8_WAIT_V(2); PG8_BAR;
        PG8_STAGE(PG8_SB(1, 0), cB + kstep, voffB); PG8_STAGE(PG8_SA(1, 0), cA + kstep, voffA); PG8_STAGE(PG8_SB(1, 1), cB + hstepB + kstep, voffB);
        PG8_WAIT_V(6); PG8_BAR;
    } else {
        PG8_STAGE(PG8_SB(0, 0), cB, voffB); PG8_STAGE(PG8_SA(0, 0), cA, voffA); PG8_STAGE(PG8_SB(0, 1), cB + hstepB, voffB); PG8_STAGE(PG8_SA(0, 1), cA + hstepA, voffA);
        if (wr == 1) PG8_BAR;
        PG8_WAIT_V(4); PG8_BAR;
        PG8_STAGE(PG8_SB(1, 0), cB + kstep, voffB); PG8_STAGE(PG8_SA(1, 0), cA + kstep, voffA); PG8_STAGE(PG8_SB(1, 1), cB + hstepB + kstep, voffB);
        PG8_WAIT_V(6); PG8_BAR;
    }
    for (;;) {
        const bool has_next = S.next(ui + 1, nxt);
        const char* nA = has_next ? (const char*)g.A + (size_t)nxt.pm * tstepA : cA; const char* nB = has_next ? (const char*)g.Bt + (size_t)nxt.pn * tstepB : cB;
        for (int t = 0; t < nt; t += 2) {
            const bool last = (t == nt - 2);
            const char* a1 = cA + (size_t)(t + 1) * kstep;
            const char* a2 = last ? nA : cA + (size_t)(t + 2) * kstep; const char* b2 = last ? nB : cB + (size_t)(t + 2) * kstep;
            const char* a3 = a2 + kstep; const char* b3 = b2 + kstep;
            if (last && has_next) S.a_ready(nxt);
            if constexpr (SP2) {
            PG8_LDB(B0, 0, 0); PG8_LDB(B1, 0, 1); PG8_SCHED; PG8_LDA(At, 0, 0); PG8_STAGE(PG8_SA(1, 1), a1 + hstepA, voffA);
            PG8_WAIT_V(8); PG8_WAIT_L(0); PG8_BAR; PG8_MMA(0, 0, At, B0); PG8_MMA(0, 1, At, B1); PG8_BAR; PG8_SCHED;
            PG8_LDA(At, 0, 1); PG8_STAGE(PG8_SB(0, 0), b2, voffB); PG8_STAGE(PG8_SB(0, 1), b2 + hstepB, voffB); PG8_STAGE(PG8_SA(0, 0), a2, voffA);
            PG8_WAIT_V(8); PG8_WAIT_L(0); PG8_BAR; PG8_MMA(1, 0, At, B0); PG8_MMA(1, 1, At, B1); PG8_BAR; PG8_SCHED;
            PG8_LDB(B0, 1, 0); PG8_LDB(B1, 1, 1); PG8_SCHED; PG8_LDA(At, 1, 0); PG8_STAGE(PG8_SA(0, 1), a2 + hstepA, voffA);
            PG8_WAIT_V(8); PG8_WAIT_L(0); PG8_BAR; PG8_MMA(0, 0, At, B0); PG8_MMA(0, 1, At, B1); PG8_BAR; PG8_SCHED;
            PG8_LDA(At, 1, 1); PG8_STAGE(PG8_SB(1, 0), b3, voffB); PG8_STAGE(PG8_SB(1, 1), b3 + hstepB, voffB); PG8_STAGE(PG8_SA(1, 0), a3, voffA);
            PG8_WAIT_V(8); PG8_WAIT_L(0); PG8_BAR; PG8_MMA(1, 0, At, B0); PG8_MMA(1, 1, At, B1); PG8_BAR; PG8_SCHED;
            } else {
            PG8_LDB(B0, 0, 0); PG8_SCHED; PG8_LDA(At, 0, 0); PG8_STAGE(PG8_SA(1, 1), a1 + hstepA, voffA);
            PG8_WAIT_L(8); PG8_BAR; PG8_WAIT_L(0); PG8_MMA(0, 0, At, B0); PG8_BAR; PG8_SCHED;
            PG8_LDB(B1, 0, 1); PG8_STAGE(PG8_SB(0, 0), b2, voffB);
            PG8_BAR; PG8_WAIT_L(0); PG8_MMA(0, 1, At, B1); PG8_BAR;
            PG8_LDA(At, 0, 1); PG8_STAGE(PG8_SA(0, 0), a2, voffA);
            PG8_BAR; PG8_WAIT_L(0); PG8_MMA(1, 0, At, B0); PG8_BAR; PG8_SCHED;
            PG8_STAGE(PG8_SB(0, 1), b2 + hstepB, voffB);
            PG8_WAIT_V(6); PG8_BAR; PG8_MMA(1, 1, At, B1); PG8_BAR;
            PG8_LDB(B0, 1, 0); PG8_SCHED; PG8_LDA(At, 1, 0); PG8_STAGE(PG8_SA(0, 1), a2 + hstepA, voffA);
            PG8_WAIT_L(8); PG8_BAR; PG8_WAIT_L(0); PG8_MMA(0, 0, At, B0); PG8_BAR; PG8_SCHED;
            PG8_LDB(B1, 1, 1); PG8_STAGE(PG8_SB(1, 0), b3, voffB);
            PG8_BAR; PG8_WAIT_L(0); PG8_MMA(0, 1, At, B1); PG8_BAR;
            PG8_LDA(At, 1, 1); PG8_STAGE(PG8_SA(1, 0), a3, voffA);
            PG8_BAR; PG8_WAIT_L(0); PG8_MMA(1, 0, At, B0); PG8_BAR; PG8_SCHED;
            PG8_STAGE(PG8_SB(1, 1), b3 + hstepB, voffB);
            PG8_WAIT_V(6); PG8_BAR; PG8_MMA(1, 1, At, B1); PG8_BAR;
            }
        }
        if constexpr (ALIGN_EPI) { if (wr == 0) PG8_BAR; }
        if constexpr (!Epi::AFTER_DRAIN) { E(acc, cur, wr, wc, fr, fq); S.done(cur); }
        if (!has_next) break;
#pragma unroll
        for (int a = 0; a < 2; ++a)
#pragma unroll
            for (int b = 0; b < 2; ++b)
#pragma unroll
                for (int m = 0; m < 4; ++m)
#pragma unroll
                    for (int n = 0; n < 2; ++n) acc[a][b][m][n] = (f32x4){0.f, 0.f, 0.f, 0.f};
        cur = nxt; cA = nA; cB = nB; ++ui;
        if constexpr (ALIGN_EPI) { if (wr == 1) PG8_BAR; }
    }
    PG8_WAIT_V(0);
    if constexpr (!ALIGN_EPI) { if (wr == 0) PG8_BAR; }
    PG8_BAR;
    if constexpr (Epi::AFTER_DRAIN) { E.fused(acc, cur, wr, wc, fr, fq, lds, wid, lane); S.done(cur); }
#undef PG8_SA
#undef PG8_SB
#undef PG8_STAGE
#undef PG8_LDA
#undef PG8_LDB
#undef PG8_MMA
#undef PG8_WAIT_V
#undef PG8_WAIT_L
#undef PG8_BAR
#undef PG8_SCHED
}
}

#define LAS __attribute__((address_space(3)))
#define DI __device__ __forceinline__
typedef unsigned short bf16_t;
typedef short bf16x8 __attribute__((ext_vector_type(8)));
typedef float f32x4 __attribute__((ext_vector_type(4)));
typedef float f32x2 __attribute__((ext_vector_type(2)));
typedef float f32x16 __attribute__((ext_vector_type(16)));
typedef unsigned u32x4 __attribute__((ext_vector_type(4)));
typedef unsigned u32x2 __attribute__((ext_vector_type(2)));
typedef __bf16 bf2_t __attribute__((ext_vector_type(2)));

DI int otid() { int t = threadIdx.x; asm volatile("" : "+v"(t)); return t; }
DI unsigned pk2(float a, float b) { f32x2 v = {a, b}; bf2_t r = __builtin_convertvector(v, bf2_t); return __builtin_bit_cast(unsigned, r); }
DI float bflo(unsigned w) { return __uint_as_float(w << 16); }
DI float bfhi(unsigned w) { return __uint_as_float(w & 0xffff0000u); }
DI float bf1(bf16_t h) { return __uint_as_float(((unsigned)h) << 16); }
DI bf16_t tobf(float x) { return (bf16_t)(pk2(x, 0.f) & 0xffffu); }
DI float sigm(float x) { return __builtin_amdgcn_rcpf(1.f + __expf(-x)); }
DI float tanh_fast(float x) { return 1.f - 2.f * __builtin_amdgcn_rcpf(1.f + __expf(2.f * x)); }
DI void unpack8(const u32x4 w, float* f) { f[0] = bflo(w.x); f[1] = bfhi(w.x); f[2] = bflo(w.y); f[3] = bfhi(w.y); f[4] = bflo(w.z); f[5] = bfhi(w.z); f[6] = bflo(w.w); f[7] = bfhi(w.w); }
DI u32x4 pack8(const float* f) { u32x4 w; w.x = pk2(f[0], f[1]); w.y = pk2(f[2], f[3]); w.z = pk2(f[4], f[5]); w.w = pk2(f[6], f[7]); return w; }
template <int CTRL> DI float dpp_add(float x) { return x + __builtin_bit_cast(float, __builtin_amdgcn_update_dpp(0, __builtin_bit_cast(int, x), CTRL, 0xf, 0xf, true)); }
DI float red4(float x) { x = dpp_add<0xB1>(x); x = dpp_add<0x4E>(x); return x; }
DI float red8(float x) { x = red4(x); x = dpp_add<0x141>(x); return x; }
DI float red16(float x) { x = red8(x); x = dpp_add<0x140>(x); return x; }
#define DPP_ADD2(a, b, ctrl) asm("s_nop 1\n\tv_add_f32_dpp %0, %0, %0 " ctrl " row_mask:0xf bank_mask:0xf bound_ctrl:1\n\tv_add_f32_dpp %1, %1, %1 " ctrl " row_mask:0xf bank_mask:0xf bound_ctrl:1" : "+v"(a), "+v"(b))
DI void red16x2(float& a, float& b) { DPP_ADD2(a, b, "quad_perm:[1,0,3,2]"); DPP_ADD2(a, b, "quad_perm:[2,3,0,1]"); DPP_ADD2(a, b, "row_half_mirror"); DPP_ADD2(a, b, "row_mirror"); }
DI float wave_sum(float v) {
#pragma unroll
    for (int o = 1; o < 64; o <<= 1) v += __shfl_xor(v, o);
    return v;
}
#define MFMA16(a, b, c) __builtin_amdgcn_mfma_f32_16x16x32_bf16((a), (b), (c), 0, 0, 0)
#define MFMA32(a, b, c) __builtin_amdgcn_mfma_f32_32x32x16_bf16((a), (b), (c), 0, 0, 0)

constexpr int M_TOK = 32768, DM = 1024, SEQ = 4096;
constexpr int PP = 3096;
constexpr int NPROJ = 5144, NPROJ_P = 5376;
constexpr int C_Q = 0, C_KC = 512, C_VC = 640, C_KS = 768, C_VS = 896, C_KW = 1024, C_VW = 1152, C_NG = 1280, C_R = 1304, C_K = 1816, C_V = 2328,
              C_WL = 2840, C_AL = 2904, C_GL = 2968, C_GA = 3096;
constexpr size_t MiB = 1u << 20;
constexpr size_t WS_BIASP = 0, WS_KCN = 64 * 1024, WS_VCT = WS_KCN + 512 * 1024, WS_SS = 2 * MiB, WS_BAR = 3 * MiB;
constexpr size_t WS_W = 4 * MiB, WS_PROJ = 36 * MiB, WS_GATE = 230 * MiB, WS_PREP = 294 * MiB, WS_VST = 486 * MiB, WS_VWT = 494 * MiB, WS_H = 36 * MiB;
constexpr size_t WS_U = WS_PREP, WS_MERGED = WS_PREP, WS_HN = WS_PREP + 64 * MiB;
constexpr size_t WS_Y = WS_PREP + 96 * MiB;
constexpr size_t W_IN = 0, W_A = 5505024, W_B = 6029312, W_OUT = 6553600, W_UP = 7602176, W_DOWN = 11796480, W_WL = 15990784, W_AL = 16023552, W_GL = 16056320,
                 W_C1 = 16121856, W_C2 = 16646144;
constexpr int LDS_BYTES = 155648;

struct Args { const float* in[25]; float* out; unsigned char* ws; int ph_lo, ph_hi; };
enum { I_X = 0, I_MIXNORM, I_WIN, I_QGAIN, I_KGAIN, I_CMPPOS, I_CMPW1, I_CMPW2, I_WATTN, I_TOKMIX, I_W0, I_WLORA, I_A0, I_ALORA, I_GLORA, I_KK, I_KA, I_RK, I_LNW, I_LNB,
       I_WRWKV, I_WOUT, I_FFNNORM, I_WUP, I_WDOWN };

#define XB_TMO      128
#define XB_XCNT(j)  (256  + 64 * (j))
#define XB_XSUB(j)  (1280 + 64 * (j))
#define XB_XGEN(j)  (2304 + 64 * (j))
#define XB_TOP      3328
#define XB_TOPGEN   3392
#define XCD_BAR_WORDS 3456
#define XB_SPIN_CAP (1u << 18)

__device__ __forceinline__ unsigned xb_ld(unsigned* p)              { return __hip_atomic_load(p, __ATOMIC_RELAXED, __HIP_MEMORY_SCOPE_AGENT); }
__device__ __forceinline__ unsigned xb_add(unsigned* p, unsigned v) { return __hip_atomic_fetch_add(p, v, __ATOMIC_RELAXED, __HIP_MEMORY_SCOPE_AGENT); }
__device__ __forceinline__ unsigned xb_xcc_id() { return (unsigned)__builtin_amdgcn_s_getreg((3 << 11) | 20) & 0xFu; }
#define XB_SPIN(cond, bar) do { unsigned _sp = 0; while (cond) { __builtin_amdgcn_s_sleep(1); \
    if ((++_sp & 255u) == 0u) { if (xb_ld(&(bar)[XB_TMO])) break; if (_sp > XB_SPIN_CAP) { atomicAdd(&(bar)[XB_TMO], 1u); break; } } } } while (0)

struct XcdBarrier {
    unsigned* bar; unsigned x;
    volatile LAS unsigned* st;
};

__device__ __forceinline__ XcdBarrier xcd_barrier_post(unsigned* bar, volatile LAS unsigned* st) {
    XcdBarrier b; b.bar = bar; b.x = xb_xcc_id(); b.st = st;
    if (threadIdx.x == 0) (void)xb_add(&bar[XB_XCNT(b.x)], 1u);
    return b;
}
__device__ __forceinline__ void xcd_barrier_complete(unsigned* bar, unsigned x, unsigned& nloc, unsigned& nx) {
    const unsigned G = gridDim.x * gridDim.y * gridDim.z;
    unsigned sum, cnt, mine, sp = 0u;
    for (;;) {
        sum = 0u; cnt = 0u; mine = 0u;
#pragma unroll
        for (unsigned j = 0; j < 16; ++j) { const unsigned c = xb_ld(&bar[XB_XCNT(j)]); sum += c; cnt += (c > 0u) ? 1u : 0u; mine = (j == x) ? c : mine; }
        if (sum == G) break;
        __builtin_amdgcn_s_sleep(1);
        if ((++sp & 255u) == 0u) { if (xb_ld(&bar[XB_TMO])) break; if (sp > XB_SPIN_CAP) { atomicAdd(&bar[XB_TMO], 1u); break; } }
    }
    nloc = mine > 0u ? mine : 1u; nx = cnt > 0u ? cnt : 1u;
}

__device__ __forceinline__ void xcd_barrier(const XcdBarrier& b) {
    asm volatile("s_waitcnt vmcnt(0)" ::: "memory");
    __syncthreads();
    if (threadIdx.x == 0) {
        unsigned* bar = b.bar;
        __builtin_amdgcn_s_waitcnt(0);
        unsigned nloc = b.st[0], nx = b.st[1];
        if (nloc == 0u) { xcd_barrier_complete(bar, b.x, nloc, nx); b.st[0] = nloc; b.st[1] = nx; }
        const unsigned old = xb_add(&bar[XB_XSUB(b.x)], 1u);
        const unsigned gen = old / nloc;
        if (old + 1u == (gen + 1u) * nloc) {
            __builtin_amdgcn_fence(__ATOMIC_RELEASE, "agent");
            asm volatile("s_waitcnt vmcnt(0)" ::: "memory");
            const unsigned og = xb_add(&bar[XB_TOP], 1u);
            const unsigned tg = og / nx;
            if (og + 1u == (tg + 1u) * nx) xb_add(&bar[XB_TOPGEN], 1u);
            else XB_SPIN(xb_ld(&bar[XB_TOPGEN]) == tg, bar);
            __builtin_amdgcn_fence(__ATOMIC_ACQUIRE, "agent");
            xb_add(&bar[XB_XGEN(b.x)], 1u);
            asm volatile("s_waitcnt vmcnt(0)" ::: "memory");
        } else {
            XB_SPIN(xb_ld(&bar[XB_XGEN(b.x)]) == gen, bar);
            __builtin_amdgcn_fence(__ATOMIC_ACQUIRE, "agent");
            asm volatile("s_waitcnt vmcnt(0)" ::: "memory");
        }
    }
    __syncthreads();
}

namespace pg8 {
struct EpiProj {
    static constexpr bool PERM = true, AFTER_DRAIN = false;
    bf16_t* P; uint8_t* G; const float* ss;
    __device__ __forceinline__ void operator()(const f32x4 (&acc)[2][2][4][2], const Unit& u, int wr, int wc, int fr, int fq) const {
        const int row0 = u.pm * BM + wr * 64 + fr, col0 = u.pn * BM + wc * 32 + 8 * fq;
#pragma unroll
        for (int ai = 0; ai < 2; ++ai)
#pragma unroll
            for (int m = 0; m < 4; ++m) {
                const size_t row = (size_t)(row0 + ai * HALF + m * 16);
                const float rs = ss ? rsqrtf(ss[row] * (1.f / 1024.f) + 1e-6f) : 1.f;
#pragma unroll
                for (int bj = 0; bj < 2; ++bj) {
                    const int col = col0 + bj * HALF;
                    f32x4 v0 = acc[ai][bj][m][0] * rs, v1 = acc[ai][bj][m][1] * rs;
                    if (col < C_GA) {
                        if (col >= C_NG && col < C_R) {
#pragma unroll
                            for (int e = 0; e < 4; ++e) { v0[e] = sigm(v0[e]); v1[e] = sigm(v1[e]); }
                        }
                        ::u32x4 w; w.x = cvt_pk_bf16(v0[0], v0[1]); w.y = cvt_pk_bf16(v0[2], v0[3]); w.z = cvt_pk_bf16(v1[0], v1[1]); w.w = cvt_pk_bf16(v1[2], v1[3]);
                        *(::u32x4*)(P + row * PP + col) = w;
                    } else if (col < NPROJ) {
                        unsigned q[8];
#pragma unroll
                        for (int e = 0; e < 4; ++e) { q[e] = (unsigned)__builtin_rintf(sigm(v0[e]) * 255.f); q[4 + e] = (unsigned)__builtin_rintf(sigm(v1[e]) * 255.f); }
                        ::u32x2 w; w.x = q[0] | (q[1] << 8) | (q[2] << 16) | (q[3] << 24); w.y = q[4] | (q[5] << 8) | (q[6] << 16) | (q[7] << 24);
                        *(::u32x2*)(G + row * 2048 + (col - C_GA)) = w;
                    }
                }
            }
    }
};
template <bool SECOND> struct EpiMerge {
    static constexpr bool PERM = true, AFTER_DRAIN = false;
    bf16_t* O; const uint8_t* G;
    __device__ __forceinline__ void operator()(const f32x4 (&acc)[2][2][4][2], const Unit& u, int wr, int wc, int fr, int fq) const {
        const int row0 = u.pm * BM + wr * 64 + fr, col0 = u.pn * BM + wc * 32 + 8 * fq;
#pragma unroll
        for (int ai = 0; ai < 2; ++ai)
#pragma unroll
            for (int m = 0; m < 4; ++m) {
                const size_t row = (size_t)(row0 + ai * HALF + m * 16);
#pragma unroll
                for (int bj = 0; bj < 2; ++bj) {
                    const int col = col0 + bj * HALF;
                    const ::u32x2 gq = *(const ::u32x2*)(G + row * 2048 + (SECOND ? 1024 : 0) + col);
                    float v[8];
#pragma unroll
                    for (int e = 0; e < 4; ++e) { v[e] = acc[ai][bj][m][0][e] * ((float)((gq.x >> (8 * e)) & 255u) * (1.f / 255.f)); v[4 + e] = acc[ai][bj][m][1][e] * ((float)((gq.y >> (8 * e)) & 255u) * (1.f / 255.f)); }
                    ::u32x4* op = (::u32x4*)(O + row * 1024 + col);
                    if (SECOND) { const ::u32x4 t = *op; float tf[8]; unpack8(t, tf);
#pragma unroll
                        for (int e = 0; e < 8; ++e) v[e] += tf[e]; }
                    *op = pack8(v);
                }
                asm volatile("" ::: "memory");
            }
    }
};
struct EpiResF32 {
    static constexpr bool PERM = false, AFTER_DRAIN = false;
    const float* base; float* out; bf16_t* xn; const float* gain; float* ss;
    __device__ __forceinline__ void operator()(const f32x4 (&acc)[2][2][4][2], const Unit& u, int wr, int wc, int fr, int fq) const {
        const int row0 = u.pm * BM + wr * 64 + fr, col0 = u.pn * BM + wc * 32 + 4 * fq;
        f32x4 gv[2][2];
        if (xn) {
#pragma unroll
            for (int bj = 0; bj < 2; ++bj)
#pragma unroll
                for (int n = 0; n < 2; ++n) gv[bj][n] = *(const f32x4*)(gain + col0 + bj * HALF + n * 16);
        }
#pragma unroll
        for (int ai = 0; ai < 2; ++ai)
#pragma unroll
            for (int m = 0; m < 4; ++m) {
                const int row = row0 + ai * HALF + m * 16;
                const size_t off = (size_t)row * 1024 + col0;
                float sq = 0.f;
#pragma unroll
                for (int bj = 0; bj < 2; ++bj)
#pragma unroll
                    for (int n = 0; n < 2; ++n) {
                        const f32x4 b = *(const f32x4*)(base + off + bj * HALF + n * 16); const f32x4 o = b + acc[ai][bj][m][n];
                        *(f32x4*)(out + off + bj * HALF + n * 16) = o;
                        if (xn) { sq += (o[0] * o[0] + o[1] * o[1]) + (o[2] * o[2] + o[3] * o[3]); const f32x4 og = o * gv[bj][n];
                            ::u32x2 w; w.x = cvt_pk_bf16(og[0], og[1]); w.y = cvt_pk_bf16(og[2], og[3]); *(::u32x2*)(xn + off + bj * HALF + n * 16) = w; }
                    }
                if (xn) { sq += __shfl_xor(sq, 16); sq += __shfl_xor(sq, 32); if (fq == 0) atomicAdd(ss + row, sq); }
                asm volatile("" ::: "memory");
            }
    }
};
struct EpiRelu2 {
    static constexpr bool PERM = true, AFTER_DRAIN = false;
    bf16_t* O; const float* ss;
    __device__ __forceinline__ void operator()(const f32x4 (&acc)[2][2][4][2], const Unit& u, int wr, int wc, int fr, int fq) const {
        const int row0 = u.pm * BM + wr * 64 + fr, col0 = u.pn * BM + wc * 32 + 8 * fq;
#pragma unroll
        for (int ai = 0; ai < 2; ++ai)
#pragma unroll
            for (int m = 0; m < 4; ++m) {
                const size_t row = (size_t)(row0 + ai * HALF + m * 16);
                const float r2 = 1.f / (ss[row] * (1.f / 1024.f) + 1e-6f);
#pragma unroll
                for (int bj = 0; bj < 2; ++bj) {
                    f32x4 v0 = acc[ai][bj][m][0], v1 = acc[ai][bj][m][1];
#pragma unroll
                    for (int e = 0; e < 4; ++e) { const float a = fmaxf(v0[e], 0.f), b = fmaxf(v1[e], 0.f); v0[e] = a * a * r2; v1[e] = b * b * r2; }
                    ::u32x4 w; w.x = cvt_pk_bf16(v0[0], v0[1]); w.y = cvt_pk_bf16(v0[2], v0[3]); w.z = cvt_pk_bf16(v1[0], v1[1]); w.w = cvt_pk_bf16(v1[2], v1[3]);
                    *(::u32x4*)(O + row * 4096 + col0 + bj * HALF) = w;
                }
            }
    }
};
}

DI void tr_item(const float* __restrict__ W, int K, int N, bf16_t* WT, LAS float* scr, int item, int lane, int nblk) {
    const int kb = item / nblk, nb = item % nblk, k0 = 64 * kb, n0 = 32 * nb;
    const int nn = n0 + (lane & 31);
    float v[32];
#pragma unroll
    for (int i = 0; i < 32; ++i) { const int kk = 2 * i + (lane >> 5); v[i] = (nn < N) ? W[(size_t)(k0 + kk) * N + nn] : 0.f; }
#pragma unroll
    for (int i = 0; i < 32; ++i) { const int kk = 2 * i + (lane >> 5); scr[kk * 33 + (lane & 31)] = v[i]; }
    asm volatile("s_waitcnt lgkmcnt(0)" ::: "memory");
    const int c = lane & 7;
#pragma unroll
    for (int j = 0; j < 4; ++j) { const int n = (lane >> 3) + 8 * j; const LAS float* s = scr + (8 * c) * 33 + n;
        u32x4 o; o.x = pk2(s[0 * 33], s[1 * 33]); o.y = pk2(s[2 * 33], s[3 * 33]); o.z = pk2(s[4 * 33], s[5 * 33]); o.w = pk2(s[6 * 33], s[7 * 33]);
        *(u32x4*)(WT + (size_t)(n0 + n) * K + k0 + 8 * c) = o; }
    asm volatile("s_waitcnt lgkmcnt(0)" ::: "memory");
}
DI void conv_mat(const float* W, int K, int N, int NP, bf16_t* WT, LAS float* scr, int gw, int NGW, int lane) {
    const int nblk = NP / 32, nit = (K / 64) * nblk;
    for (int it = gw; it < nit; it += NGW) tr_item(W, K, N, WT, scr, it, lane, nblk);
}
DI void rms_row(const float* x, const float* gain, bf16_t* o, int lane) {
    const f32x4* xr = (const f32x4*)x + lane; const f32x4* gr = (const f32x4*)gain + lane;
    f32x4 v[4]; float s = 0.f;
#pragma unroll
    for (int j = 0; j < 4; ++j) { v[j] = xr[64 * j]; s += (v[j].x * v[j].x + v[j].y * v[j].y) + (v[j].z * v[j].z + v[j].w * v[j].w); }
    const float rstd = rsqrtf(wave_sum(s) * (1.f / 1024.f) + 1e-6f);
    u32x2* op = (u32x2*)o + lane;
#pragma unroll
    for (int j = 0; j < 4; ++j) { const f32x4 g = gr[64 * j]; u32x2 w; w.x = pk2(v[j].x * rstd * g.x, v[j].y * rstd * g.y); w.y = pk2(v[j].z * rstd * g.z, v[j].w * rstd * g.w); op[64 * j] = w; }
}
DI void phase_conv(const Args& a, int l, LAS unsigned char* lds) {
    const int tid = otid(), wid = tid >> 6, lane = tid & 63;
    LAS float* scr = (LAS float*)(lds + wid * 16384);
    const int gw = blockIdx.x * 8 + wid, NGW = gridDim.x * 8;
    bf16_t* W = (bf16_t*)(a.ws + WS_W);
    conv_mat(a.in[I_WIN] + (size_t)l * 1024 * NPROJ, 1024, NPROJ, NPROJ_P, W + W_IN, scr, gw, NGW, lane);
    conv_mat(a.in[I_WUP] + (size_t)l * 1024 * 4096, 1024, 4096, 4096, W + W_UP, scr, gw, NGW, lane);
    conv_mat(a.in[I_WDOWN] + (size_t)l * 1024 * 4096, 4096, 1024, 1024, W + W_DOWN, scr, gw, NGW, lane);
    conv_mat(a.in[I_WOUT] + (size_t)l * 1024 * 1024, 1024, 1024, 1024, W + W_OUT, scr, gw, NGW, lane);
    conv_mat(a.in[I_WATTN] + (size_t)l * 512 * 1024, 512, 1024, 1024, W + W_A, scr, gw, NGW, lane);
    conv_mat(a.in[I_WRWKV] + (size_t)l * 512 * 1024, 512, 1024, 1024, W + W_B, scr, gw, NGW, lane);
    conv_mat(a.in[I_WLORA] + (size_t)l * 64 * 512, 64, 512, 512, W + W_WL, scr, gw, NGW, lane);
    conv_mat(a.in[I_ALORA] + (size_t)l * 64 * 512, 64, 512, 512, W + W_AL, scr, gw, NGW, lane);
    conv_mat(a.in[I_GLORA] + (size_t)l * 128 * 512, 128, 512, 512, W + W_GL, scr, gw, NGW, lane);
    for (int kv = 0; kv < 2; ++kv) {
        conv_mat(a.in[I_CMPW1] + (size_t)(l * 2 + kv) * 2048 * 128, 2048, 128, 128, W + W_C1 + kv * 262144, scr, gw, NGW, lane);
        conv_mat(a.in[I_CMPW2] + (size_t)(l * 2 + kv) * 128 * 64, 128, 64, 64, W + W_C2 + kv * 8192, scr, gw, NGW, lane);
    }
    float* biasp = (float*)(a.ws + WS_BIASP);
    for (int u = gw; u < 64; u += NGW) {
        const int kv = u >> 5, ng = (u >> 4) & 1, kp = u & 15, n = ng * 64 + lane;
        const float* pos = a.in[I_CMPPOS] + (size_t)(l * 2 + kv) * 2048; const float* w1 = a.in[I_CMPW1] + (size_t)(l * 2 + kv) * 2048 * 128;
        float acc8[8] = {0.f, 0.f, 0.f, 0.f, 0.f, 0.f, 0.f, 0.f};
#pragma unroll 2
        for (int k = kp * 128; k < kp * 128 + 128; k += 8) {
#pragma unroll
            for (int e = 0; e < 8; ++e) acc8[e] += pos[k + e] * w1[(size_t)(k + e) * 128 + n];
        }
        biasp[(kv * 16 + kp) * 128 + n] = ((acc8[0] + acc8[1]) + (acc8[2] + acc8[3])) + ((acc8[4] + acc8[5]) + (acc8[6] + acc8[7]));
    }
    if (l == 0) {
        float* ssz = (float*)(a.ws + WS_SS);
        for (int i = blockIdx.x * 512 + tid; i < 3 * M_TOK; i += gridDim.x * 512) ssz[i] = 0.f;
        bf16_t* U = (bf16_t*)(a.ws + WS_U);
        for (int m = gw; m < M_TOK; m += NGW) rms_row(a.in[I_X] + (size_t)m * DM, a.in[I_MIXNORM], U + (size_t)m * DM, lane);
    }
}
DI void phase_norm2(const Args& a, int l) {
    const int tid = otid(), wid = tid >> 6, lane = tid & 63;
    const int gw = blockIdx.x * 8 + wid, NGW = gridDim.x * 8;
    bf16_t* HN = (bf16_t*)(a.ws + WS_HN);
    for (int m = gw; m < M_TOK; m += NGW) rms_row(a.out + (size_t)m * DM, a.in[I_FFNNORM] + l * DM, HN + (size_t)m * DM, lane);
}

DI void lerp8(const bf16_t* cur, const bf16_t* prev, bool has_prev, const float* mu, float* o) {
    const u32x4 c = *(const u32x4*)cur; u32x4 p = {0u, 0u, 0u, 0u}; if (has_prev) p = *(const u32x4*)prev;
    float cf[8], pf[8]; unpack8(c, cf); unpack8(p, pf);
    const f32x4 m0 = *(const f32x4*)mu, m1 = *(const f32x4*)(mu + 4);
#pragma unroll
    for (int i = 0; i < 8; ++i) { const float m = i < 4 ? m0[i] : m1[i - 4]; o[i] = cf[i] + (pf[i] - cf[i]) * m; }
}
DI void rwkv_prep_item(const Args& a, int l, int item, LAS unsigned char* lds) {
    const int tid = otid(), wid = tid >> 6, lane = tid & 63;
    const int b = item >> 6, t0 = (item & 63) * 64;
    bf16_t* PROJ = (bf16_t*)(a.ws + WS_PROJ); bf16_t* PREP = (bf16_t*)(a.ws + WS_PREP); const bf16_t* W = (const bf16_t*)(a.ws + WS_W);
    LAS bf16_t* A_w = (LAS bf16_t*)lds; LAS bf16_t* A_a = (LAS bf16_t*)(lds + 9216);
    LAS bf16_t* a_s = (LAS bf16_t*)(lds + 18432); LAS bf16_t* omd_s = (LAS bf16_t*)(lds + 18432 + 65536);
    const float* mu = a.in[I_TOKMIX] + l * 1792;
    {
        const int token = tid >> 3, part = tid & 7; const size_t row = (size_t)b * SEQ + t0 + token; const bool hp = (t0 + token) > 0;
        float v[8];
        lerp8(PROJ + row * PP + C_WL + part * 8, PROJ + (row - 1) * PP + C_WL + part * 8, hp, mu + (C_WL - C_R) + part * 8, v);
#pragma unroll
        for (int i = 0; i < 8; ++i) v[i] = tanh_fast(v[i]);
        *(LAS u32x4*)(A_w + token * 72 + part * 8) = pack8(v);
        lerp8(PROJ + row * PP + C_AL + part * 8, PROJ + (row - 1) * PP + C_AL + part * 8, hp, mu + (C_AL - C_R) + part * 8, v);
        *(LAS u32x4*)(A_a + token * 72 + part * 8) = pack8(v);
    }
    __syncthreads();
#pragma unroll 1
    for (int which = 0; which < 2; ++which) {
        f32x4 acc[4][4];
#pragma unroll
        for (int m = 0; m < 4; ++m)
#pragma unroll
            for (int n = 0; n < 4; ++n) acc[m][n] = (f32x4){0.f, 0.f, 0.f, 0.f};
        const int fr = lane & 15, fq = lane >> 4;
        const LAS bf16_t* As = which ? A_a : A_w; const bf16_t* Bw = W + (which ? W_AL : W_WL);
#pragma unroll
        for (int ks = 0; ks < 2; ++ks) {
            bf16x8 af[4];
#pragma unroll
            for (int m = 0; m < 4; ++m) af[m] = *(const LAS bf16x8*)(As + (m * 16 + fr) * 72 + ks * 32 + fq * 8);
#pragma unroll
            for (int n = 0; n < 4; ++n) {
                const bf16x8 bfr = *(const bf16x8*)(Bw + (size_t)(wid * 64 + n * 16 + fr) * 64 + ks * 32 + fq * 8);
#pragma unroll
                for (int m = 0; m < 4; ++m) acc[m][n] = MFMA16(af[m], bfr, acc[m][n]);
            }
        }
        LAS bf16_t* dst = which ? a_s : omd_s;
#pragma unroll
        for (int n = 0; n < 4; ++n) {
            const int c = wid * 64 + n * 16 + fr; const float c0 = a.in[which ? I_A0 : I_W0][l * 512 + c];
#pragma unroll
            for (int m = 0; m < 4; ++m)
#pragma unroll
                for (int r = 0; r < 4; ++r) {
                    const int token = m * 16 + fq * 4 + r;
                    float res;
                    if (which) res = sigm(c0 + acc[m][n][r]);
                    else {
                        const float x = -(c0 + acc[m][n][r]);
                        const float ew = 0.60653065971f * __builtin_amdgcn_rcpf(1.f + __expf(x));
                        res = ew > 0.03f ? 1.f - __expf(-ew) : ew * (1.f - ew * (0.5f - ew * (1.f / 6.f)));
                    }
                    dst[token * 512 + c] = tobf(res);
                }
        }
    }
    __syncthreads();
    {
        const int cgp = tid & 63, head = cgp >> 3, k0 = (cgp & 7) * 8, c = cgp * 8;
        float mur[8], muk[8], muv[8], kkp[8], kap[8];
        {
            const float* srcs[5] = {mu + c, mu + 512 + c, mu + 1024 + c, a.in[I_KK] + l * 512 + c, a.in[I_KA] + l * 512 + c};
            float* dsts[5] = {mur, muk, muv, kkp, kap};
#pragma unroll
            for (int q = 0; q < 5; ++q) { const f32x4 t0 = *(const f32x4*)srcs[q], t1 = *(const f32x4*)(srcs[q] + 4);
#pragma unroll
                for (int i = 0; i < 4; ++i) { dsts[q][i] = t0[i]; dsts[q][4 + i] = t1[i]; } }
        }
        u32x4 raw[6];
        auto load_unit = [&](int u) {
            const int token = u * 8 + (tid >> 6); const size_t row = (size_t)b * SEQ + t0 + token; const bool hp = (t0 + token) > 0;
            const u32x4 z = {0u, 0u, 0u, 0u};
            raw[0] = *(const u32x4*)(PROJ + row * PP + C_R + c); raw[1] = hp ? *(const u32x4*)(PROJ + (row - 1) * PP + C_R + c) : z;
            raw[2] = *(const u32x4*)(PROJ + row * PP + C_K + c); raw[3] = hp ? *(const u32x4*)(PROJ + (row - 1) * PP + C_K + c) : z;
            raw[4] = *(const u32x4*)(PROJ + row * PP + C_V + c); raw[5] = hp ? *(const u32x4*)(PROJ + (row - 1) * PP + C_V + c) : z;
        };
        load_unit(0);
#pragma unroll 1
        for (int u = 0; u < 8; ++u) {
            const int token = u * 8 + (tid >> 6);
            float r[8], k[8], v[8], av[8], od[8];
            {
                float cf[8], pf[8];
                unpack8(raw[0], cf); unpack8(raw[1], pf);
#pragma unroll
                for (int i = 0; i < 8; ++i) r[i] = cf[i] + (pf[i] - cf[i]) * mur[i];
                unpack8(raw[2], cf); unpack8(raw[3], pf);
#pragma unroll
                for (int i = 0; i < 8; ++i) k[i] = cf[i] + (pf[i] - cf[i]) * muk[i];
                unpack8(raw[4], cf); unpack8(raw[5], pf);
#pragma unroll
                for (int i = 0; i < 8; ++i) v[i] = cf[i] + (pf[i] - cf[i]) * muv[i];
            }
            if (u + 1 < 8) load_unit(u + 1);
            unpack8(*(const LAS u32x4*)(a_s + token * 512 + c), av); unpack8(*(const LAS u32x4*)(omd_s + token * 512 + c), od);
            float kk[8], bb[8], kp[8]; float ss = 0.f;
#pragma unroll
            for (int i = 0; i < 8; ++i) { kk[i] = k[i] * kkp[i]; ss += kk[i] * kk[i]; }
            ss = red8(ss);
            const float rn = rsqrtf(fmaxf(ss, 1e-24f));
#pragma unroll
            for (int i = 0; i < 8; ++i) { kk[i] *= rn; bb[i] = kk[i] * av[i]; kp[i] = k[i] * (1.f + (av[i] - 1.f) * kap[i]); }
            bf16_t* op = PREP + ((size_t)(b * 8 + head) * SEQ + t0 + token) * 384 + k0;
            *(u32x4*)(op) = pack8(r); *(u32x4*)(op + 64) = pack8(od); *(u32x4*)(op + 128) = pack8(kp); *(u32x4*)(op + 192) = pack8(kk); *(u32x4*)(op + 256) = pack8(bb); *(u32x4*)(op + 320) = pack8(v);
        }
    }
    __syncthreads();
}
DI void nsa_norm_item(const Args& a, int l, int item, LAS unsigned char* lds) {
    const int tid = otid();
    const int b = item >> 6, t0 = (item & 63) * 64;
    bf16_t* PROJ = (bf16_t*)(a.ws + WS_PROJ);
    LAS bf16_t* vt = (LAS bf16_t*)lds;
    const int token = tid >> 3, part = tid & 7, g = part >> 2, d0 = (part & 3) * 16;
    const size_t row = (size_t)b * SEQ + t0 + token;
#pragma unroll
    for (int var = 0; var < 2; ++var) {
        bf16_t* kp = PROJ + row * PP + (var ? C_KW : C_KS) + g * 64 + d0;
        float f[16]; unpack8(*(const u32x4*)kp, f); unpack8(*(const u32x4*)(kp + 8), f + 8);
        float ss = 0.f;
#pragma unroll
        for (int i = 0; i < 16; ++i) ss += f[i] * f[i];
        ss = red4(ss);
        const float rstd = rsqrtf(ss * (1.f / 64.f) + 1e-6f);
        const float* gn = a.in[I_KGAIN] + (l * 3 + 1 + var) * 64 + d0;
#pragma unroll
        for (int i = 0; i < 16; ++i) f[i] = f[i] * rstd * gn[i];
        *(u32x4*)kp = pack8(f); *(u32x4*)(kp + 8) = pack8(f + 8);
        const bf16_t* vp = PROJ + row * PP + (var ? C_VW : C_VS) + g * 64 + d0;
        const u32x4 v0 = *(const u32x4*)vp, v1 = *(const u32x4*)(vp + 8);
        const unsigned vw[8] = {v0.x, v0.y, v0.z, v0.w, v1.x, v1.y, v1.z, v1.w};
#pragma unroll
        for (int i = 0; i < 8; ++i) { vt[(var * 128 + g * 64 + d0 + 2 * i) * 72 + token] = (bf16_t)(vw[i] & 0xffffu); vt[(var * 128 + g * 64 + d0 + 2 * i + 1) * 72 + token] = (bf16_t)(vw[i] >> 16); }
    }
    __syncthreads();
#pragma unroll
    for (int u = 0; u < 4; ++u) {
        const int id = u * 512 + tid, var = id >> 10, rr = (id >> 3) & 127, seg = id & 7, gg = rr >> 6, d = rr & 63;
        bf16_t* dst = (bf16_t*)(a.ws + (var ? WS_VWT : WS_VST)) + ((size_t)(b * 2 + gg) * 64 + d) * SEQ + t0 + seg * 8;
        *(u32x4*)dst = *(const LAS u32x4*)(vt + (var * 128 + rr) * 72 + seg * 8);
    }
    __syncthreads();
}
DI float gelu_tanh(float x) { const float u = 0.7978845608f * (x + 0.044715f * x * x * x); return 0.5f * x * (1.f + tanh_fast(u)); }
DI void compress_item(const Args& a, int l, int item, LAS unsigned char* lds) {
    const int tid = otid(), wid = tid >> 6, lane = tid & 63, fr = lane & 15, fq = lane >> 4;
    const int kv = item >> 7, bg = (item >> 3) & 15, nq = item & 7, b = bg >> 1, g = bg & 1;
    const bf16_t* PROJ = (const bf16_t*)(a.ws + WS_PROJ); const bf16_t* W = (const bf16_t*)(a.ws + WS_W);
    LAS bf16_t* hs = (LAS bf16_t*)lds; LAS float* os = (LAS float*)(lds + 8704);
    const int colbase = (kv ? C_VC : C_KC) + g * 64;
    f32x4 acc[2];
#pragma unroll
    for (int m = 0; m < 2; ++m) acc[m] = (f32x4){0.f, 0.f, 0.f, 0.f};
    const bf16_t* w1 = W + W_C1 + (size_t)kv * 262144 + (size_t)(wid * 16 + fr) * 2048 + fq * 8;
    int tk0[2];
#pragma unroll
    for (int m = 0; m < 2; ++m) tk0[m] = 16 * (nq * 32 + m * 16 + fr);
#pragma unroll 1
    for (int k8 = 0; k8 < 64; k8 += 8) {
        bf16x8 bfr[8], af[8][2];
#pragma unroll
        for (int kk = 0; kk < 8; ++kk) {
            const int ks = k8 + kk, tokoff = ks >> 1, dcol = (ks & 1) * 32 + fq * 8;
            bfr[kk] = *(const bf16x8*)(w1 + ks * 32);
#pragma unroll
            for (int m = 0; m < 2; ++m) { int tk = tk0[m] + tokoff; tk = tk > SEQ - 1 ? SEQ - 1 : tk; af[kk][m] = *(const bf16x8*)(PROJ + ((size_t)b * SEQ + tk) * PP + colbase + dcol); }
        }
#pragma unroll
        for (int kk = 0; kk < 8; ++kk)
#pragma unroll
            for (int m = 0; m < 2; ++m) acc[m] = MFMA16(af[kk][m], bfr[kk], acc[m]);
    }
    {
        const int c = wid * 16 + fr; const float* biasp = (const float*)(a.ws + WS_BIASP) + kv * 16 * 128 + c;
        float bias = 0.f;
#pragma unroll
        for (int kp = 0; kp < 16; ++kp) bias += biasp[kp * 128];
#pragma unroll
        for (int m = 0; m < 2; ++m)
#pragma unroll
            for (int r = 0; r < 4; ++r) hs[(m * 16 + fq * 4 + r) * 136 + c] = tobf(gelu_tanh(acc[m][r] + bias));
    }
    __syncthreads();
    {
        const int m = wid >> 2, nt = wid & 3;
        f32x4 acc2 = {0.f, 0.f, 0.f, 0.f};
#pragma unroll
        for (int ks = 0; ks < 4; ++ks) {
            const bf16x8 af = *(const LAS bf16x8*)(hs + (m * 16 + fr) * 136 + ks * 32 + fq * 8);
            const bf16x8 bf = *(const bf16x8*)(W + W_C2 + (size_t)kv * 8192 + (size_t)(nt * 16 + fr) * 128 + ks * 32 + fq * 8);
            acc2 = MFMA16(af, bf, acc2);
        }
#pragma unroll
        for (int r = 0; r < 4; ++r) os[(m * 16 + fq * 4 + r) * 64 + nt * 16 + fr] = acc2[r];
    }
    __syncthreads();
    if (tid < 256) {
        const int rowi = tid >> 3, d0 = (tid & 7) * 8, n = nq * 32 + rowi;
        float v[8];
#pragma unroll
        for (int i = 0; i < 8; ++i) v[i] = os[rowi * 64 + d0 + i];
        if (kv == 0) {
            float ss = 0.f;
#pragma unroll
            for (int i = 0; i < 8; ++i) ss += v[i] * v[i];
            ss = red8(ss);
            const float rstd = rsqrtf(ss * (1.f / 64.f) + 1e-6f);
            const float* gn = a.in[I_KGAIN] + (l * 3 + 0) * 64 + d0;
#pragma unroll
            for (int i = 0; i < 8; ++i) v[i] = (n == 255) ? 0.f : v[i] * rstd * gn[i];
            *(u32x4*)((bf16_t*)(a.ws + WS_KCN) + ((size_t)bg * 256 + n) * 64 + d0) = pack8(v);
        } else {
            bf16_t* vct = (bf16_t*)(a.ws + WS_VCT) + (size_t)bg * 64 * 256;
#pragma unroll
            for (int i = 0; i < 8; ++i) vct[(d0 + i) * 256 + n] = tobf(n == 255 ? 0.f : v[i]);
        }
    }
    __syncthreads();
}
DI void phase_prep(const Args& a, int l, LAS unsigned char* lds) {
#ifdef DUPPREP
    for (int it = blockIdx.x; it < 768; it += gridDim.x) { if (it < 256) compress_item(a, l, it, lds); else rwkv_prep_item(a, l, it - 256, lds); }
#endif
#ifdef OLD_PREP
    for (int it = blockIdx.x; it < 1280; it += gridDim.x) {
        if (it < 256) compress_item(a, l, it, lds);
        else if (it < 768) rwkv_prep_item(a, l, it - 256, lds);
        else nsa_norm_item(a, l, it - 768, lds);
    }
#else
    for (int it = blockIdx.x; it < 768; it += gridDim.x) {
        if (it < 256) compress_item(a, l, it, lds);
        else nsa_norm_item(a, l, it - 256, lds);
    }
#endif
}

DI f32x2 red16p(f32x2 x) { float a = x.x, b = x.y; red16x2(a, b); return (f32x2){a, b}; }
template <int RPL>
DI void scan_bh(const Args& a, int bh, int halfsel, LAS unsigned char* lds) {
    const int tid = otid(), wid = tid >> 6, lane = tid & 63, vq = lane >> 4, kq = lane & 15;
    const bf16_t* src = (const bf16_t*)(a.ws + WS_PREP) + (size_t)bh * SEQ * 384;
    bf16_t* PROJ = (bf16_t*)(a.ws + WS_PROJ);
    const int b = bh >> 3, h = bh & 7;
    constexpr int T = 32, CH = T * 384, NL = CH / 2048;
    LAS float* opbuf = (LAS float*)lds;
    LAS unsigned char* ybuf = lds + 2 * CH * 4;
    const int row0 = RPL == 2 ? halfsel * 32 + (wid & 3) * 8 + vq * 2 : halfsel * 32 + wid * 4 + vq;
    const bool active = RPL == 2 ? wid < 4 : true;
    f32x2 S[4];
#pragma unroll
    for (int j = 0; j < 4; ++j) S[j] = (f32x2){0.f, 0.f};
    u32x2 ld[NL]; bool isd[NL];
#pragma unroll
    for (int j = 0; j < NL; ++j) { isd[j] = (((tid * 4 + j * 2048) % 384) >> 6) == 1; ld[j] = *(const u32x2*)(src + tid * 4 + j * 2048); }
#pragma unroll
    for (int j = 0; j < NL; ++j) { f32x4 f = {bflo(ld[j].x), bfhi(ld[j].x), bflo(ld[j].y), bfhi(ld[j].y)}; if (isd[j]) f = 1.f - f; *(LAS f32x4*)(opbuf + tid * 4 + j * 2048) = f; }
    __syncthreads();
#pragma unroll 1
    for (int c = 0; c < SEQ / T; ++c) {
        if (c + 1 < SEQ / T) {
#pragma unroll
            for (int j = 0; j < NL; ++j) ld[j] = *(const u32x2*)(src + (size_t)(c + 1) * CH + tid * 4 + j * 2048);
        }
        const LAS float* cur = opbuf + (c & 1) * CH;
        LAS unsigned char* yb = ybuf + (c & 1) * (T * 128);
        f32x4 r4 = *(const LAS f32x4*)(cur + kq * 4), d4 = *(const LAS f32x4*)(cur + 64 + kq * 4), k4 = *(const LAS f32x4*)(cur + 128 + kq * 4),
              kk4 = *(const LAS f32x4*)(cur + 192 + kq * 4), b4 = *(const LAS f32x4*)(cur + 256 + kq * 4);
        f32x2 v2; if (RPL == 2) v2 = *(const LAS f32x2*)(cur + 320 + row0); else { v2.x = cur[320 + row0]; v2.y = 0.f; }
        if (active) {
#pragma unroll
        for (int st = 0; st < T; ++st) {
            f32x4 nr4, nd4, nk4, nkk4, nb4; f32x2 nv2;
            if (st < T - 1) {
                const LAS float* o = cur + (st + 1) * 384;
                nr4 = *(const LAS f32x4*)(o + kq * 4); nd4 = *(const LAS f32x4*)(o + 64 + kq * 4); nk4 = *(const LAS f32x4*)(o + 128 + kq * 4);
                nkk4 = *(const LAS f32x4*)(o + 192 + kq * 4); nb4 = *(const LAS f32x4*)(o + 256 + kq * 4);
                if (RPL == 2) nv2 = *(const LAS f32x2*)(o + 320 + row0); else { nv2.x = o[320 + row0]; nv2.y = 0.f; }
            }
            if (RPL == 2) {
                f32x2 sa = S[0] * kk4[0]; sa += S[1] * kk4[1]; f32x2 sb = S[2] * kk4[2]; sb += S[3] * kk4[3]; sa += sb;
                sa = red16p(sa); sa = -sa;
#pragma unroll
                for (int j = 0; j < 4; ++j) S[j] = S[j] * d4[j] + sa * b4[j] + v2 * k4[j];
                f32x2 y = S[0] * r4[0]; y += S[1] * r4[1]; f32x2 yc = S[2] * r4[2]; yc += S[3] * r4[3]; y += yc;
                y = red16p(y);
                *(LAS unsigned*)(yb + st * 128 + row0 * 2) = pk2(y.x, y.y);
            } else {
                const f32x2 kk01 = {kk4[0], kk4[1]}, kk23 = {kk4[2], kk4[3]}, d01 = {d4[0], d4[1]}, d23 = {d4[2], d4[3]}, b01 = {b4[0], b4[1]}, b23 = {b4[2], b4[3]},
                            k01 = {k4[0], k4[1]}, k23 = {k4[2], k4[3]}, r01 = {r4[0], r4[1]}, r23 = {r4[2], r4[3]};
                f32x2 sa2 = S[0] * kk01; sa2 += S[1] * kk23;
                const float sa = -red16(sa2.x + sa2.y);
                S[0] = S[0] * d01 + sa * b01 + v2.x * k01; S[1] = S[1] * d23 + sa * b23 + v2.x * k23;
                f32x2 y2 = S[0] * r01; y2 += S[1] * r23;
                const float y = red16(y2.x + y2.y);
                if (kq == 0) *(LAS bf16_t*)(yb + st * 128 + row0 * 2) = tobf(y);
            }
            if (st < T - 1) { r4 = nr4; d4 = nd4; k4 = nk4; kk4 = nkk4; b4 = nb4; v2 = nv2; }
        }
        }
        if (c + 1 < SEQ / T) {
            LAS float* nb = opbuf + ((c + 1) & 1) * CH;
#pragma unroll
            for (int j = 0; j < NL; ++j) { f32x4 f = {bflo(ld[j].x), bfhi(ld[j].x), bflo(ld[j].y), bfhi(ld[j].y)}; if (isd[j]) f = 1.f - f; *(LAS f32x4*)(nb + tid * 4 + j * 2048) = f; }
        }
        __syncthreads();
        { if (tid < T * 4) { const int rowi = tid >> 2, seg = tid & 3;
            *(u32x4*)(PROJ + ((size_t)b * SEQ + c * T + rowi) * PP + C_R + h * 64 + halfsel * 32 + seg * 8) = *(const LAS u32x4*)(yb + rowi * 128 + halfsel * 64 + seg * 16); } }
    }
    __syncthreads();
}

DI void scan_bh2(const Args& a, int l, int bh, int halfsel, LAS unsigned char* lds) {
    const int tid = otid(), wid = tid >> 6, lane = tid & 63;
    const int b = bh >> 3, h = bh & 7;
    constexpr int T = 32, CH = T * 384;
    LAS float* opbuf = (LAS float*)lds;
    LAS unsigned char* ybuf = lds + 2 * CH * 4;
    bf16_t* PROJ = (bf16_t*)(a.ws + WS_PROJ);
    if (wid < 4) {
        const int vq = lane >> 4, kq = lane & 15;
        const int row0 = halfsel * 32 + wid * 8 + vq * 2;
        bf16_t* Y = (bf16_t*)(a.ws + WS_Y);
        f32x2 S[4];
#pragma unroll
        for (int j = 0; j < 4; ++j) S[j] = (f32x2){0.f, 0.f};
        __syncthreads();
#pragma unroll 1
        for (int c = 0; c < SEQ / T; ++c) {
            const LAS float* cur = opbuf + (c & 1) * CH;
            LAS unsigned char* yb = ybuf + (c & 1) * (T * 128);
            f32x4 r4 = *(const LAS f32x4*)(cur + kq * 4), d4 = *(const LAS f32x4*)(cur + 64 + kq * 4), k4 = *(const LAS f32x4*)(cur + 128 + kq * 4),
                  kk4 = *(const LAS f32x4*)(cur + 192 + kq * 4), b4 = *(const LAS f32x4*)(cur + 256 + kq * 4);
            f32x2 v2 = *(const LAS f32x2*)(cur + 320 + row0);
#pragma unroll
            for (int st = 0; st < T; ++st) {
                f32x4 nr4, nd4, nk4, nkk4, nb4; f32x2 nv2;
                if (st < T - 1) {
                    const LAS float* o = cur + (st + 1) * 384;
                    nr4 = *(const LAS f32x4*)(o + kq * 4); nd4 = *(const LAS f32x4*)(o + 64 + kq * 4); nk4 = *(const LAS f32x4*)(o + 128 + kq * 4);
                    nkk4 = *(const LAS f32x4*)(o + 192 + kq * 4); nb4 = *(const LAS f32x4*)(o + 256 + kq * 4); nv2 = *(const LAS f32x2*)(o + 320 + row0);
                }
                f32x2 sa = S[0] * kk4[0]; sa += S[1] * kk4[1]; f32x2 sb = S[2] * kk4[2]; sb += S[3] * kk4[3]; sa += sb;
                sa = red16p(sa); sa = -sa;
#pragma unroll
                for (int j = 0; j < 4; ++j) S[j] = S[j] * d4[j] + sa * b4[j] + v2 * k4[j];
                f32x2 y = S[0] * r4[0]; y += S[1] * r4[1]; f32x2 yc = S[2] * r4[2]; yc += S[3] * r4[3]; y += yc;
                y = red16p(y);
                *(LAS unsigned*)(yb + st * 128 + row0 * 2) = pk2(y.x, y.y);
                if (st < T - 1) { r4 = nr4; d4 = nd4; k4 = nk4; kk4 = nkk4; b4 = nb4; v2 = nv2; }
            }
            __syncthreads();
            if (tid < T * 4) { const int rowi = tid >> 2, seg = tid & 3;
                *(u32x4*)(Y + ((size_t)b * SEQ + c * T + rowi) * 512 + h * 64 + halfsel * 32 + seg * 8) = *(const LAS u32x4*)(yb + rowi * 128 + halfsel * 64 + seg * 16); }
        }
    } else {
        const int lw = wid - 4, token = lane >> 3, part = lane & 7, fr = lane & 15, fq = lane >> 4;
        const int c8 = part * 8, ch = h * 64 + c8;
        LAS unsigned char* scr = lds + 2 * CH * 4 + 2 * T * 128 + lw * 7168;
        LAS bf16_t* A_w = (LAS bf16_t*)scr; LAS bf16_t* A_a = (LAS bf16_t*)(scr + 2304);
        LAS bf16_t* a_s = (LAS bf16_t*)(scr + 4608); LAS bf16_t* omd_s = (LAS bf16_t*)(scr + 5632);
        const bf16_t* W = (const bf16_t*)(a.ws + WS_W);
        bf16_t* PREP3 = (bf16_t*)(a.ws + WS_PREP);
        const float* mu = a.in[I_TOKMIX] + l * 1792;
        float mur[8], muk[8], muv[8], kkp[8], kap[8], muw[8], mua[8];
        {
            const float* srcs[7] = {mu + ch, mu + 512 + ch, mu + 1024 + ch, a.in[I_KK] + l * 512 + ch, a.in[I_KA] + l * 512 + ch, mu + (C_WL - C_R) + c8, mu + (C_AL - C_R) + c8};
            float* dsts[7] = {mur, muk, muv, kkp, kap, muw, mua};
#pragma unroll
            for (int q = 0; q < 7; ++q) { const f32x4 t0 = *(const f32x4*)srcs[q], t1 = *(const f32x4*)(srcs[q] + 4);
#pragma unroll
                for (int i = 0; i < 4; ++i) { dsts[q][i] = t0[i]; dsts[q][4 + i] = t1[i]; } }
        }
        float w0c[4], a0c[4];
#pragma unroll
        for (int n = 0; n < 4; ++n) { w0c[n] = a.in[I_W0][l * 512 + h * 64 + n * 16 + fr]; a0c[n] = a.in[I_A0][l * 512 + h * 64 + n * 16 + fr]; }
        { const u32x4 z = {0u, 0u, 0u, 0u}; *(LAS u32x4*)(A_w + (8 + token) * 72 + c8) = z; *(LAS u32x4*)(A_a + (8 + token) * 72 + c8) = z; }
        u32x4 nxt[10];
        auto load_rows = [&](int cc2) {
            const int tg2 = cc2 * T + lw * 8 + token; const bool hp2 = tg2 > 0; const u32x4 z = {0u, 0u, 0u, 0u};
            const bf16_t* pr = PROJ + ((size_t)b * SEQ + tg2) * PP;
            nxt[0] = *(const u32x4*)(pr + C_WL + c8); nxt[1] = hp2 ? *(const u32x4*)(pr - PP + C_WL + c8) : z;
            nxt[2] = *(const u32x4*)(pr + C_AL + c8); nxt[3] = hp2 ? *(const u32x4*)(pr - PP + C_AL + c8) : z;
            nxt[4] = *(const u32x4*)(pr + C_R + ch);  nxt[5] = hp2 ? *(const u32x4*)(pr - PP + C_R + ch) : z;
            nxt[6] = *(const u32x4*)(pr + C_K + ch);  nxt[7] = hp2 ? *(const u32x4*)(pr - PP + C_K + ch) : z;
            nxt[8] = *(const u32x4*)(pr + C_V + ch);  nxt[9] = hp2 ? *(const u32x4*)(pr - PP + C_V + ch) : z;
        };
        load_rows(0);
#pragma unroll 1
        for (int cc = 0; cc <= SEQ / T; ++cc) {
            if (cc < SEQ / T) {
                const int tg = cc * T + lw * 8 + token;
                const u32x4 rw0 = nxt[0], rw1 = nxt[1], ra0 = nxt[2], ra1 = nxt[3], rr0 = nxt[4], rr1 = nxt[5], rk0 = nxt[6], rk1 = nxt[7], rv0 = nxt[8], rv1 = nxt[9];
                bf16x8 bwq[2][4];
#pragma unroll
                for (int ks = 0; ks < 2; ++ks)
#pragma unroll
                    for (int n = 0; n < 4; ++n) bwq[ks][n] = *(const bf16x8*)(W + W_WL + (size_t)(h * 64 + n * 16 + fr) * 64 + ks * 32 + fq * 8);
                float cf[8], pf[8], t8[8];
                unpack8(rw0, cf); unpack8(rw1, pf);
#pragma unroll
                for (int i = 0; i < 8; ++i) t8[i] = tanh_fast(cf[i] + (pf[i] - cf[i]) * muw[i]);
                *(LAS u32x4*)(A_w + token * 72 + c8) = pack8(t8);
                unpack8(ra0, cf); unpack8(ra1, pf);
#pragma unroll
                for (int i = 0; i < 8; ++i) t8[i] = cf[i] + (pf[i] - cf[i]) * mua[i];
                *(LAS u32x4*)(A_a + token * 72 + c8) = pack8(t8);
                asm volatile("s_waitcnt lgkmcnt(0)" ::: "memory");
#pragma unroll
                for (int which = 0; which < 2; ++which) {
                    f32x4 acc[4];
#pragma unroll
                    for (int n = 0; n < 4; ++n) acc[n] = (f32x4){0.f, 0.f, 0.f, 0.f};
                    const LAS bf16_t* As = which ? A_a : A_w;
#pragma unroll
                    for (int ks = 0; ks < 2; ++ks) {
                        const bf16x8 af = *(const LAS bf16x8*)(As + fr * 72 + ks * 32 + fq * 8);
#pragma unroll
                        for (int n = 0; n < 4; ++n) acc[n] = MFMA16(af, bwq[ks][n], acc[n]);
                    }
                    if (which == 0) {
#pragma unroll
                        for (int ks = 0; ks < 2; ++ks)
#pragma unroll
                            for (int n = 0; n < 4; ++n) bwq[ks][n] = *(const bf16x8*)(W + W_AL + (size_t)(h * 64 + n * 16 + fr) * 64 + ks * 32 + fq * 8);
                    }
                    if (fq < 2) {
                        LAS bf16_t* dst = which ? a_s : omd_s;
#pragma unroll
                        for (int n = 0; n < 4; ++n)
#pragma unroll
                            for (int r = 0; r < 4; ++r) {
                                float res;
                                if (which) res = sigm(a0c[n] + acc[n][r]);
                                else { const float x = -(w0c[n] + acc[n][r]); const float ew = 0.60653065971f * __builtin_amdgcn_rcpf(1.f + __expf(x));
                                       res = ew > 0.03f ? 1.f - __expf(-ew) : ew * (1.f - ew * (0.5f - ew * (1.f / 6.f))); }
                                dst[(fq * 4 + r) * 64 + n * 16 + fr] = tobf(res);
                            }
                    }
                }
                asm volatile("s_waitcnt lgkmcnt(0)" ::: "memory");
                float r[8], k[8], v[8], av[8], od[8];
                unpack8(rr0, cf); unpack8(rr1, pf);
#pragma unroll
                for (int i = 0; i < 8; ++i) r[i] = cf[i] + (pf[i] - cf[i]) * mur[i];
                unpack8(rk0, cf); unpack8(rk1, pf);
#pragma unroll
                for (int i = 0; i < 8; ++i) k[i] = cf[i] + (pf[i] - cf[i]) * muk[i];
                unpack8(rv0, cf); unpack8(rv1, pf);
#pragma unroll
                for (int i = 0; i < 8; ++i) v[i] = cf[i] + (pf[i] - cf[i]) * muv[i];
                unpack8(*(const LAS u32x4*)(a_s + token * 64 + c8), av); unpack8(*(const LAS u32x4*)(omd_s + token * 64 + c8), od);
                float kk[8], bb[8], kp[8]; float ss = 0.f;
#pragma unroll
                for (int i = 0; i < 8; ++i) { kk[i] = k[i] * kkp[i]; ss += kk[i] * kk[i]; }
                ss = red8(ss);
                const float rn = rsqrtf(fmaxf(ss, 1e-24f));
#pragma unroll
                for (int i = 0; i < 8; ++i) { kk[i] *= rn; bb[i] = kk[i] * av[i]; kp[i] = k[i] * (1.f + (av[i] - 1.f) * kap[i]); }
                const u32x4 r16 = pack8(r), kp16 = pack8(kp), kk16 = pack8(kk), bb16 = pack8(bb), v16 = pack8(v);
                if (halfsel == 0) { bf16_t* op = PREP3 + ((size_t)bh * SEQ + tg) * 192 + c8; *(u32x4*)op = r16; *(u32x4*)(op + 64) = kp16; *(u32x4*)(op + 128) = v16; }
                LAS float* ob = opbuf + (cc & 1) * CH + (lw * 8 + token) * 384 + c8;
                unpack8(r16, t8);  *(LAS f32x4*)(ob) = (f32x4){t8[0], t8[1], t8[2], t8[3]};       *(LAS f32x4*)(ob + 4) = (f32x4){t8[4], t8[5], t8[6], t8[7]};
#pragma unroll
                for (int i = 0; i < 8; ++i) t8[i] = 1.f - od[i];
                *(LAS f32x4*)(ob + 64) = (f32x4){t8[0], t8[1], t8[2], t8[3]};  *(LAS f32x4*)(ob + 68) = (f32x4){t8[4], t8[5], t8[6], t8[7]};
                unpack8(kp16, t8); *(LAS f32x4*)(ob + 128) = (f32x4){t8[0], t8[1], t8[2], t8[3]}; *(LAS f32x4*)(ob + 132) = (f32x4){t8[4], t8[5], t8[6], t8[7]};
                unpack8(kk16, t8); *(LAS f32x4*)(ob + 192) = (f32x4){t8[0], t8[1], t8[2], t8[3]}; *(LAS f32x4*)(ob + 196) = (f32x4){t8[4], t8[5], t8[6], t8[7]};
                unpack8(bb16, t8); *(LAS f32x4*)(ob + 256) = (f32x4){t8[0], t8[1], t8[2], t8[3]}; *(LAS f32x4*)(ob + 260) = (f32x4){t8[4], t8[5], t8[6], t8[7]};
                unpack8(v16, t8);  *(LAS f32x4*)(ob + 320) = (f32x4){t8[0], t8[1], t8[2], t8[3]}; *(LAS f32x4*)(ob + 324) = (f32x4){t8[4], t8[5], t8[6], t8[7]};
                if (cc + 1 < SEQ / T) load_rows(cc + 1);
            }
            __syncthreads();
        }
    }
    __syncthreads();
}

constexpr int IMPP = 65;
constexpr int AT_IMP = 0, AT_SEL = 4 * 64 * IMPP * 4, AT_LINV = AT_SEL + 512, AT_BUF = AT_LINV + 1024, AT_BUFSZ = 18432, AT_VOFF = 9216;
struct AttnCtx {
    bf16x8 q[4]; int t, tw, qi, hi, tid; unsigned long long mymask; int ncv, ncvw, ncvmin; float inv; LAS float* impw; LAS unsigned char* lds; bool nocompute;
};
template <int BR>
DI void attn_branch(const AttnCtx& c, unsigned long long tmask, const bf16_t* kbase, size_t kpitch, const bf16_t* vbase, size_t vpitch, f32x16 (&o)[2], float& lsum) {
    if (tmask == 0ull) return;
    const int rowi = c.tid >> 3, seg = c.tid & 7;
    const bf16_t* kg = kbase + (size_t)rowi * kpitch + seg * 8;
    const bf16_t* vg = vbase + (size_t)rowi * vpitch + seg * 8;
    unsigned long long m = tmask;
    int j = __ffsll((long long)m) - 1; m &= m - 1;
    u32x4 kr = *(const u32x4*)(kg + (size_t)j * 64 * kpitch), vr;
    if (BR != 0) vr = *(const u32x4*)(vg + j * 64);
    int it = 0;
    for (;;) {
        LAS bf16_t* Ks = (LAS bf16_t*)(c.lds + AT_BUF + (it & 1) * AT_BUFSZ); LAS bf16_t* Vs = (LAS bf16_t*)(c.lds + AT_BUF + (it & 1) * AT_BUFSZ + AT_VOFF);
        *(LAS u32x4*)(Ks + rowi * 72 + seg * 8) = kr;
        if (BR != 0) { *(LAS u32x2*)(Vs + rowi * 68 + seg * 8) = (u32x2){vr.x, vr.y}; *(LAS u32x2*)(Vs + rowi * 68 + seg * 8 + 4) = (u32x2){vr.z, vr.w}; }
        __syncthreads();
        const int jc = j; const bool more = m != 0ull;
        if (more) { j = __ffsll((long long)m) - 1; m &= m - 1; kr = *(const u32x4*)(kg + (size_t)j * 64 * kpitch); if (BR != 0) vr = *(const u32x4*)(vg + j * 64); }
        bool mine = true;
        if (BR == 2) mine = (c.mymask >> jc) & 1ull;
        const bool wave_on = (BR == 2 ? (__ballot(mine) != 0ull) : true) && !c.nocompute;
        if (wave_on) {
            const float sbias = (BR == 2 && !mine) ? -1e30f : 0.f;
            bool interior;
            if (BR <= 1) interior = jc * 64 + 64 <= c.ncvmin;
            else if (BR == 2) interior = jc * 64 + 63 <= c.tw;
            else interior = (jc * 64 + 63 <= c.tw) && (jc * 64 > c.tw + 31 - 512);
            if (interior) {
                f32x16 s0, s1;
#pragma unroll
                for (int i = 0; i < 16; ++i) { s0[i] = sbias; s1[i] = sbias; }
#pragma unroll
                for (int st = 0; st < 4; ++st) {
                    const bf16x8 kf0 = *(const LAS bf16x8*)(Ks + c.qi * 72 + 16 * st + 8 * c.hi), kf1 = *(const LAS bf16x8*)(Ks + (32 + c.qi) * 72 + 16 * st + 8 * c.hi);
                    s0 = MFMA32(kf0, c.q[st], s0); s1 = MFMA32(kf1, c.q[st], s1);
                }
                float p0[16], p1[16];
#pragma unroll
                for (int i = 0; i < 16; ++i) { p0[i] = __builtin_amdgcn_exp2f(s0[i]); p1[i] = __builtin_amdgcn_exp2f(s1[i]); }
                {
                    float l0 = 0.f, l1 = 0.f;
#pragma unroll
                    for (int i = 0; i < 16; ++i) { l0 += p0[i]; l1 += p1[i]; }
                    lsum += l0 + l1;
                }
                if (BR == 1) {
#pragma unroll
                    for (int gq = 0; gq < 4; ++gq) {
                        const int jj = jc * 16 + gq * 2 + c.hi;
                        __hip_atomic_fetch_add(c.impw + jj, (p0[4 * gq] + p0[4 * gq + 1]) + (p0[4 * gq + 2] + p0[4 * gq + 3]), __ATOMIC_RELAXED, __HIP_MEMORY_SCOPE_WORKGROUP);
                        __hip_atomic_fetch_add(c.impw + jj + 1, p0[4 * gq + 3], __ATOMIC_RELAXED, __HIP_MEMORY_SCOPE_WORKGROUP);
                    }
#pragma unroll
                    for (int gq = 0; gq < 4; ++gq) {
                        const int jj = jc * 16 + 8 + gq * 2 + c.hi;
                        __hip_atomic_fetch_add(c.impw + jj, (p1[4 * gq] + p1[4 * gq + 1]) + (p1[4 * gq + 2] + p1[4 * gq + 3]), __ATOMIC_RELAXED, __HIP_MEMORY_SCOPE_WORKGROUP);
                        if (jj + 1 < 64) __hip_atomic_fetch_add(c.impw + jj + 1, p1[4 * gq + 3], __ATOMIC_RELAXED, __HIP_MEMORY_SCOPE_WORKGROUP);
                    }
                }
                if (BR != 0) {
                    unsigned pa[8], pb[8];
#pragma unroll
                    for (int i = 0; i < 8; ++i) { pa[i] = pk2(p0[2 * i], p0[2 * i + 1]); pb[i] = pk2(p1[2 * i], p1[2 * i + 1]); }
#pragma unroll
                    for (int f = 0; f < 2; ++f) {
                        const u32x4 bw0 = {pa[4 * f], pa[4 * f + 1], pa[4 * f + 2], pa[4 * f + 3]}, bw1 = {pb[4 * f], pb[4 * f + 1], pb[4 * f + 2], pb[4 * f + 3]};
#pragma unroll
                        for (int mt = 0; mt < 2; ++mt) {
                            const LAS bf16_t* vp = Vs + (mt * 32 + c.qi) * 68 + f * 16 + 4 * c.hi;
                            const u32x2 a0 = *(const LAS u32x2*)vp, a1 = *(const LAS u32x2*)(vp + 8), a2 = *(const LAS u32x2*)(vp + 32), a3 = *(const LAS u32x2*)(vp + 40);
                            const u32x4 aw0 = {a0.x, a0.y, a1.x, a1.y}, aw1 = {a2.x, a2.y, a3.x, a3.y};
                            o[mt] = MFMA32(__builtin_bit_cast(bf16x8, aw0), __builtin_bit_cast(bf16x8, bw0), o[mt]);
                            o[mt] = MFMA32(__builtin_bit_cast(bf16x8, aw1), __builtin_bit_cast(bf16x8, bw1), o[mt]);
                        }
                    }
                }
            } else {
#pragma unroll
            for (int sub = 0; sub < 2; ++sub) {
                const int key0 = jc * 64 + sub * 32;
                bool skip;
                if (BR <= 1) skip = key0 >= c.ncvw;
                else if (BR == 2) skip = key0 > c.tw + 31;
                else skip = (key0 + 31 < c.tw - 511) || (key0 > c.tw + 31);
                if (skip) continue;
                f32x16 s;
#pragma unroll
                for (int i = 0; i < 16; ++i) s[i] = sbias;
#pragma unroll
                for (int st = 0; st < 4; ++st) { const bf16x8 kf = *(const LAS bf16x8*)(Ks + (sub * 32 + c.qi) * 72 + 16 * st + 8 * c.hi); s = MFMA32(kf, c.q[st], s); }
                float p[16];
#pragma unroll
                for (int i = 0; i < 16; ++i) p[i] = __builtin_amdgcn_exp2f(s[i]);
                int lim;
                if (BR <= 1) lim = c.ncv - 1 - key0 - 4 * c.hi; else lim = c.t - key0 - 4 * c.hi;
#pragma unroll
                for (int i = 0; i < 16; ++i) { const int cst = (i & 3) + 8 * (i >> 2); bool valid = cst <= lim; if (BR == 3) valid = valid && (cst > lim - 512); p[i] = valid ? p[i] : 0.f; }
#pragma unroll
                for (int i = 0; i < 16; ++i) lsum += p[i];
                if (BR == 0) continue;
                if (BR == 1) {
#pragma unroll
                    for (int gq = 0; gq < 4; ++gq) {
                        const int jj = jc * 16 + sub * 8 + gq * 2 + c.hi;
                        __hip_atomic_fetch_add(c.impw + jj, (p[4 * gq] + p[4 * gq + 1]) + (p[4 * gq + 2] + p[4 * gq + 3]), __ATOMIC_RELAXED, __HIP_MEMORY_SCOPE_WORKGROUP);
                        if (jj + 1 < 64) __hip_atomic_fetch_add(c.impw + jj + 1, p[4 * gq + 3], __ATOMIC_RELAXED, __HIP_MEMORY_SCOPE_WORKGROUP);
                    }
                }
                unsigned pp[8];
#pragma unroll
                for (int i = 0; i < 8; ++i) pp[i] = pk2(p[2 * i], p[2 * i + 1]);
#pragma unroll
                for (int f = 0; f < 2; ++f) {
                    const u32x4 bw = {pp[4 * f], pp[4 * f + 1], pp[4 * f + 2], pp[4 * f + 3]};
                    const bf16x8 bfr = __builtin_bit_cast(bf16x8, bw);
#pragma unroll
                    for (int mt = 0; mt < 2; ++mt) {
                        const LAS bf16_t* vp = Vs + (mt * 32 + c.qi) * 68 + sub * 32 + f * 16 + 4 * c.hi;
                        const u32x2 a0 = *(const LAS u32x2*)vp, a1 = *(const LAS u32x2*)(vp + 8);
                        const u32x4 aw = {a0.x, a0.y, a1.x, a1.y};
                        o[mt] = MFMA32(__builtin_bit_cast(bf16x8, aw), bfr, o[mt]);
                    }
                }
            }
            }
        }
        if (!more) break;
        ++it;
    }
    __syncthreads();
}
DI void attn_item(const Args& a, int l, int item, LAS unsigned char* lds, bool dry = false) {
    const int tid = otid(), wid = tid >> 6, lane = tid & 63, qi = lane & 31, hi = lane >> 5;
    const int qb = item >> 4, bg = item & 15, b = bg >> 1, g = bg & 1;
    const int hh = wid >> 1, half = wid & 1, head = g * 4 + hh;
    const int t0 = qb * 64, tw = t0 + half * 32, t = tw + qi, tq = half * 32 + qi;
    bf16_t* PROJ = (bf16_t*)(a.ws + WS_PROJ);
    LAS float* imp = (LAS float*)(lds + AT_IMP);
    LAS unsigned long long* selm = (LAS unsigned long long*)(lds + AT_SEL);
    LAS float* linv = (LAS float*)(lds + AT_LINV);
    for (int i = tid; i < 4 * 64 * IMPP; i += 512) imp[i] = 0.f;
    const size_t qrow = (size_t)b * SEQ + t;
    AttnCtx c; c.nocompute = false;
#ifdef DRY_NOCOMPUTE
    c.nocompute = dry;
#endif
    c.t = t; c.tw = tw; c.qi = qi; c.hi = hi; c.tid = tid; c.lds = lds; c.mymask = 0ull; c.inv = 0.f;
    c.ncv = t >= 31 ? (t - 15) >> 4 : 0; c.ncvw = (tw + 16) >> 4; c.ncvmin = tw >= 31 ? (tw - 15) >> 4 : 0; c.impw = imp + (hh * 64 + tq) * IMPP;
    {
        const bf16_t* qp = PROJ + qrow * PP + C_Q + head * 64 + 8 * hi;
        float qf[4][8]; float ss = 0.f;
#pragma unroll
        for (int st = 0; st < 4; ++st) { unpack8(*(const u32x4*)(qp + 16 * st), qf[st]);
#pragma unroll
            for (int j = 0; j < 8; ++j) ss += qf[st][j] * qf[st][j]; }
        ss += __shfl_xor(ss, 32);
        const float sc = rsqrtf(ss * (1.f / 64.f) + 1e-6f) * 0.125f * 1.4426950408889634f;
        const float* qg = a.in[I_QGAIN] + l * 64 + 8 * hi;
#pragma unroll
        for (int st = 0; st < 4; ++st) {
#pragma unroll
            for (int j = 0; j < 8; ++j) qf[st][j] *= sc * qg[16 * st + j];
            c.q[st] = __builtin_bit_cast(bf16x8, pack8(qf[st]));
        }
    }
    const float g_c = bf1(PROJ[qrow * PP + C_NG + head * 3 + 0]), g_s = bf1(PROJ[qrow * PP + C_NG + head * 3 + 1]), g_w = bf1(PROJ[qrow * PP + C_NG + head * 3 + 2]);
    f32x16 ot[2], ob[2];
#pragma unroll
    for (int i = 0; i < 16; ++i) { ot[0][i] = 0.f; ot[1][i] = 0.f; ob[0][i] = 0.f; ob[1][i] = 0.f; }
    __syncthreads();
    {
        const int ntc = (((t0 + 48) >> 4) + 63) >> 6;
        const unsigned long long cm = (1ull << ntc) - 1ull;
        const bf16_t* kc = (const bf16_t*)(a.ws + WS_KCN) + (size_t)bg * 256 * 64;
        const bf16_t* vct = (const bf16_t*)(a.ws + WS_VCT) + (size_t)bg * 64 * 256;
        float lsum = 0.f;
        attn_branch<1>(c, cm, kc, 64, vct, 256, ob, lsum);
        lsum += __shfl_xor(lsum, 32);
        const float inv = lsum > 0.f ? 1.f / lsum : 0.f;
        if (hi == 0) linv[hh * 64 + tq] = inv;
        const float sc = g_c * inv;
#pragma unroll
        for (int i = 0; i < 16; ++i) { ot[0][i] += ob[0][i] * sc; ot[1][i] += ob[1][i] * sc; ob[0][i] = 0.f; ob[1][i] = 0.f; }
    }
    __syncthreads();
    if (qb < 16) { if (lane < 8) selm[wid * 8 + lane] = (2ull << qb) - 1ull; }
    else
    for (int k = 0; k < 8; ++k) {
        const int tk = wid * 8 + k;
        float val = (imp[(0 * 64 + tk) * IMPP + lane] * linv[tk] + imp[(1 * 64 + tk) * IMPP + lane] * linv[64 + tk]) + (imp[(2 * 64 + tk) * IMPP + lane] * linv[128 + tk] + imp[(3 * 64 + tk) * IMPP + lane] * linv[192 + tk]);
        const bool causal = lane <= qb, forced = (lane == 0) || (lane == qb) || (lane == qb - 1);
        val = causal ? val + (forced ? 1000.f : 0.f) : -1.f;
        int rank = 0;
#pragma unroll
        for (int j = 0; j < 64; ++j) { const float vj = __builtin_bit_cast(float, __builtin_amdgcn_readlane(__builtin_bit_cast(int, val), j)); rank += (vj > val || (vj == val && j < lane)) ? 1 : 0; }
        const unsigned long long mk = __ballot(rank < 16 && causal);
        if (lane == 0) selm[tk] = mk;
    }
    __syncthreads();
    {
        c.mymask = selm[tq];
        const unsigned long long all = selm[lane];
        unsigned long long um = 0ull;
        for (int j = 0; j <= qb; ++j) if (__ballot((all >> j) & 1ull) != 0ull) um |= 1ull << j;
        float lsum = 0.f;
        attn_branch<2>(c, um, PROJ + (size_t)b * SEQ * PP + C_KS + g * 64, PP, (const bf16_t*)(a.ws + WS_VST) + (size_t)bg * 64 * SEQ, SEQ, ob, lsum);
        lsum += __shfl_xor(lsum, 32);
        const float sc = lsum > 0.f ? g_s / lsum : 0.f;
#pragma unroll
        for (int i = 0; i < 16; ++i) { ot[0][i] += ob[0][i] * sc; ot[1][i] += ob[1][i] * sc; ob[0][i] = 0.f; ob[1][i] = 0.f; }
    }
    {
        const int jlo = qb >= 8 ? qb - 8 : 0;
        const unsigned long long wm = ((qb == 63 ? ~0ull : ((1ull << (qb + 1)) - 1ull)) >> jlo) << jlo;
        float lsum = 0.f;
        attn_branch<3>(c, wm, PROJ + (size_t)b * SEQ * PP + C_KW + g * 64, PP, (const bf16_t*)(a.ws + WS_VWT) + (size_t)bg * 64 * SEQ, SEQ, ob, lsum);
        lsum += __shfl_xor(lsum, 32);
        const float sc = lsum > 0.f ? g_w / lsum : 0.f;
#pragma unroll
        for (int i = 0; i < 16; ++i) { ot[0][i] += ob[0][i] * sc; ot[1][i] += ob[1][i] * sc; }
    }
    if (!dry || a.ph_hi == 12345) {
        bf16_t* op = PROJ + qrow * PP + C_Q + head * 64 + 4 * hi;
#pragma unroll
        for (int mt = 0; mt < 2; ++mt)
#pragma unroll
            for (int gq = 0; gq < 4; ++gq) { u32x2 w; w.x = pk2(ot[mt][4 * gq], ot[mt][4 * gq + 1]); w.y = pk2(ot[mt][4 * gq + 2], ot[mt][4 * gq + 3]); *(u32x2*)(op + mt * 32 + gq * 8) = w; }
    }
    __syncthreads();
}
#ifndef SCAN_RPL
#define SCAN_RPL 2
#endif
DI void phase_mix(const Args& a, int l, LAS unsigned char* lds) {
    const int nscan = 128;
    if ((int)blockIdx.x < nscan) {
#ifdef DUPSCAN
        for (int rep = 0; rep < 2; ++rep)
#endif
        { const int sx = blockIdx.x & 7, si = blockIdx.x >> 3;
          scan_bh2(a, l, (si >> 1) * 8 + sx, si & 1, lds); }
        if (gridDim.x - nscan == 128) { const int sb = blockIdx.x, xcd = sb & 7, slot = sb >> 3; attn_item(a, l, slot * 16 + 2 * xcd, lds); }
    } else { const int na = gridDim.x - nscan;
#ifdef DUPATTN
        for (int it = blockIdx.x - nscan; it < 1024; it += na) attn_item(a, l, it, lds, true);
#endif
        if (na == 128) {
            const int ab = blockIdx.x - nscan, xcd = ab & 7, slot = ab >> 3;
            for (int r = 0; r < 8; ++r) {
                const int bg = 2 * xcd + (r >> 2), rr = r & 3;
                const int qb = rr == 0 ? 63 - slot : rr == 1 ? slot : rr == 2 ? 47 - slot : 16 + slot;
                if (r == 1) continue;
                attn_item(a, l, qb * 16 + bg, lds);
            }
        } else { for (int it = blockIdx.x - nscan; it < 1024; it += na) attn_item(a, l, it, lds); } }
}

DI void post_item(const Args& a, int l, int item, LAS unsigned char* lds) {
    const int tid = otid(), wid = tid >> 6, lane = tid & 63, fr = lane & 15, fq = lane >> 4;
    const int b = item >> 6, t0 = (item & 63) * 64;
    bf16_t* PROJ = (bf16_t*)(a.ws + WS_PROJ); const bf16_t* PREP = (const bf16_t*)(a.ws + WS_PREP); const bf16_t* W = (const bf16_t*)(a.ws + WS_W);
    LAS bf16_t* A_g = (LAS bf16_t*)lds; LAS bf16_t* z_s = (LAS bf16_t*)(lds + 17408);
    constexpr int PZ = 520;
    const float* mu = a.in[I_TOKMIX] + l * 1792;
    {
        const int token = tid >> 3, part = tid & 7; const size_t row = (size_t)b * SEQ + t0 + token; const bool hp = (t0 + token) > 0;
#pragma unroll
        for (int hf = 0; hf < 2; ++hf) {
            float v[8]; const int cc = part * 16 + hf * 8;
            lerp8(PROJ + row * PP + C_GL + cc, PROJ + (row - 1) * PP + C_GL + cc, hp, mu + (C_GL - C_R) + cc, v);
#pragma unroll
            for (int i = 0; i < 8; ++i) v[i] = sigm(v[i]);
            *(LAS u32x4*)(A_g + token * 136 + cc) = pack8(v);
        }
    }
    {
        const int cgp = tid & 63, head = cgp >> 3, k0 = (cgp & 7) * 8, c = cgp * 8;
        float rk[8], lw[8], lb[8];
        {
            const float* srcs[3] = {a.in[I_RK] + l * 512 + c, a.in[I_LNW] + l * 512 + c, a.in[I_LNB] + l * 512 + c};
            float* dsts[3] = {rk, lw, lb};
#pragma unroll
            for (int q = 0; q < 3; ++q) { const f32x4 t0v = *(const f32x4*)srcs[q], t1v = *(const f32x4*)(srcs[q] + 4);
#pragma unroll
                for (int i = 0; i < 4; ++i) { dsts[q][i] = t0v[i]; dsts[q][4 + i] = t1v[i]; } }
        }
        u32x4 raw[4];
        auto load_unit = [&](int u) {
            const int token = u * 8 + (tid >> 6); const size_t row = (size_t)b * SEQ + t0 + token;
            raw[0] = *(const u32x4*)((const bf16_t*)(a.ws + WS_Y) + row * 512 + c);
            const bf16_t* ip = PREP + ((size_t)(b * 8 + head) * SEQ + t0 + token) * 192 + k0;
            raw[1] = *(const u32x4*)ip; raw[2] = *(const u32x4*)(ip + 64); raw[3] = *(const u32x4*)(ip + 128);
        };
        load_unit(0);
#pragma unroll 1
        for (int u = 0; u < 8; ++u) {
            const int token = u * 8 + (tid >> 6);
            float y[8], r[8], k[8], v[8];
            unpack8(raw[0], y); unpack8(raw[1], r); unpack8(raw[2], k); unpack8(raw[3], v);
            if (u + 1 < 8) load_unit(u + 1);
            float sm = 0.f;
#pragma unroll
            for (int i = 0; i < 8; ++i) sm += y[i];
            const float mean = red8(sm) * (1.f / 64.f);
            float sv = 0.f;
#pragma unroll
            for (int i = 0; i < 8; ++i) { y[i] -= mean; sv += y[i] * y[i]; }
            const float rstd = rsqrtf(red8(sv) * (1.f / 64.f) + 64e-5f);
            float dot = 0.f;
#pragma unroll
            for (int i = 0; i < 8; ++i) dot += r[i] * k[i] * rk[i];
            dot = red8(dot);
            float z[8];
#pragma unroll
            for (int i = 0; i < 8; ++i) z[i] = y[i] * rstd * lw[i] + lb[i] + dot * v[i];
            *(LAS u32x4*)(z_s + token * PZ + c) = pack8(z);
        }
    }
    __syncthreads();
    {
        f32x4 acc[4][4];
#pragma unroll
        for (int m = 0; m < 4; ++m)
#pragma unroll
            for (int n = 0; n < 4; ++n) acc[m][n] = (f32x4){0.f, 0.f, 0.f, 0.f};
#pragma unroll
        for (int ks = 0; ks < 4; ++ks) {
            bf16x8 ag[4];
#pragma unroll
            for (int m = 0; m < 4; ++m) ag[m] = *(const LAS bf16x8*)(A_g + (m * 16 + fr) * 136 + ks * 32 + fq * 8);
#pragma unroll
            for (int n = 0; n < 4; ++n) {
                const bf16x8 bgf = *(const bf16x8*)(W + W_GL + (size_t)(wid * 64 + n * 16 + fr) * 128 + ks * 32 + fq * 8);
#pragma unroll
                for (int m = 0; m < 4; ++m) acc[m][n] = MFMA16(ag[m], bgf, acc[m][n]);
            }
        }
#pragma unroll
        for (int m = 0; m < 4; ++m)
#pragma unroll
            for (int n = 0; n < 4; ++n)
#pragma unroll
                for (int r = 0; r < 4; ++r) { const int idx = (m * 16 + fq * 4 + r) * PZ + wid * 64 + n * 16 + fr; z_s[idx] = tobf(bf1(z_s[idx]) * acc[m][n][r]); }
    }
    __syncthreads();
#pragma unroll
    for (int u = 0; u < 8; ++u) {
        const int id = u * 512 + tid, token = id >> 6, cgp = id & 63;
        *(u32x4*)(PROJ + ((size_t)b * SEQ + t0 + token) * PP + C_R + cgp * 8) = *(const LAS u32x4*)(z_s + token * PZ + cgp * 8);
    }
    __syncthreads();
}

#ifndef PHMASK
#define PHMASK 0x3ff
#endif
#define PHEN(k) ((PHMASK >> (k)) & 1)
__global__ void __launch_bounds__(512, 2) fwd_kernel(Args a) {
    extern __shared__ __attribute__((aligned(16))) unsigned char lds_raw[];
    LAS unsigned char* lds = (LAS unsigned char*)lds_raw;
    cg::grid_group grid = cg::this_grid();
    volatile LAS unsigned* xst = (volatile LAS unsigned*)(lds + LDS_BYTES - 16);
    if (threadIdx.x == 0) { xst[0] = 0u; xst[1] = 0u; }
    __syncthreads();
    const XcdBarrier xb = xcd_barrier_post((unsigned*)(a.ws + WS_BAR), xst);
#pragma unroll 1
    for (int ph = a.ph_lo; ph < a.ph_hi; ++ph) {
        const int l = ph / 10, p = ph % 10;
        if (p == 7) continue;
        if (ph > a.ph_lo) { if (a.ph_hi == 12345) grid.sync(); else xcd_barrier(xb); }
        { size_t z_ = 0; asm volatile("" : "+s"(z_)); a.ws = a.ws + z_; a.out = a.out + z_; }
        bf16_t* W = (bf16_t*)(a.ws + WS_W);
        bf16_t* PROJ = (bf16_t*)(a.ws + WS_PROJ);
#ifdef DUPMASK
        const int nrep = ((DUPMASK >> p) & 1) ? 2 : 1;
#else
        const int nrep = 1;
#endif
#pragma unroll 1
        for (int rep = 0; rep < nrep; ++rep) {
        if (rep) grid.sync();
        if (PHEN(0) && p == 0) { phase_conv(a, l, lds); __syncthreads(); }
        else if (PHEN(1) && p == 1) {
            pg8::Gemm g{(const bf16_t*)(a.ws + WS_U), W + W_IN, M_TOK, NPROJ_P, DM, DM}; pg8::StaticOrder S; S.init(M_TOK, NPROJ_P, gridDim.x, (int)blockIdx.x);
            pg8::EpiProj E{PROJ, (uint8_t*)(a.ws + WS_GATE), l == 0 ? nullptr : (const float*)(a.ws + WS_SS) + M_TOK};
            pg8::gemm_phase<pg8::EpiProj, pg8::StaticOrder, true, true>(lds, g, S, E);
        }
        else if (PHEN(2) && p == 2) phase_prep(a, l, lds);
        else if (PHEN(3) && p == 3) phase_mix(a, l, lds);
        else if (PHEN(4) && p == 4) { for (int it = blockIdx.x; it < 512; it += gridDim.x) post_item(a, l, it, lds); }
        else if (PHEN(5) && p == 5) {
            { pg8::Gemm g{PROJ + C_Q, W + W_A, M_TOK, DM, 512, PP}; pg8::StaticOrder S; S.init(M_TOK, DM, gridDim.x, (int)blockIdx.x);
              pg8::EpiMerge<false> E{(bf16_t*)(a.ws + WS_MERGED), (const uint8_t*)(a.ws + WS_GATE)};
              pg8::gemm_phase<pg8::EpiMerge<false>, pg8::StaticOrder, true, true>(lds, g, S, E); }
            { pg8::Gemm g{PROJ + C_R, W + W_B, M_TOK, DM, 512, PP}; pg8::StaticOrder S; S.init(M_TOK, DM, gridDim.x, (int)blockIdx.x);
              pg8::EpiMerge<true> E{(bf16_t*)(a.ws + WS_MERGED), (const uint8_t*)(a.ws + WS_GATE)};
              pg8::gemm_phase<pg8::EpiMerge<true>, pg8::StaticOrder, true, true>(lds, g, S, E); }
        }
        else if (PHEN(6) && p == 6) {
            pg8::Gemm g{(const bf16_t*)(a.ws + WS_MERGED), W + W_OUT, M_TOK, DM, DM, DM}; pg8::StaticOrder S; S.init(M_TOK, DM, gridDim.x, (int)blockIdx.x);
            pg8::EpiResF32 E{l == 0 ? a.in[I_X] : a.out, a.out, (bf16_t*)(a.ws + WS_HN), a.in[I_FFNNORM] + l * DM, (float*)(a.ws + WS_SS) + (l == 0 ? 0 : 2 * M_TOK)};
            pg8::gemm_phase<pg8::EpiResF32, pg8::StaticOrder, true, true>(lds, g, S, E);
        }
        else if (PHEN(7) && p == 7) phase_norm2(a, l);
        else if (PHEN(8) && p == 8) {
            pg8::Gemm g{(const bf16_t*)(a.ws + WS_HN), W + W_UP, M_TOK, 4096, DM, DM}; pg8::StaticOrder S; S.init(M_TOK, 4096, gridDim.x, (int)blockIdx.x);
            pg8::EpiRelu2 E{(bf16_t*)(a.ws + WS_H), (const float*)(a.ws + WS_SS) + (l == 0 ? 0 : 2 * M_TOK)};
            pg8::gemm_phase<pg8::EpiRelu2, pg8::StaticOrder, true, true>(lds, g, S, E);
        }
        else if (PHEN(9)) {
            pg8::Gemm g{(const bf16_t*)(a.ws + WS_H), W + W_DOWN, M_TOK, DM, 4096, 4096}; pg8::StaticOrder S; S.init(M_TOK, DM, gridDim.x, (int)blockIdx.x);
            pg8::EpiResF32 E{a.out, a.out, l == 0 ? (bf16_t*)(a.ws + WS_U) : nullptr, a.in[I_MIXNORM] + DM, (float*)(a.ws + WS_SS) + M_TOK};
            pg8::gemm_phase<pg8::EpiResF32, pg8::StaticOrder, true, true>(lds, g, S, E);
        }
        }
    }
}

#ifndef N_PHASE_LAUNCH
#define N_PHASE_LAUNCH 20
#endif
extern "C" void kernel_launch(void* const* d_in, const int* in_sizes, int n_in, void* d_out, int out_size, void* d_ws, size_t ws_size, hipStream_t stream) {
    static int grid = 0;
    if (grid == 0) {
        int dev = 0, cus = 0, per_cu = 0;
        (void)hipGetDevice(&dev);
        (void)hipDeviceGetAttribute(&cus, hipDeviceAttributeMultiprocessorCount, dev);
        if (hipFuncSetAttribute((const void*)fwd_kernel, hipFuncAttributeMaxDynamicSharedMemorySize, LDS_BYTES) != hipSuccess) { fprintf(stderr, "hipFuncSetAttribute failed\n"); grid = -1; return; }
        (void)hipOccupancyMaxActiveBlocksPerMultiprocessor(&per_cu, (const void*)fwd_kernel, 512, LDS_BYTES);
        if (per_cu < 1) { fprintf(stderr, "occupancy query says %d blocks per CU\n", per_cu); per_cu = 1; }
        (void)hipGetLastError();
        grid = cus;
        if (ws_size < 502 * MiB) { fprintf(stderr, "workspace too small: %zu\n", ws_size); grid = -1; return; }
    }
    if (grid < 0) return;
    if (hipMemsetAsync((char*)d_ws + WS_BAR, 0, XCD_BAR_WORDS * 4, stream) != hipSuccess) { fprintf(stderr, "memset of the barrier words failed\n"); return; }
    Args a{};
    for (int i = 0; i < 25; ++i) a.in[i] = (const float*)d_in[i];
    a.out = (float*)d_out; a.ws = (unsigned char*)d_ws;
    for (int lo = 0; lo < 20; lo += N_PHASE_LAUNCH) {
        a.ph_lo = lo; a.ph_hi = lo + N_PHASE_LAUNCH > 20 ? 20 : lo + N_PHASE_LAUNCH;
        void* args[] = {&a};
        hipError_t e;
        if (N_PHASE_LAUNCH > 1) e = hipLaunchCooperativeKernel((const void*)fwd_kernel, dim3(grid), dim3(512), args, LDS_BYTES, stream);
        else e = hipLaunchKernel((const void*)fwd_kernel, dim3(grid), dim3(512), args, LDS_BYTES, stream);
        if (e != hipSuccess) { fprintf(stderr, "launch failed: %s\n", hipGetErrorString(e)); break; }
    }
}
```
